# Optimizing an MI355X kernel written in HIP

```python
import math
import jax, jax.numpy as jnp
from jax import lax
import numpy as np

D_MODEL = 4096
BATCH = 4
SEQ = 2048
DEPTH = 2

HEAD_DIM = 128
D_MIX = D_MODEL
BRANCH_WIDTH = D_MIX // 4
GLA_HEADS = BRANCH_WIDTH // HEAD_DIM
GLA_DK = HEAD_DIM // 2
GLA_DV = HEAD_DIM
GLA_RANK = 16
GLA_TAU = 16.0
GLA_CHUNK = 64
SWA_HEADS = BRANCH_WIDTH // HEAD_DIM
SWA_KV_HEADS = SWA_HEADS // 4
SWA_GROUP = SWA_HEADS // SWA_KV_HEADS
SWA_WINDOW = 128
DIFF_HEADS = BRANCH_WIDTH // HEAD_DIM
DIFF_DQK = HEAD_DIM // 2
DIFF_DV = HEAD_DIM
Q_BLOCK = 128
LRU_WIDTH = BRANCH_WIDTH
LRU_BLOCKS = BRANCH_WIDTH // HEAD_DIM
LRU_BLOCK_DIM = LRU_WIDTH // LRU_BLOCKS
LRU_C = 8.0
CONV_WIDTH = 4
NORM_EPS = 1e-6

IN_SPLITS = (
    GLA_HEADS * GLA_DK, GLA_HEADS * GLA_DK, GLA_HEADS * GLA_DV, GLA_RANK,
    SWA_HEADS * HEAD_DIM, SWA_KV_HEADS * HEAD_DIM, SWA_KV_HEADS * HEAD_DIM,
    DIFF_HEADS * 2 * DIFF_DQK, DIFF_HEADS * 2 * DIFF_DQK, DIFF_HEADS * DIFF_DV,
    LRU_WIDTH, D_MIX,
)
D_IN = sum(IN_SPLITS)

kernel_name = 'hybrid_parallel_heads_block'


def rms_norm(x, w):
    xf = x.astype(jnp.float32)
    y = xf * lax.rsqrt(jnp.mean(xf * xf, axis=-1, keepdims=True) + NORM_EPS)
    return (y * w.astype(jnp.float32)).astype(x.dtype)


def alibi_slopes(n):
    return 2.0 ** (-8.0 * jnp.arange(1, n + 1, dtype=jnp.float32) / n)


def split_cols(t, sizes):
    offs, acc = [], 0
    for s in sizes[:-1]:
        acc += s
        offs.append(acc)
    return jnp.split(t, offs, axis=-1)


def gla_mixer(q, k, v, a_lr, w_up, b_up, norm_w):
    B, S, _ = q.shape
    C, H, dk, dv = GLA_CHUNK, GLA_HEADS, GLA_DK, GLA_DV
    nc = S // C
    f32 = jnp.float32
    qf = q.astype(f32).reshape(B, nc, C, H, dk) * dk ** -0.5
    kf = k.astype(f32).reshape(B, nc, C, H, dk)
    vf = v.astype(f32).reshape(B, nc, C, H, dv)
    logit = jnp.einsum('bsr,rk->bsk', a_lr.astype(f32), w_up.astype(f32)) + b_up.astype(f32)
    g = (jax.nn.log_sigmoid(logit) / GLA_TAU).reshape(B, nc, C, H, dk)
    b = jnp.cumsum(g, axis=2)
    b_last = b[:, :, -1:]
    q_dec = qf * jnp.exp(b)
    k_dec = kf * jnp.exp(-b)
    causal = jnp.tril(jnp.ones((C, C), dtype=bool))
    A = jnp.einsum('bnihd,bnjhd->bnhij', q_dec, k_dec)
    A = jnp.where(causal, A, 0.0)
    o_intra = jnp.einsum('bnhij,bnjhv->bnihv', A, vf)
    k_state = kf * jnp.exp(b_last - b)
    U = jnp.einsum('bnjhd,bnjhv->bnhdv', k_state, vf)
    decay = jnp.exp(b_last[:, :, 0])

    def step(state, inp):
        d, u = inp
        return d[..., None] * state + u, state

    s0 = jnp.zeros((B, H, dk, dv), f32)
    _, s_start = lax.scan(step, s0, (jnp.swapaxes(decay, 0, 1), jnp.swapaxes(U, 0, 1)))
    s_start = jnp.swapaxes(s_start, 0, 1)
    o_inter = jnp.einsum('bnihd,bnhdv->bnihv', q_dec, s_start)
    o = (o_intra + o_inter).reshape(B, S, H, dv)
    o = rms_norm(o, norm_w)
    return o.reshape(B, S, H * dv).astype(v.dtype)


def with_prev_block(t, W):
    B, S, Hk, d = t.shape
    tb = t.reshape(B, S // W, W, Hk, d)
    prev = jnp.concatenate([jnp.zeros_like(tb[:, :1]), tb[:, :-1]], axis=1)
    return jnp.concatenate([prev, tb], axis=2)


def swa_mixer(q, k, v, q_norm_w, k_norm_w, sinks):
    B, S, _ = q.shape
    W = SWA_WINDOW
    nb = S // W
    q = rms_norm(q.reshape(B, S, SWA_KV_HEADS, SWA_GROUP, HEAD_DIM), q_norm_w) * HEAD_DIM ** -0.5
    k = rms_norm(k.reshape(B, S, SWA_KV_HEADS, HEAD_DIM), k_norm_w)
    v = v.reshape(B, S, SWA_KV_HEADS, HEAD_DIM)
    qb = q.reshape(B, nb, W, SWA_KV_HEADS, SWA_GROUP, HEAD_DIM)
    kb = with_prev_block(k, W)
    vb = with_prev_block(v, W)
    s = jnp.einsum('bnqhgd,bnkhd->bnhgqk', qb, kb).astype(jnp.float32)
    q_pos = jnp.arange(W)[:, None] + W
    k_pos = jnp.arange(2 * W)[None, :]
    dist = q_pos - k_pos
    blk = jnp.arange(nb)[:, None, None]
    valid = (dist >= 0) & (dist < W) & (blk * W + k_pos - W >= 0)
    slopes = alibi_slopes(SWA_HEADS).reshape(SWA_KV_HEADS, SWA_GROUP)
    s = s - slopes[:, :, None, None] * dist.astype(jnp.float32)
    s = jnp.where(valid[None, :, None, None], s, -jnp.inf)
    sink = sinks.astype(jnp.float32).reshape(1, 1, SWA_KV_HEADS, SWA_GROUP, 1, 1)
    m = jnp.maximum(jnp.max(s, axis=-1, keepdims=True), sink)
    p = jnp.exp(s - m)
    p = p / (jnp.sum(p, axis=-1, keepdims=True) + jnp.exp(sink - m))
    o = jnp.einsum('bnhgqk,bnkhd->bnqhgd', p.astype(v.dtype), vb)
    return o.reshape(B, S, SWA_HEADS * HEAD_DIM)


def diff_mixer(q, k, v, q_norm_w, k_norm_w, lq1, lk1, lq2, lk2, out_norm_w, lambda_init):
    B, S, _ = q.shape
    H = DIFF_HEADS
    q = rms_norm(q.reshape(B, S, H, 2, DIFF_DQK), q_norm_w) * DIFF_DQK ** -0.5
    k = rms_norm(k.reshape(B, S, H, 2, DIFF_DQK), k_norm_w)
    v = v.reshape(B, S, H, DIFF_DV)
    f32 = jnp.float32
    lam = (jnp.exp(jnp.sum(lq1.astype(f32) * lk1.astype(f32)))
           - jnp.exp(jnp.sum(lq2.astype(f32) * lk2.astype(f32))) + lambda_init)
    slopes = alibi_slopes(H)
    nq = S // Q_BLOCK
    qb = jnp.moveaxis(q.reshape(B, nq, Q_BLOCK, H, 2, DIFF_DQK), 1, 0)
    k_pos = jnp.arange(S)

    def block(args):
        qi, idx = args
        s = jnp.einsum('bqhcd,bkhcd->bhcqk', qi, k).astype(f32)
        q_pos = idx * Q_BLOCK + jnp.arange(Q_BLOCK)
        dist = q_pos[:, None] - k_pos[None, :]
        s = s - slopes[None, :, None, None, None] * dist.astype(f32)
        s = jnp.where(dist >= 0, s, -jnp.inf)
        p = jax.nn.softmax(s, axis=-1)
        w = p[:, :, 0] - lam * p[:, :, 1]
        return jnp.einsum('bhqk,bkhv->bqhv', w.astype(v.dtype), v)

    o = lax.map(block, (qb, jnp.arange(nq)))
    o = jnp.moveaxis(o, 0, 1).reshape(B, S, H, DIFF_DV)
    o = rms_norm(o, out_norm_w) * (1.0 - lambda_init)
    return o.reshape(B, S, H * DIFF_DV)


def rglru_mixer(x, conv_w, conv_b, w_r, b_r, w_i, b_i, lam):
    B, S, Wd = x.shape
    f32 = jnp.float32
    xc = lax.conv_general_dilated(
        x, conv_w[:, None, :].astype(x.dtype), window_strides=(1,),
        padding=[(CONV_WIDTH - 1, 0)], dimension_numbers=('NWC', 'WIO', 'NWC'),
        feature_group_count=Wd) + conv_b
    xf = xc.astype(f32)
    xh = xf.reshape(B, S, LRU_BLOCKS, LRU_BLOCK_DIM)
    r = jax.nn.sigmoid(jnp.einsum('bsni,nij->bsnj', xh, w_r.astype(f32)).reshape(B, S, Wd) + b_r.astype(f32))
    i = jax.nn.sigmoid(jnp.einsum('bsni,nij->bsnj', xh, w_i.astype(f32)).reshape(B, S, Wd) + b_i.astype(f32))
    log_a = -LRU_C * r * jax.nn.softplus(-lam.astype(f32))
    a = jnp.exp(log_a)
    u = jnp.sqrt(-jnp.expm1(2.0 * log_a)) * (i * xf)

    def combine(c1, c2):
        a1, b1 = c1
        a2, b2 = c2
        return a1 * a2, a2 * b1 + b2

    _, h = lax.associative_scan(combine, (a, u), axis=1)
    return h.astype(x.dtype)


def setup_inputs(seed: int = 0) -> dict:
    key = jax.random.key(seed)
    ks = jax.random.split(key, 24)

    def nrm(k, shape, scale):
        return jax.random.normal(k, shape, jnp.float32) * scale

    u = jax.random.uniform(ks[23], (DEPTH, LRU_WIDTH), jnp.float32, 0.9, 0.999)
    p = u ** (1.0 / LRU_C)
    return {
        'x': nrm(ks[0], (BATCH, SEQ, D_MODEL), 1.0),
        'norm_w': 1.0 + nrm(ks[1], (DEPTH, D_MODEL), 0.02),
        'w_in': nrm(ks[2], (DEPTH, D_MODEL, D_IN), D_MODEL ** -0.5),
        'w_out': nrm(ks[3], (DEPTH, D_MIX, D_MODEL), D_MIX ** -0.5),
        'gla_w_up': nrm(ks[4], (DEPTH, GLA_RANK, GLA_HEADS * GLA_DK), GLA_RANK ** -0.5),
        'gla_b_up': nrm(ks[5], (DEPTH, GLA_HEADS * GLA_DK), 0.1),
        'gla_norm_w': 1.0 + nrm(ks[6], (DEPTH, GLA_DV), 0.02),
        'swa_q_norm': 1.0 + nrm(ks[7], (DEPTH, HEAD_DIM), 0.02),
        'swa_k_norm': 1.0 + nrm(ks[8], (DEPTH, HEAD_DIM), 0.02),
        'swa_sinks': nrm(ks[9], (DEPTH, SWA_HEADS), 0.5),
        'diff_q_norm': 1.0 + nrm(ks[10], (DEPTH, DIFF_DQK), 0.02),
        'diff_k_norm': 1.0 + nrm(ks[11], (DEPTH, DIFF_DQK), 0.02),
        'diff_lq1': nrm(ks[12], (DEPTH, DIFF_DQK), 0.1),
        'diff_lk1': nrm(ks[13], (DEPTH, DIFF_DQK), 0.1),
        'diff_lq2': nrm(ks[14], (DEPTH, DIFF_DQK), 0.1),
        'diff_lk2': nrm(ks[15], (DEPTH, DIFF_DQK), 0.1),
        'diff_out_norm': 1.0 + nrm(ks[16], (DEPTH, DIFF_DV), 0.02),
        'lru_conv_w': nrm(ks[17], (DEPTH, CONV_WIDTH, LRU_WIDTH), CONV_WIDTH ** -0.5),
        'lru_conv_b': nrm(ks[18], (DEPTH, LRU_WIDTH), 0.02),
        'lru_w_r': nrm(ks[19], (DEPTH, LRU_BLOCKS, LRU_BLOCK_DIM, LRU_BLOCK_DIM), LRU_BLOCK_DIM ** -0.5),
        'lru_b_r': nrm(ks[20], (DEPTH, LRU_WIDTH), 0.02),
        'lru_w_i': nrm(ks[21], (DEPTH, LRU_BLOCKS, LRU_BLOCK_DIM, LRU_BLOCK_DIM), LRU_BLOCK_DIM ** -0.5),
        'lru_b_i': nrm(ks[22], (DEPTH, LRU_WIDTH), 0.02),
        'lru_lambda': jnp.log(p) - jnp.log1p(-p),
    }


def reference(x, norm_w, w_in, w_out, gla_w_up, gla_b_up, gla_norm_w,
              swa_q_norm, swa_k_norm, swa_sinks,
              diff_q_norm, diff_k_norm, diff_lq1, diff_lk1, diff_lq2, diff_lk2, diff_out_norm,
              lru_conv_w, lru_conv_b, lru_w_r, lru_b_r, lru_w_i, lru_b_i, lru_lambda):
    for layer in range(DEPTH):
        h = rms_norm(x, norm_w[layer])
        proj = jnp.einsum('bsd,de->bse', h, w_in[layer])
        (g_q, g_k, g_v, g_a, s_q, s_k, s_v, d_q, d_k, d_v, r_x, gate) = split_cols(proj, IN_SPLITS)
        y_gla = gla_mixer(g_q, g_k, g_v, g_a, gla_w_up[layer], gla_b_up[layer], gla_norm_w[layer])
        y_swa = swa_mixer(s_q, s_k, s_v, swa_q_norm[layer], swa_k_norm[layer], swa_sinks[layer])
        lambda_init = 0.8 - 0.6 * math.exp(-0.3 * layer)
        y_diff = diff_mixer(d_q, d_k, d_v, diff_q_norm[layer], diff_k_norm[layer],
                            diff_lq1[layer], diff_lk1[layer], diff_lq2[layer], diff_lk2[layer],
                            diff_out_norm[layer], lambda_init)
        y_lru = rglru_mixer(r_x, lru_conv_w[layer], lru_conv_b[layer], lru_w_r[layer], lru_b_r[layer],
                            lru_w_i[layer], lru_b_i[layer], lru_lambda[layer])
        y = jnp.concatenate([y_gla, y_swa, y_diff, y_lru], axis=-1)
        y = y * jax.nn.silu(gate)
        x = x + jnp.einsum('bse,ed->bsd', y, w_out[layer])
    return x
```

```cpp
#include <hip/hip_runtime.h>
#include <hip/hip_cooperative_groups.h>
#include <cstdio>
namespace cg = cooperative_groups;
namespace pg8 {
#define PG8_LAS __attribute__((address_space(3)))
typedef unsigned short bf16_t;
typedef short bf16x8 __attribute__((ext_vector_type(8)));
typedef float f32x4 __attribute__((ext_vector_type(4)));
typedef unsigned u32x4 __attribute__((ext_vector_type(4)));
constexpr int BM = 256, BK = 64, HALF = 128, HTB = HALF * BK * 2  , STAGE_BYTES = 8 * HTB, NXCD = 8, WGM = 4;

__host__ __device__ __forceinline__ int lds_byte(int r, int c) { const int st = (r >> 4) * 2 + (c >> 5), rr = r & 15, cc = c & 31, ob = rr * 64 + cc * 2; return st * 1024 + (ob ^ (((ob >> 9) & 1) << 5)); }
__host__ __device__ __forceinline__ void stage_rc(int b, int& R, int& C) { const int st = b / 1024, sb = b % 1024, swz = sb ^ (((sb >> 9) & 1) << 5); R = (st >> 1) * 16 + swz / 64; C = (st & 1) * 32 + (swz % 64) / 2; }
__host__ __device__ __forceinline__ int perm32(int rho) { const int n = rho >> 4, i = rho & 15; return 8 * (i >> 2) + 4 * n + (i & 3); }

struct Unit { int pm, pn; };
struct Gemm { const bf16_t* A; const bf16_t* Bt; int M, N, K; };

struct StaticOrder {
    int nM, nN, nwg, G, c;
    __host__ __device__ void init(int M, int N, int G_, int c_) { nM = M / BM; nN = N / BM; nwg = nM * nN; G = G_; c = c_; }
    __host__ __device__ bool next(int i, Unit& u) const {
        const long L = (long)i * G + c; if (L >= nwg) return false;
        int wgid = (int)L; { const int q = nwg / NXCD, r = nwg % NXCD, xcd = wgid % NXCD, off = wgid / NXCD; wgid = (xcd < r ? xcd * (q + 1) : r * (q + 1) + (xcd - r) * q) + off; }
        const int nig = WGM * nN, gid = wgid / nig, fm = gid * WGM, gsz = (nM - fm) < WGM ? (nM - fm) : WGM;
        u.pm = fm + ((wgid % nig) % gsz); u.pn = (wgid % nig) / gsz; return true;
    }
    __device__ __forceinline__ void a_ready(const Unit&) const {}
    __device__ __forceinline__ void done(const Unit&) const {}
};
__device__ __forceinline__ unsigned cvt_pk_bf16(float lo, float hi) { unsigned r; asm volatile("v_cvt_pk_bf16_f32 %0, %1, %2" : "=v"(r) : "v"(lo), "v"(hi)); return r; }
typedef float f32x2 __attribute__((ext_vector_type(2)));
template <class Epi, class Sched, bool ALIGN_EPI = false, bool SP2 = false>
__device__ __forceinline__ void gemm_phase(PG8_LAS unsigned char* lds, const Gemm g, const Sched& S, const Epi& E) {
    int tid_ = threadIdx.x; asm volatile("" : "+v"(tid_)); const int tid = tid_, wid = __builtin_amdgcn_readfirstlane(tid >> 6), lane = tid & 63, wr = wid >> 2, wc = wid & 3, fr = lane & 15, fq = lane >> 4;
    const int K = g.K, nt = K / BK;
    unsigned voffA[2], voffB[2];
#pragma unroll
    for (int i = 0; i < 2; ++i) { int R, C; stage_rc(tid * 16 + i * 8192, R, C); const int Rb = Epi::PERM ? ((R & ~31) + perm32(R & 31)) : R;
        voffA[i] = (unsigned)(R * K + C) * 2u; voffB[i] = (unsigned)(Rb * K + C) * 2u; }
    const size_t kstep = (size_t)(BK * 2);
    const size_t hstep = (size_t)HALF * K * 2;
    const size_t tstep = 2 * hstep;
    const unsigned ldsw = (unsigned)wid * 1024u;
    const int aoff = lds_byte(wr * 64 + fr, fq * 8), boff = lds_byte(wc * 32 + fr, fq * 8);
#define PG8_SA(b, h) (((b) * 2 + (h)) * HTB)
#define PG8_SB(b, h) ((4 + (b) * 2 + (h)) * HTB)
#define PG8_STAGE(bufoff, gbase, voff) do { _Pragma("unroll") for (int _i = 0; _i < 2; ++_i) \
        __builtin_amdgcn_global_load_lds((const unsigned*)((const char*)(gbase) + (voff)[_i]), (PG8_LAS unsigned*)(lds + (bufoff) + ldsw + _i * 8192), 16, 0, 0); } while (0)
#define PG8_LDA(dst, b, h) do { _Pragma("unroll") for (int m = 0; m < 4; ++m) _Pragma("unroll") for (int k = 0; k < 2; ++k) dst[m][k] = *(const PG8_LAS bf16x8*)(lds + PG8_SA(b, h) + aoff + m * 2048 + k * 1024); } while (0)
#define PG8_LDB(dst, b, h) do { _Pragma("unroll") for (int n = 0; n < 2; ++n) _Pragma("unroll") for (int k = 0; k < 2; ++k) dst[n][k] = *(const PG8_LAS bf16x8*)(lds + PG8_SB(b, h) + boff + n * 2048 + k * 1024); } while (0)
#define PG8_MMA(ai, bj, At, Bt) do { __builtin_amdgcn_s_setprio(1); _Pragma("unroll") for (int m = 0; m < 4; ++m) _Pragma("unroll") for (int n = 0; n < 2; ++n) _Pragma("unroll") for (int k = 0; k < 2; ++k) \
        acc[ai][bj][m][n] = __builtin_amdgcn_mfma_f32_16x16x32_bf16(Bt[n][k], At[m][k], acc[ai][bj][m][n], 0, 0, 0); __builtin_amdgcn_s_setprio(0); } while (0)
#define PG8_WAIT_V(n) asm volatile("s_waitcnt vmcnt(" #n ")" ::: "memory")
#define PG8_WAIT_L(n) asm volatile("s_waitcnt lgkmcnt(" #n ")" ::: "memory")
#define PG8_BAR __builtin_amdgcn_s_barrier()
#define PG8_SCHED __builtin_amdgcn_sched_barrier(0)
    Unit cur, nxt; int ui = 0;
    if (!S.next(0, cur)) return;
    f32x4 acc[2][2][4][2];
    E.init(acc, cur, wr, wc, fr, fq);
    bf16x8 At[4][2], B0[2][2], B1[2][2];
    const char* cA = (const char*)g.A + (size_t)cur.pm * tstep; const char* cB = (const char*)g.Bt + (size_t)cur.pn * tstep;
    S.a_ready(cur);
    if constexpr (SP2) {
        PG8_STAGE(PG8_SB(0, 0), cB, voffB); PG8_STAGE(PG8_SB(0, 1), cB + hstep, voffB); PG8_STAGE(PG8_SA(0, 0), cA, voffA); PG8_STAGE(PG8_SA(0, 1), cA + hstep, voffA);
        if (wr == 1) PG8_BAR;
        PG8_WAIT_V(2); PG8_BAR;
        PG8_STAGE(PG8_SB(1, 0), cB + kstep, voffB); PG8_STAGE(PG8_SA(1, 0), cA + kstep, voffA); PG8_STAGE(PG8_SB(1, 1), cB + hstep + kstep, voffB);
        PG8_WAIT_V(6); PG8_BAR;
    } else {
        PG8_STAGE(PG8_SB(0, 0), cB, voffB); PG8_STAGE(PG8_SA(0, 0), cA, voffA); PG8_STAGE(PG8_SB(0, 1), cB + hstep, voffB); PG8_STAGE(PG8_SA(0, 1), cA + hstep, voffA);
        if (wr == 1) PG8_BAR;
        PG8_WAIT_V(4); PG8_BAR;
        PG8_STAGE(PG8_SB(1, 0), cB + kstep, voffB); PG8_STAGE(PG8_SA(1, 0), cA + kstep, voffA); PG8_STAGE(PG8_SB(1, 1), cB + hstep + kstep, voffB);
        PG8_WAIT_V(6); PG8_BAR;
    }
    for (;;) {
        const bool has_next = S.next(ui + 1, nxt);
        const char* nA = has_next ? (const char*)g.A + (size_t)nxt.pm * tstep : cA; const char* nB = has_next ? (const char*)g.Bt + (size_t)nxt.pn * tstep : cB;
        for (int t = 0; t < nt; t += 2) {
            const bool last = (t == nt - 2);
            const char* a1 = cA + (size_t)(t + 1) * kstep;
            const char* a2 = last ? nA : cA + (size_t)(t + 2) * kstep; const char* b2 = last ? nB : cB + (size_t)(t + 2) * kstep;
            const char* a3 = a2 + kstep; const char* b3 = b2 + kstep;
            if (last && has_next) S.a_ready(nxt);
            if constexpr (SP2) {
            PG8_LDB(B0, 0, 0); PG8_LDB(B1, 0, 1); PG8_SCHED; PG8_LDA(At, 0, 0); PG8_STAGE(PG8_SA(1, 1), a1 + hstep, voffA);
            PG8_WAIT_V(8); PG8_WAIT_L(0); PG8_BAR; PG8_MMA(0, 0, At, B0); PG8_MMA(0, 1, At, B1); PG8_BAR; PG8_SCHED;
            PG8_LDA(At, 0, 1); PG8_STAGE(PG8_SB(0, 0), b2, voffB); PG8_STAGE(PG8_SB(0, 1), b2 + hstep, voffB); PG8_STAGE(PG8_SA(0, 0), a2, voffA);
            PG8_WAIT_V(8); PG8_WAIT_L(0); PG8_BAR; PG8_MMA(1, 0, At, B0); PG8_MMA(1, 1, At, B1); PG8_BAR; PG8_SCHED;
            PG8_LDB(B0, 1, 0); PG8_LDB(B1, 1, 1); PG8_SCHED; PG8_LDA(At, 1, 0); PG8_STAGE(PG8_SA(0, 1), a2 + hstep, voffA);
            PG8_WAIT_V(8); PG8_WAIT_L(0); PG8_BAR; PG8_MMA(0, 0, At, B0); PG8_MMA(0, 1, At, B1); PG8_BAR; PG8_SCHED;
            PG8_LDA(At, 1, 1); PG8_STAGE(PG8_SB(1, 0), b3, voffB); PG8_STAGE(PG8_SB(1, 1), b3 + hstep, voffB); PG8_STAGE(PG8_SA(1, 0), a3, voffA);
            PG8_WAIT_V(8); PG8_WAIT_L(0); PG8_BAR; PG8_MMA(1, 0, At, B0); PG8_MMA(1, 1, At, B1); PG8_BAR; PG8_SCHED;
            } else {
            PG8_LDB(B0, 0, 0); PG8_SCHED; PG8_LDA(At, 0, 0); PG8_STAGE(PG8_SA(1, 1), a1 + hstep, voffA);
            PG8_WAIT_L(8); PG8_BAR; PG8_WAIT_L(0); PG8_MMA(0, 0, At, B0); PG8_BAR; PG8_SCHED;
            PG8_LDB(B1, 0, 1); PG8_STAGE(PG8_SB(0, 0), b2, voffB);
            PG8_BAR; PG8_WAIT_L(0); PG8_MMA(0, 1, At, B1); PG8_BAR;
            PG8_LDA(At, 0, 1); PG8_STAGE(PG8_SA(0, 0), a2, voffA);
            PG8_BAR; PG8_WAIT_L(0); PG8_MMA(1, 0, At, B0); PG8_BAR; PG8_SCHED;
            PG8_STAGE(PG8_SB(0, 1), b2 + hstep, voffB);
            PG8_WAIT_V(6); PG8_BAR; PG8_MMA(1, 1, At, B1); PG8_BAR;
            PG8_LDB(B0, 1, 0); PG8_SCHED; PG8_LDA(At, 1, 0); PG8_STAGE(PG8_SA(0, 1), a2 + hstep, voffA);
            PG8_WAIT_L(8); PG8_BAR; PG8_WAIT_L(0); PG8_MMA(0, 0, At, B0); PG8_BAR; PG8_SCHED;
            PG8_LDB(B1, 1, 1); PG8_STAGE(PG8_SB(1, 0), b3, voffB);
            PG8_BAR; PG8_WAIT_L(0); PG8_MMA(0, 1, At, B1); PG8_BAR;
            PG8_LDA(At, 1, 1); PG8_STAGE(PG8_SA(1, 0), a3, voffA);
            PG8_BAR; PG8_WAIT_L(0); PG8_MMA(1, 0, At, B0); PG8_BAR; PG8_SCHED;
            PG8_STAGE(PG8_SB(1, 1), b3 + hstep, voffB);
            PG8_WAIT_V(6); PG8_BAR; PG8_MMA(1, 1, At, B1); PG8_BAR;
            }
        }
        if constexpr (ALIGN_EPI) { if (wr == 0) PG8_BAR; }
        if constexpr (!Epi::AFTER_DRAIN) { E(acc, cur, wr, wc, fr, fq); S.done(cur); }
        if (!has_next) break;
        E.init(acc, nxt, wr, wc, fr, fq);
        cur = nxt; cA = nA; cB = nB; ++ui;
        if constexpr (ALIGN_EPI) { if (wr == 1) PG8_BAR; }
    }
    PG8_WAIT_V(0);
    if constexpr (!ALIGN_EPI) { if (wr == 0) PG8_BAR; }
    PG8_BAR;
    if constexpr (Epi::AFTER_DRAIN) { E.fused(acc, cur, wr, wc, fr, fq, lds, wid, lane); S.done(cur); }
#undef PG8_SA
#undef PG8_SB
#undef PG8_STAGE
#undef PG8_LDA
#undef PG8_LDB
#undef PG8_MMA
#undef PG8_WAIT_V
#undef PG8_WAIT_L
#undef PG8_BAR
#undef PG8_SCHED
}
}

#define LAS __attribute__((address_space(3)))
typedef unsigned short bf16_t;
typedef float f32x4 __attribute__((ext_vector_type(4)));
typedef unsigned u32x4 __attribute__((ext_vector_type(4)));
constexpr int TOK = 8192, SEQ = 2048, DM = 4096, NIN = 11792, NPAD = 12032;
constexpr int C_GQ = 0, C_GK = 512, C_GV = 1024, C_SQ = 2048, C_SK = 3072, C_SV = 3328, C_DQ = 3584, C_DK = 4608, C_DV = 5632, C_RX = 6656, C_GATE = 7680, C_GA = 11776;
constexpr float EPS = 1e-6f;
constexpr int LDS_BYTES = 152 * 1024;
constexpr int NPH = 10;
constexpr int XCD_BAR_WORDS_C = 3456;
constexpr size_t WS_WIN = 0;
constexpr size_t SZ_WIN = (size_t)NPAD * DM * 2;
constexpr size_t WS_WOUT = WS_WIN + 2 * SZ_WIN;
constexpr size_t SZ_WOUT = (size_t)DM * DM * 2;
constexpr size_t WS_H = WS_WOUT + 2 * SZ_WOUT;
constexpr size_t WS_PROJ = WS_H + (size_t)TOK * DM * 2;
constexpr size_t WS_Y = WS_PROJ + (size_t)TOK * NPAD * 2;
constexpr size_t WS_X1 = WS_Y + (size_t)TOK * DM * 2;
constexpr size_t WS_LA = WS_X1 + (size_t)TOK * DM * 4;
constexpr size_t WS_LU = WS_LA + (size_t)TOK * 1024 * 4;
constexpr size_t WS_GP = WS_LU + (size_t)TOK * 1024 * 4;
constexpr size_t WS_END = WS_GP + (size_t)1024 * 41216;

struct Params { const float* in[24]; float* out; unsigned char* ws; int ph_lo, ph_hi; };

__device__ __forceinline__ int tid_opaque() { int t = threadIdx.x; asm volatile("" : "+v"(t)); return t; }
__device__ __forceinline__ float bf2f(bf16_t b) { return __uint_as_float(((unsigned)b) << 16); }
typedef __bf16 bf16v2_t __attribute__((ext_vector_type(2)));
typedef float f32v2_t __attribute__((ext_vector_type(2)));
__device__ __forceinline__ unsigned cvt2(float lo, float hi) { f32v2_t f = {lo, hi}; bf16v2_t b = __builtin_convertvector(f, bf16v2_t); return __builtin_bit_cast(unsigned, b); }
__device__ __forceinline__ bf16_t f2bf(float f) { return (bf16_t)(cvt2(f, f) & 0xffffu); }
__device__ __forceinline__ unsigned pk2(float lo, float hi) { return cvt2(lo, hi); }
__device__ __forceinline__ float wsum(float v) { for (int o = 32; o; o >>= 1) v += __shfl_xor(v, o); return v; }
__device__ __forceinline__ float wmax(float v) { for (int o = 32; o; o >>= 1) v = fmaxf(v, __shfl_xor(v, o)); return v; }
__device__ __forceinline__ float siluf(float x) { return x / (1.f + __expf(-x)); }
__device__ __forceinline__ float sigmf(float x) { return 1.f / (1.f + __expf(-x)); }
__device__ __forceinline__ void unpack8(const uint4 u, float* f) {
    f[0] = __uint_as_float(u.x << 16); f[1] = __uint_as_float(u.x & 0xffff0000u); f[2] = __uint_as_float(u.y << 16); f[3] = __uint_as_float(u.y & 0xffff0000u);
    f[4] = __uint_as_float(u.z << 16); f[5] = __uint_as_float(u.z & 0xffff0000u); f[6] = __uint_as_float(u.w << 16); f[7] = __uint_as_float(u.w & 0xffff0000u);
}

struct EpiProj {
    static constexpr bool PERM = true, AFTER_DRAIN = false;
    bf16_t* O;
    __device__ __forceinline__ void init(f32x4 (&acc)[2][2][4][2], const pg8::Unit&, int, int, int, int) const {
#pragma unroll
        for (int a = 0; a < 2; ++a)
#pragma unroll
            for (int b = 0; b < 2; ++b)
#pragma unroll
                for (int m = 0; m < 4; ++m)
#pragma unroll
                    for (int n = 0; n < 2; ++n) acc[a][b][m][n] = (f32x4){0.f, 0.f, 0.f, 0.f};
    }
    __device__ __forceinline__ void operator()(const f32x4 (&acc)[2][2][4][2], const pg8::Unit& u, int wr, int wc, int fr, int fq) const {
        const int row0 = u.pm * 256 + wr * 64 + fr, col0 = u.pn * 256 + wc * 32 + 8 * fq;
        const bool act = (u.pn >= 30 && u.pn < 46);
#pragma unroll
        for (int ai = 0; ai < 2; ++ai)
#pragma unroll
            for (int m = 0; m < 4; ++m) { bf16_t* rowp = O + (size_t)(row0 + ai * 128 + m * 16) * NPAD + col0;
#pragma unroll
                for (int bj = 0; bj < 2; ++bj) { f32x4 v0 = acc[ai][bj][m][0], v1 = acc[ai][bj][m][1];
                    if (act) {
#pragma unroll
                        for (int j = 0; j < 4; ++j) { v0[j] = v0[j] * __builtin_amdgcn_rcpf(1.f + __builtin_amdgcn_exp2f(-1.4426950408889634f * v0[j])); v1[j] = v1[j] * __builtin_amdgcn_rcpf(1.f + __builtin_amdgcn_exp2f(-1.4426950408889634f * v1[j])); } }
                    u32x4 w; w.x = pg8::cvt_pk_bf16(v0[0], v0[1]); w.y = pg8::cvt_pk_bf16(v0[2], v0[3]); w.z = pg8::cvt_pk_bf16(v1[0], v1[1]); w.w = pg8::cvt_pk_bf16(v1[2], v1[3]);
                    *(u32x4*)(rowp + bj * 128) = w; } }
    }
};
struct EpiRes {
    static constexpr bool PERM = false, AFTER_DRAIN = false;
    const float* R; float* C;
    __device__ __forceinline__ void init(f32x4 (&acc)[2][2][4][2], const pg8::Unit& u, int wr, int wc, int fr, int fq) const {
        const int row0 = u.pm * 256 + wr * 64 + fr, col0 = u.pn * 256 + wc * 32 + 4 * fq;
#pragma unroll
        for (int ai = 0; ai < 2; ++ai)
#pragma unroll
            for (int m = 0; m < 4; ++m) { const size_t off = (size_t)(row0 + ai * 128 + m * 16) * DM + col0;
#pragma unroll
                for (int bj = 0; bj < 2; ++bj)
#pragma unroll
                    for (int n = 0; n < 2; ++n) acc[ai][bj][m][n] = *(const f32x4*)(R + off + bj * 128 + n * 16); }
    }
    __device__ __forceinline__ void operator()(const f32x4 (&acc)[2][2][4][2], const pg8::Unit& u, int wr, int wc, int fr, int fq) const {
        const int row0 = u.pm * 256 + wr * 64 + fr, col0 = u.pn * 256 + wc * 32 + 4 * fq;
#pragma unroll
        for (int ai = 0; ai < 2; ++ai)
#pragma unroll
            for (int m = 0; m < 4; ++m) { const size_t off = (size_t)(row0 + ai * 128 + m * 16) * DM + col0;
#pragma unroll
                for (int bj = 0; bj < 2; ++bj)
#pragma unroll
                    for (int n = 0; n < 2; ++n) *(f32x4*)(C + off + bj * 128 + n * 16) = acc[ai][bj][m][n]; }
    }
};

constexpr int NDEF = 1536;
constexpr int HOST0 = 1024;
constexpr int PREP_TILES = 6016;
constexpr int DHOST_WIN = 6016 - HOST0, DHOST = DHOST_WIN + 2048 - NDEF;
struct TrTile { const float* W; bf16_t* WT; int ld, nt, kt; bool permute; };
__device__ __forceinline__ TrTile tr_tile(const Params& p, int t) {
    TrTile r; int q = t; const int l = 0;
    r.W = p.in[2] + (size_t)l * DM * NIN; r.WT = (bf16_t*)(p.ws + WS_WIN + l * SZ_WIN); r.ld = NIN; r.permute = true;
    r.nt = q >> 5; r.kt = q & 31; return r;
}
__device__ __forceinline__ void tr_load(const TrTile& T, int tid, f32x4 (&v)[4]) {
#pragma unroll
    for (int i = 0; i < 2; ++i) {
        const int idx = tid + 512 * i, kp = idx >> 4, c4 = idx & 15;
        const int nd = T.nt * 64 + c4 * 4;
        int ns = nd;
        if (T.permute) { ns = (nd < 2048) ? nd : ((nd < 11776) ? nd + 16 : ((nd < 11792) ? nd - 11776 + 2048 : -1)); }
        v[2 * i] = (f32x4){0.f, 0.f, 0.f, 0.f}; v[2 * i + 1] = v[2 * i];
        if (ns >= 0) { const float* q = T.W + (size_t)(T.kt * 128 + 2 * kp) * T.ld + ns; v[2 * i] = __builtin_nontemporal_load((const f32x4*)q); v[2 * i + 1] = __builtin_nontemporal_load((const f32x4*)(q + T.ld)); }
    }
}
__device__ __forceinline__ void tr_stage(int tid, const f32x4 (&v)[4], unsigned* lds) {
#pragma unroll
    for (int i = 0; i < 2; ++i) {
        const int idx = tid + 512 * i, kp = idx >> 4, c4 = idx & 15;
        const f32x4 a = v[2 * i], b = v[2 * i + 1];
        unsigned* d = lds + kp * 65 + c4 * 4;
        d[0] = pk2(a[0], b[0]); d[1] = pk2(a[1], b[1]); d[2] = pk2(a[2], b[2]); d[3] = pk2(a[3], b[3]);
    }
}
__device__ __forceinline__ void tr_flush(const TrTile& T, int tid, const unsigned* lds) {
#pragma unroll
    for (int i = 0; i < 2; ++i) {
        const int idx = tid + 512 * i, kc = idx & 15, n = idx >> 4;
        uint4 o; o.x = lds[(kc * 4 + 0) * 65 + n]; o.y = lds[(kc * 4 + 1) * 65 + n]; o.z = lds[(kc * 4 + 2) * 65 + n]; o.w = lds[(kc * 4 + 3) * 65 + n];
        *(uint4*)(T.WT + (size_t)(T.nt * 64 + n) * DM + T.kt * 128 + kc * 8) = o;
    }
}
__device__ __forceinline__ void tr_store(const TrTile& T, int tid, const f32x4 (&v)[4], unsigned* lds) {
#pragma unroll
    for (int i = 0; i < 2; ++i) {
        const int idx = tid + 512 * i, kp = idx >> 4, c4 = idx & 15;
        const f32x4 a = v[2 * i], b = v[2 * i + 1];
        unsigned* d = lds + kp * 65 + c4 * 4;
        d[0] = pk2(a[0], b[0]); d[1] = pk2(a[1], b[1]); d[2] = pk2(a[2], b[2]); d[3] = pk2(a[3], b[3]);
    }
    __syncthreads();
#pragma unroll
    for (int i = 0; i < 2; ++i) {
        const int idx = tid + 512 * i, kc = idx & 15, n = idx >> 4;
        uint4 o; o.x = lds[(kc * 4 + 0) * 65 + n]; o.y = lds[(kc * 4 + 1) * 65 + n]; o.z = lds[(kc * 4 + 2) * 65 + n]; o.w = lds[(kc * 4 + 3) * 65 + n];
        *(uint4*)(T.WT + (size_t)(T.nt * 64 + n) * DM + T.kt * 128 + kc * 8) = o;
    }
    __syncthreads();
}

__device__ __forceinline__ void rmsnorm_rows(const float* __restrict__ X, const float* __restrict__ w, bf16_t* __restrict__ H) {
    const int tid = tid_opaque(), lane = tid & 63, wave = tid >> 6;
    for (int row = blockIdx.x * 8 + wave; row < TOK; row += gridDim.x * 8) {
        const float4* xp = (const float4*)(X + (size_t)row * DM);
        float4 v[16]; float ss = 0.f;
#pragma unroll
        for (int i = 0; i < 16; ++i) { v[i] = xp[lane + 64 * i]; ss += v[i].x * v[i].x + v[i].y * v[i].y + v[i].z * v[i].z + v[i].w * v[i].w; }
        ss = wsum(ss);
        const float rstd = rsqrtf(ss * (1.f / DM) + EPS);
#pragma unroll
        for (int i = 0; i < 16; ++i) { const float4 g = ((const float4*)w)[lane + 64 * i];
            uint2 o; o.x = pk2(v[i].x * rstd * g.x, v[i].y * rstd * g.y); o.y = pk2(v[i].z * rstd * g.z, v[i].w * rstd * g.w);
            *(uint2*)(H + (size_t)row * DM + 4 * (lane + 64 * i)) = o; }
    }
}

__device__ __forceinline__ void phase_prep(const Params& p, unsigned char* lds) {
    { const int tid = tid_opaque();
      f32x4 va[4], vb[4];
      int t = blockIdx.x;
      TrTile T = tr_tile(p, t < PREP_TILES ? t : 0);
      if (t < PREP_TILES) tr_load(T, tid, va);
#pragma unroll 1
      while (t < PREP_TILES) {
          const int tn = t + gridDim.x;
          const TrTile Tn = tr_tile(p, tn < PREP_TILES ? tn : 0);
          if (tn < PREP_TILES) tr_load(Tn, tid, vb);
          tr_store(T, tid, va, (unsigned*)lds);
#pragma unroll
          for (int i = 0; i < 4; ++i) va[i] = vb[i];
          T = Tn; t = tn;
      } }
    rmsnorm_rows(p.in[0], p.in[1], (bf16_t*)(p.ws + WS_H));
}

__device__ __forceinline__ bool host_tile(const Params& p, int l, int hidx, TrTile& T) {
    if (l == 0) { if (hidx >= HOST0) return false;
        T.W = p.in[2] + (size_t)DM * NIN; T.WT = (bf16_t*)(p.ws + WS_WIN + SZ_WIN); T.ld = NIN; T.permute = true; T.nt = hidx >> 5; T.kt = hidx & 31; return true; }
    const int r = NDEF + hidx; if (r >= 2048) return false;
    T.W = p.in[3] + (size_t)DM * DM; T.WT = (bf16_t*)(p.ws + WS_WOUT + SZ_WOUT); T.ld = DM; T.permute = false; T.nt = r >> 5; T.kt = r & 31; return true;
}
__device__ __forceinline__ bool diff_host_tile(const Params& p, int l, int s, TrTile& T) {
    if (l != 0 || s >= DHOST) return false;
    if (s < DHOST_WIN) { const int q = HOST0 + s; T.W = p.in[2] + (size_t)DM * NIN; T.WT = (bf16_t*)(p.ws + WS_WIN + SZ_WIN); T.ld = NIN; T.permute = true; T.nt = q >> 5; T.kt = q & 31; return true; }
    const int r = NDEF + (s - DHOST_WIN); T.W = p.in[3]; T.WT = (bf16_t*)(p.ws + WS_WOUT); T.ld = DM; T.permute = false; T.nt = r >> 5; T.kt = r & 31; return true;
}
__device__ __forceinline__ TrTile tr_tile_wout(const Params& p, int l, int r) {
    TrTile T; T.W = p.in[3] + (size_t)l * DM * DM; T.WT = (bf16_t*)(p.ws + WS_WOUT + l * SZ_WOUT); T.ld = DM; T.permute = false; T.nt = r >> 5; T.kt = r & 31; return T;
}
__device__ __forceinline__ void convert_deferred(const Params& p, int l, int rank, int nidle, unsigned char* lds) {
    const int tid = tid_opaque();
    f32x4 va[4], vb[4];
    int r = rank;
    TrTile T = tr_tile_wout(p, l, r < NDEF ? r : 0);
    if (r < NDEF) tr_load(T, tid, va);
#pragma unroll 1
    while (r < NDEF) {
        const int rn = r + nidle;
        const TrTile Tn = tr_tile_wout(p, l, rn < NDEF ? rn : 0);
        if (rn < NDEF) tr_load(Tn, tid, vb);
        tr_store(T, tid, va, (unsigned*)lds);
#pragma unroll
        for (int i = 0; i < 4; ++i) va[i] = vb[i];
        T = Tn; r = rn;
    }
}

struct LayerW {
    const float *gla_w_up, *gla_b_up, *gla_nw, *swa_qn, *swa_kn, *swa_sinks, *dq_n, *dk_n, *lq1, *lk1, *lq2, *lk2, *d_on, *conv_w, *conv_b, *w_r, *b_r, *w_i, *b_i, *lam;
    float lambda_init;
};
__device__ __forceinline__ LayerW layer_w(const Params& p, int l) {
    LayerW w;
    w.gla_w_up = p.in[4] + l * 16 * 512; w.gla_b_up = p.in[5] + l * 512; w.gla_nw = p.in[6] + l * 128;
    w.swa_qn = p.in[7] + l * 128; w.swa_kn = p.in[8] + l * 128; w.swa_sinks = p.in[9] + l * 8;
    w.dq_n = p.in[10] + l * 64; w.dk_n = p.in[11] + l * 64; w.lq1 = p.in[12] + l * 64; w.lk1 = p.in[13] + l * 64; w.lq2 = p.in[14] + l * 64; w.lk2 = p.in[15] + l * 64;
    w.d_on = p.in[16] + l * 128; w.conv_w = p.in[17] + l * 4096; w.conv_b = p.in[18] + l * 1024;
    w.w_r = p.in[19] + l * 8 * 128 * 128; w.b_r = p.in[20] + l * 1024; w.w_i = p.in[21] + l * 8 * 128 * 128; w.b_i = p.in[22] + l * 1024; w.lam = p.in[23] + l * 1024;
    w.lambda_init = 0.8f - 0.6f * expf(-0.3f * (float)l);
    return w;
}

__device__ void gla_simple(const bf16_t* __restrict__ P, bf16_t* __restrict__ Y, const LayerW& W, int bh, float* lds) {
    const int b = bh >> 3, h = bh & 7, tid = tid_opaque();
    float* sAl = lds; float* sQ = sAl + 2048; float* sK = sQ + 2048; float* sV = sK + 2048; float* sPo = sV + 4096; float* sW = sPo + 16384;
    __syncthreads();
    for (int i = tid; i < 1024; i += 512) sW[i] = W.gla_w_up[(i >> 6) * 512 + h * 64 + (i & 63)];
    if (tid < 64) sW[1024 + tid] = W.gla_b_up[h * 64 + tid];
    const int v = tid & 127, dg = tid >> 7;
    float s[16];
#pragma unroll
    for (int i = 0; i < 16; ++i) s[i] = 0.f;
    for (int c = 0; c < 64; ++c) {
        __syncthreads();
        const int tok0 = b * SEQ + c * 32;
        for (int i = tid; i < 2048; i += 512) { const int tt = i >> 6, d = i & 63; const bf16_t* row = P + (size_t)(tok0 + tt) * NPAD;
            float lg = sW[1024 + d];
#pragma unroll
            for (int r = 0; r < 16; ++r) lg += bf2f(row[C_GA + r]) * sW[r * 64 + d];
            const float ls = fminf(lg, 0.f) - log1pf(expf(-fabsf(lg)));
            sAl[i] = expf(ls * (1.f / 16.f));
            sQ[i] = bf2f(row[C_GQ + h * 64 + d]) * 0.125f;
            sK[i] = bf2f(row[C_GK + h * 64 + d]); }
        for (int i = tid; i < 4096; i += 512) { const int tt = i >> 7, vv = i & 127; sV[i] = bf2f(P[(size_t)(tok0 + tt) * NPAD + C_GV + h * 128 + vv]); }
        __syncthreads();
        for (int tt = 0; tt < 32; ++tt) {
            const float vt = sV[tt * 128 + v]; float po = 0.f;
#pragma unroll
            for (int i = 0; i < 16; ++i) { const int d = dg * 16 + i; s[i] = sAl[tt * 64 + d] * s[i] + sK[tt * 64 + d] * vt; po += sQ[tt * 64 + d] * s[i]; }
            sPo[(dg * 32 + tt) * 128 + v] = po;
        }
        __syncthreads();
        { const int tt = tid >> 4, v0 = (tid & 15) * 8; float o[8]; float ss = 0.f;
#pragma unroll
            for (int j = 0; j < 8; ++j) { o[j] = sPo[(0 * 32 + tt) * 128 + v0 + j] + sPo[(1 * 32 + tt) * 128 + v0 + j] + sPo[(2 * 32 + tt) * 128 + v0 + j] + sPo[(3 * 32 + tt) * 128 + v0 + j]; ss += o[j] * o[j]; }
            ss += __shfl_xor(ss, 1); ss += __shfl_xor(ss, 2); ss += __shfl_xor(ss, 4); ss += __shfl_xor(ss, 8);
            const float rstd = rsqrtf(ss * (1.f / 128.f) + EPS);
            const bf16_t* gp = P + (size_t)(tok0 + tt) * NPAD + C_GATE + h * 128 + v0;
            bf16_t* yp = Y + (size_t)(tok0 + tt) * DM + h * 128 + v0;
#pragma unroll
            for (int j = 0; j < 8; ++j) yp[j] = f2bf(o[j] * rstd * W.gla_nw[v0 + j] * bf2f(gp[j])); }
    }
    __syncthreads();
}

__device__ void swa_simple_row(const bf16_t* __restrict__ P, bf16_t* __restrict__ Y, const LayerW& W, int row, float* wl) {
    const int lane = tid_opaque() & 63;
    const int bh = row & 31, b = bh >> 3, hq = bh & 7, q = row >> 5, kvh = hq >> 2;
    const size_t tok = (size_t)b * SEQ + q;
    const bf16_t* qp = P + tok * NPAD + C_SQ + hq * 128;
    const float q0 = bf2f(qp[2 * lane]), q1 = bf2f(qp[2 * lane + 1]);
    const float rq = rsqrtf(wsum(q0 * q0 + q1 * q1) * (1.f / 128.f) + EPS) * 0.08838834764831845f;
    __threadfence_block();
    wl[2 * lane] = q0 * rq * W.swa_qn[2 * lane] * W.swa_kn[2 * lane];
    wl[2 * lane + 1] = q1 * rq * W.swa_qn[2 * lane + 1] * W.swa_kn[2 * lane + 1];
    __threadfence_block();
    const float slope = exp2f(-(float)(hq + 1)), sink = W.swa_sinks[hq];
    float sc[2];
#pragma unroll
    for (int i = 0; i < 2; ++i) {
        const int j = q - 127 + lane + 64 * i;
        sc[i] = -INFINITY;
        if (j >= 0) { const uint4* kp = (const uint4*)(P + ((size_t)b * SEQ + j) * NPAD + C_SK + kvh * 128);
            float dot = 0.f, ssk = 0.f;
            for (int c = 0; c < 16; ++c) { float f[8]; unpack8(kp[c], f);
#pragma unroll
                for (int e = 0; e < 8; ++e) { dot += wl[c * 8 + e] * f[e]; ssk += f[e] * f[e]; } }
            sc[i] = dot * rsqrtf(ssk * (1.f / 128.f) + EPS) - slope * (float)(q - j); }
    }
    const float m = fmaxf(wmax(fmaxf(sc[0], sc[1])), sink);
    const float p0 = (sc[0] == -INFINITY) ? 0.f : __expf(sc[0] - m), p1 = (sc[1] == -INFINITY) ? 0.f : __expf(sc[1] - m);
    const float inv = 1.f / (wsum(p0 + p1) + __expf(sink - m));
    wl[128 + lane] = p0 * inv; wl[192 + lane] = p1 * inv;
    __threadfence_block();
    float o0 = 0.f, o1 = 0.f;
    for (int jj = 0; jj < 128; ++jj) { const int j = q - 127 + jj; if (j < 0) continue;
        const unsigned vv = *(const unsigned*)(P + ((size_t)b * SEQ + j) * NPAD + C_SV + kvh * 128 + 2 * lane);
        const float pj = wl[128 + jj]; o0 += pj * __uint_as_float(vv << 16); o1 += pj * __uint_as_float(vv & 0xffff0000u); }
    const unsigned gg = *(const unsigned*)(P + tok * NPAD + C_GATE + 1024 + hq * 128 + 2 * lane);
    *(unsigned*)(Y + tok * DM + 1024 + hq * 128 + 2 * lane) = pk2(o0 * __uint_as_float(gg << 16), o1 * __uint_as_float(gg & 0xffff0000u));
    __threadfence_block();
}

__device__ void diff_simple_row(const bf16_t* __restrict__ P, bf16_t* __restrict__ Y, const LayerW& W, float lam, int row, float* wl) {
    const int lane = tid_opaque() & 63;
    const int bh = row & 31, b = bh >> 3, h = bh & 7, q = row >> 5;
    const size_t tok = (size_t)b * SEQ + q;
    const bf16_t* qp = P + tok * NPAD + C_DQ + h * 128;
    const float x0 = bf2f(qp[lane]), x1 = bf2f(qp[64 + lane]);
    const float r0 = rsqrtf(wsum(x0 * x0) * (1.f / 64.f) + EPS) * 0.125f, r1 = rsqrtf(wsum(x1 * x1) * (1.f / 64.f) + EPS) * 0.125f;
    __threadfence_block();
    wl[lane] = x0 * r0 * W.dq_n[lane] * W.dk_n[lane]; wl[64 + lane] = x1 * r1 * W.dq_n[lane] * W.dk_n[lane];
    __threadfence_block();
    float* S0 = wl + 128; float* S1 = S0 + 2048;
    const float slope = exp2f(-(float)(h + 1));
    const int nk = q + 1;
    float m0 = -INFINITY, m1 = -INFINITY;
    for (int j = lane; j < nk; j += 64) {
        const uint4* kp = (const uint4*)(P + ((size_t)b * SEQ + j) * NPAD + C_DK + h * 128);
        float d0 = 0.f, k0 = 0.f, d1 = 0.f, k1 = 0.f;
        for (int c = 0; c < 8; ++c) { float f[8]; unpack8(kp[c], f);
#pragma unroll
            for (int e = 0; e < 8; ++e) { d0 += wl[c * 8 + e] * f[e]; k0 += f[e] * f[e]; } }
        for (int c = 0; c < 8; ++c) { float f[8]; unpack8(kp[8 + c], f);
#pragma unroll
            for (int e = 0; e < 8; ++e) { d1 += wl[64 + c * 8 + e] * f[e]; k1 += f[e] * f[e]; } }
        const float al = slope * (float)(q - j);
        const float s0 = d0 * rsqrtf(k0 * (1.f / 64.f) + EPS) - al, s1 = d1 * rsqrtf(k1 * (1.f / 64.f) + EPS) - al;
        S0[j] = s0; S1[j] = s1; m0 = fmaxf(m0, s0); m1 = fmaxf(m1, s1);
    }
    m0 = wmax(m0); m1 = wmax(m1);
    float l0 = 0.f, l1 = 0.f;
    for (int j = lane; j < nk; j += 64) { l0 += __expf(S0[j] - m0); l1 += __expf(S1[j] - m1); }
    l0 = 1.f / wsum(l0); l1 = lam / wsum(l1);
    for (int j = lane; j < nk; j += 64) S0[j] = __expf(S0[j] - m0) * l0 - __expf(S1[j] - m1) * l1;
    __threadfence_block();
    float o0 = 0.f, o1 = 0.f;
    const bf16_t* vp = P + (size_t)b * SEQ * NPAD + C_DV + h * 128 + 2 * lane;
    for (int j = 0; j < nk; ++j) { const unsigned vv = *(const unsigned*)(vp + (size_t)j * NPAD); const float wj = S0[j];
        o0 += wj * __uint_as_float(vv << 16); o1 += wj * __uint_as_float(vv & 0xffff0000u); }
    const float rstd = rsqrtf(wsum(o0 * o0 + o1 * o1) * (1.f / 128.f) + EPS) * (1.f - W.lambda_init);
    const unsigned gg = *(const unsigned*)(P + tok * NPAD + C_GATE + 2048 + h * 128 + 2 * lane);
    *(unsigned*)(Y + tok * DM + 2048 + h * 128 + 2 * lane) = pk2(o0 * rstd * W.d_on[2 * lane] * __uint_as_float(gg << 16), o1 * rstd * W.d_on[2 * lane + 1] * __uint_as_float(gg & 0xffff0000u));
    __threadfence_block();
}

__device__ void lru_gates_simple(const bf16_t* __restrict__ P, float* __restrict__ LA, float* __restrict__ LU, const LayerW& W, int unit, float* sXc) {
    const int tid = tid_opaque(), tg = unit >> 3, n = unit & 7, tok0 = tg * 16, t0 = tok0 & (SEQ - 1);
    __syncthreads();
#pragma unroll
    for (int e = 0; e < 4; ++e) { const int i = tid + 512 * e, tt = i >> 7, c = i & 127, ch = n * 128 + c;
        float xc = W.conv_b[ch];
#pragma unroll
        for (int w = 0; w < 4; ++w) { const int tp = t0 + tt - 3 + w; if (tp >= 0) xc += W.conv_w[w * 1024 + ch] * bf2f(P[(size_t)(tok0 + tt - 3 + w) * NPAD + C_RX + ch]); }
        sXc[i] = xc; }
    __syncthreads();
    const int tt = tid >> 5, jg = tid & 31, ch0 = n * 128 + jg * 4;
    float4 r = *(const float4*)(W.b_r + ch0), g = *(const float4*)(W.b_i + ch0);
    const float* wr = W.w_r + (size_t)n * 16384 + jg * 4; const float* wi = W.w_i + (size_t)n * 16384 + jg * 4;
    for (int i = 0; i < 128; ++i) { const float x = sXc[tt * 128 + i]; const float4 a = *(const float4*)(wr + i * 128), c = *(const float4*)(wi + i * 128);
        r.x += x * a.x; r.y += x * a.y; r.z += x * a.z; r.w += x * a.w; g.x += x * c.x; g.y += x * c.y; g.z += x * c.z; g.w += x * c.w; }
    float rr[4] = {r.x, r.y, r.z, r.w}, gg[4] = {g.x, g.y, g.z, g.w}, av[4], uv[4];
#pragma unroll
    for (int e = 0; e < 4; ++e) { const float x = -W.lam[ch0 + e]; const float sp = (x > 20.f) ? x : log1pf(expf(x));
        const float la = -8.f * sigmf(rr[e]) * sp; av[e] = expf(la); uv[e] = sqrtf(-expm1f(2.f * la)) * sigmf(gg[e]) * sXc[tt * 128 + jg * 4 + e]; }
    *(float4*)(LA + (size_t)(tok0 + tt) * 1024 + ch0) = make_float4(av[0], av[1], av[2], av[3]);
    *(float4*)(LU + (size_t)(tok0 + tt) * 1024 + ch0) = make_float4(uv[0], uv[1], uv[2], uv[3]);
}

__device__ void lru_scan_simple(const bf16_t* __restrict__ P, bf16_t* __restrict__ Y, const float* __restrict__ LA, const float* __restrict__ LU) {
    const int tid = tid_opaque();
    if (blockIdx.x >= 64 || tid >= 64) return;
    const int gid = blockIdx.x * 64 + tid, b = gid >> 10, ch = gid & 1023;
    float h = 0.f;
    for (int t = 0; t < SEQ; t += 8) {
        float a[8], u[8], g[8];
#pragma unroll
        for (int e = 0; e < 8; ++e) { const size_t tok = (size_t)b * SEQ + t + e; a[e] = LA[tok * 1024 + ch]; u[e] = LU[tok * 1024 + ch]; g[e] = bf2f(P[tok * NPAD + C_GATE + 3072 + ch]); }
#pragma unroll
        for (int e = 0; e < 8; ++e) { h = a[e] * h + u[e]; Y[((size_t)b * SEQ + t + e) * DM + 3072 + ch] = f2bf(h * g[e]); }
    }
}

__device__ __forceinline__ float diff_lambda(const LayerW& W) {
    float a = 0.f, b = 0.f;
    for (int i = 0; i < 64; ++i) { a += W.lq1[i] * W.lk1[i]; b += W.lq2[i] * W.lk2[i]; }
    return expf(a) - expf(b) + W.lambda_init;
}


typedef short bf16x8 __attribute__((ext_vector_type(8)));
typedef short s16x4 __attribute__((ext_vector_type(4)));
typedef float f32x16 __attribute__((ext_vector_type(16)));
#define MFMA32(a, b, c) __builtin_amdgcn_mfma_f32_32x32x16_bf16((a), (b), (c), 0, 0, 0)
constexpr float LOG2E = 1.4426950408889634f;
__device__ __forceinline__ int crow(int r, int h) { return (r & 3) + 8 * (r >> 2) + 4 * h; }
__device__ __forceinline__ bf16x8 pack8(const float* f) { u32x4 u; u.x = cvt2(f[0], f[1]); u.y = cvt2(f[2], f[3]); u.z = cvt2(f[4], f[5]); u.w = cvt2(f[6], f[7]); return __builtin_bit_cast(bf16x8, u); }

template <bool SWA> struct AttnCfg {
    static constexpr int DQK = SWA ? 128 : 64, NKS = DQK / 16;
    static constexpr int KP = DQK + 8;
    static constexpr int KMAPS = SWA ? 1 : 2;
    static constexpr int KBYTES = KMAPS * 64 * KP * 2;
    static constexpr int VP = 72;
    static constexpr int VBYTES = 128 * VP * 2;
    static constexpr int ABUF = KBYTES + VBYTES;
};

template <bool SWA>
__device__ __forceinline__ void attn_item(const bf16_t* __restrict__ P, bf16_t* __restrict__ Y, const LayerW& W, float lam, int item, unsigned char* lds) {
    typedef AttnCfg<SWA> C;
    const int tid = tid_opaque(), lane = tid & 63, wave = tid >> 6, c = wave & 1, g = wave >> 1, l31 = lane & 31, hh = lane >> 5;
    int b, qb, hk  , hq  ;
    if (SWA) { qb = 15 - (item >> 4); const int r = item & 15; b = r >> 2; const int kvh = (r >> 1) & 1, gp = r & 1; hk = kvh; hq = kvh * 4 + gp * 2 + c; }
    else { qb = 15 - (item >> 5); const int r = item & 31; b = r >> 3; hk = r & 7; hq = hk; }
    const size_t tokb = (size_t)b * SEQ;
    const int q0 = qb * 128 + g * 32;
    const int qcol = SWA ? (C_SQ + hq * 128) : (C_DQ + hq * 128 + c * 64);
    const int kcol = SWA ? (C_SK + hk * 128) : (C_DK + hk * 128);
    const int vcol = SWA ? (C_SV + hk * 128) : (C_DV + hk * 128);
    const float* qnw = SWA ? W.swa_qn : W.dq_n; const float* knw = SWA ? W.swa_kn : W.dk_n;
    const float slope2 = exp2f(-(float)(hq + 1)) * LOG2E;
    bf16x8 qf[C::NKS];
    {
        const bf16_t* qp = P + (tokb + q0 + l31) * NPAD + qcol;
        float f[C::NKS][8]; float ss = 0.f;
#pragma unroll
        for (int ks = 0; ks < C::NKS; ++ks) { unpack8(*(const uint4*)(qp + 16 * ks + 8 * hh), f[ks]);
#pragma unroll
            for (int e = 0; e < 8; ++e) ss += f[ks][e] * f[ks][e]; }
        ss += __shfl_xor(ss, 32);
        const float sc = rsqrtf(ss * (1.f / C::DQK) + EPS) * (SWA ? 0.08838834764831845f : 0.125f) * LOG2E;
#pragma unroll
        for (int ks = 0; ks < C::NKS; ++ks) {
#pragma unroll
            for (int e = 0; e < 8; ++e) f[ks][e] *= sc * qnw[16 * ks + 8 * hh + e];
            qf[ks] = pack8(f[ks]); }
    }
    int t_lo = 0, t_hi = 2 * qb + 2;
    if (SWA) t_lo = (qb == 0) ? 0 : 2 * qb - 2;
    const int kkey = SWA ? (tid >> 3) : (tid >> 3), kch = tid & 7;
    const int vkey = tid & 63, vch = tid >> 6;
    uint4 rk0, rk1, rv0, rv1;
#define ATT_LOAD(t) do { const bf16_t* kp_ = P + (tokb + (t) * 64 + kkey) * NPAD + kcol + kch * 16; rk0 = ((const uint4*)kp_)[0]; rk1 = ((const uint4*)kp_)[1]; \
        const bf16_t* vp_ = P + (tokb + (t) * 64 + vkey) * NPAD + vcol + vch * 16; rv0 = ((const uint4*)vp_)[0]; rv1 = ((const uint4*)vp_)[1]; } while (0)
#define ATT_STORE(bufp) do { float f_[16]; unpack8(rk0, f_); unpack8(rk1, f_ + 8); float ss_ = 0.f; \
        _Pragma("unroll") for (int e = 0; e < 16; ++e) ss_ += f_[e] * f_[e]; \
        ss_ += __shfl_xor(ss_, 1); ss_ += __shfl_xor(ss_, 2); if (SWA) ss_ += __shfl_xor(ss_, 4); \
        const float rs_ = rsqrtf(ss_ * (1.f / C::DQK) + EPS); const int d0_ = SWA ? kch * 16 : (kch & 3) * 16; \
        _Pragma("unroll") for (int e = 0; e < 16; ++e) f_[e] *= rs_ * knw[d0_ + e]; \
        bf16_t* kd_ = (bf16_t*)(bufp) + ((SWA ? 0 : (kch >> 2) * 64) + kkey) * C::KP + d0_; \
        *(bf16x8*)kd_ = pack8(f_); *(bf16x8*)(kd_ + 8) = pack8(f_ + 8); \
        bf16_t* vd_ = (bf16_t*)((bufp) + C::KBYTES) + (vch * 16) * C::VP + vkey; \
        const unsigned vw_[8] = {rv0.x, rv0.y, rv0.z, rv0.w, rv1.x, rv1.y, rv1.z, rv1.w}; \
        _Pragma("unroll") for (int e = 0; e < 8; ++e) { vd_[(2 * e) * C::VP] = (bf16_t)(vw_[e] & 0xffffu); vd_[(2 * e + 1) * C::VP] = (bf16_t)(vw_[e] >> 16); } } while (0)

    f32x16 O[4];
#pragma unroll
    for (int vt = 0; vt < 4; ++vt)
#pragma unroll
        for (int r = 0; r < 16; ++r) O[vt][r] = 0.f;
    float m = SWA ? W.swa_sinks[hq] * LOG2E + slope2 * (float)(q0 + l31) : -INFINITY, l = SWA ? 0.5f : 0.f;
    __syncthreads();
    ATT_LOAD(t_lo);
    ATT_STORE(lds);
    __syncthreads();
    for (int t = t_lo; t < t_hi; ++t) {
        unsigned char* buf = lds + ((t - t_lo) & 1) * C::ABUF;
        unsigned char* nbuf = lds + (((t - t_lo) & 1) ^ 1) * C::ABUF;
        const bool more = (t + 1 < t_hi);
        if (more) ATT_LOAD(t + 1);
        const int k0 = t * 64;
        bool act = (k0 <= q0 + 31);
        if (SWA) act = act && (k0 + 63 >= q0 - 127);
        if (act) {
            const bf16_t* Kb = (const bf16_t*)buf + (SWA ? 0 : c * 64 * C::KP);
            f32x16 s0, s1;
            { const float kb0 = slope2 * (float)(k0 + 4 * hh), kb1 = kb0 + 32.f * slope2;
#pragma unroll
              for (int r = 0; r < 16; ++r) { const float cr = (float)((r & 3) + 8 * (r >> 2)); s0[r] = fmaf(slope2, cr, kb0); s1[r] = fmaf(slope2, cr, kb1); } }
#pragma unroll
            for (int ks = 0; ks < C::NKS; ++ks) {
                const bf16x8 a0 = *(const bf16x8*)(Kb + l31 * C::KP + 16 * ks + 8 * hh);
                const bf16x8 a1 = *(const bf16x8*)(Kb + (32 + l31) * C::KP + 16 * ks + 8 * hh);
                s0 = MFMA32(a0, qf[ks], s0); s1 = MFMA32(a1, qf[ks], s1); }
            const int dq = q0 + l31 - k0;
            const bool edge = SWA ? (k0 + 63 > q0 || k0 < q0 + 31 - 127) : (k0 + 63 > q0);
            float mx = -INFINITY;
            if (edge) {
#pragma unroll
                for (int r = 0; r < 16; ++r) { const int d0 = dq - crow(r, hh), d1 = d0 - 32;
                    if (d0 < 0 || (SWA && d0 > 127)) s0[r] = -INFINITY;
                    if (d1 < 0 || (SWA && d1 > 127)) s1[r] = -INFINITY; } }
#pragma unroll
            for (int r = 0; r < 16; ++r) { mx = __builtin_amdgcn_fmed3f(mx, s0[r], INFINITY); mx = __builtin_amdgcn_fmed3f(mx, s1[r], INFINITY); }
            mx = __builtin_amdgcn_fmed3f(mx, __shfl_xor(mx, 32), INFINITY);
            const float mn = __builtin_amdgcn_fmed3f(m, mx, INFINITY), alpha = __builtin_amdgcn_exp2f(m - mn);
            m = mn;
            s0 = s0 - mn; s1 = s1 - mn;
            f32v2_t ls2 = {0.f, 0.f};
#pragma unroll
            for (int r = 0; r < 16; r += 2) { s0[r] = __builtin_amdgcn_exp2f(s0[r]); s0[r + 1] = __builtin_amdgcn_exp2f(s0[r + 1]); s1[r] = __builtin_amdgcn_exp2f(s1[r]); s1[r + 1] = __builtin_amdgcn_exp2f(s1[r + 1]);
                ls2 += (f32v2_t){s0[r], s0[r + 1]}; ls2 += (f32v2_t){s1[r], s1[r + 1]}; }
            l = l * alpha + (ls2[0] + ls2[1]);
#pragma unroll
            for (int vt = 0; vt < 4; ++vt)
#pragma unroll
                for (int r = 0; r < 16; ++r) O[vt][r] *= alpha;
            const bf16_t* Vb = (const bf16_t*)(buf + C::KBYTES);
#pragma unroll
            for (int kt2 = 0; kt2 < 2; ++kt2)
#pragma unroll
                for (int s2 = 0; s2 < 2; ++s2) {
                    float pf[8];
#pragma unroll
                    for (int e = 0; e < 8; ++e) pf[e] = kt2 ? s1[8 * s2 + e] : s0[8 * s2 + e];
                    const bf16x8 pb = pack8(pf);
#pragma unroll
                    for (int vt = 0; vt < 4; ++vt) {
                        const bf16_t* vp = Vb + (32 * vt + l31) * C::VP + 32 * kt2 + 16 * s2 + 4 * hh;
                        const s16x4 lo = *(const s16x4*)vp, hi = *(const s16x4*)(vp + 8);
                        const bf16x8 a = __builtin_shufflevector(lo, hi, 0, 1, 2, 3, 4, 5, 6, 7);
                        O[vt] = MFMA32(a, pb, O[vt]); }
                }
        }
        if (more) ATT_STORE(nbuf);
        __syncthreads();
    }
#undef ATT_LOAD
#undef ATT_STORE
    l += __shfl_xor(l, 32);
    float* OB = (float*)lds;
    const int orow = (g * 32 + l31) * 129;
    if (SWA) {
        const float sc = 1.f / l;
#pragma unroll 1
        for (int pass = 0; pass < 2; ++pass) {
            if (c == pass) {
#pragma unroll
                for (int vt = 0; vt < 4; ++vt)
#pragma unroll
                    for (int r = 0; r < 16; ++r) OB[orow + 32 * vt + crow(r, hh)] = O[vt][r] * sc; }
            __syncthreads();
            { const int q = tid >> 2, part = tid & 3; const size_t tq = tokb + qb * 128 + q; const int hq2 = hq - c + pass;
              const bf16_t* gp = P + tq * NPAD + C_GATE + 1024 + hq2 * 128 + part * 32; bf16_t* yp = Y + tq * DM + 1024 + hq2 * 128 + part * 32;
#pragma unroll
              for (int ch = 0; ch < 4; ++ch) { float gf[8]; unpack8(*(const uint4*)(gp + ch * 8), gf); float of[8];
#pragma unroll
                  for (int e = 0; e < 8; ++e) of[e] = OB[q * 129 + part * 32 + ch * 8 + e] * gf[e];
                  *(bf16x8*)(yp + ch * 8) = pack8(of); } }
            __syncthreads();
        }
    } else {
        const float sc = (c == 0) ? 1.f / l : lam / l;
        if (c == 1) {
#pragma unroll
            for (int vt = 0; vt < 4; ++vt)
#pragma unroll
                for (int r = 0; r < 16; ++r) OB[orow + 32 * vt + crow(r, hh)] = O[vt][r] * sc; }
        __syncthreads();
        if (c == 0) {
            float ss = 0.f;
#pragma unroll
            for (int vt = 0; vt < 4; ++vt)
#pragma unroll
                for (int r = 0; r < 16; ++r) { const float o = O[vt][r] * sc - OB[orow + 32 * vt + crow(r, hh)]; O[vt][r] = o; ss += o * o; }
            ss += __shfl_xor(ss, 32);
            const float rstd = rsqrtf(ss * (1.f / 128.f) + EPS) * (1.f - W.lambda_init);
#pragma unroll
            for (int vt = 0; vt < 4; ++vt)
#pragma unroll
                for (int r = 0; r < 16; ++r) OB[orow + 32 * vt + crow(r, hh)] = O[vt][r] * rstd; }
        __syncthreads();
        { const int q = tid >> 2, part = tid & 3; const size_t tq = tokb + qb * 128 + q;
          const bf16_t* gp = P + tq * NPAD + C_GATE + 2048 + hq * 128 + part * 32; bf16_t* yp = Y + tq * DM + 2048 + hq * 128 + part * 32;
#pragma unroll
          for (int ch = 0; ch < 4; ++ch) { float gf[8]; unpack8(*(const uint4*)(gp + ch * 8), gf); float of[8];
#pragma unroll
              for (int e = 0; e < 8; ++e) of[e] = OB[q * 129 + part * 32 + ch * 8 + e] * gf[e] * W.d_on[part * 32 + ch * 8 + e];
              *(bf16x8*)(yp + ch * 8) = pack8(of); } }
        __syncthreads();
    }
}


__device__ __forceinline__ void diff_item3(const Params& p, int lay, const bf16_t* __restrict__ P, bf16_t* __restrict__ Y, const LayerW& W, float lam, int item, unsigned char* lds) {
    constexpr int KP = 72, VP = 72, KBYTES = 2 * 64 * KP * 2, ABUF = KBYTES + 128 * VP * 2;
    const int tid = tid_opaque(), lane = tid & 63, wave = tid >> 6, c = wave & 1, g = wave >> 1, l31 = lane & 31, hh = lane >> 5;
    const int qb = 15 - (item >> 5), r_ = item & 31, b = r_ >> 3, h = r_ & 7;
    const size_t tokb = (size_t)b * SEQ;
    const int q0 = qb * 128 + g * 32;
    const int kcol = C_DK + h * 128, vcol = C_DV + h * 128;
    const float slope2 = exp2f(-(float)(h + 1)) * LOG2E;
    const int kkey = tid >> 3, kch = tid & 7, vkey = tid & 63, vch = tid >> 6;
    uint4 rk0, rk1, rv0, rv1;
#define D3_KLOAD(t) do { const bf16_t* kp_ = P + (tokb + (t) * 64 + kkey) * NPAD + kcol + kch * 16; rk0 = ((const uint4*)kp_)[0]; rk1 = ((const uint4*)kp_)[1]; } while (0)
#define D3_VLOAD(t) do { const bf16_t* vp_ = P + (tokb + (t) * 64 + vkey) * NPAD + vcol + vch * 16; rv0 = ((const uint4*)vp_)[0]; rv1 = ((const uint4*)vp_)[1]; } while (0)
#define D3_KSTORE(t) do { float f_[16]; unpack8(rk0, f_); unpack8(rk1, f_ + 8); float ss_ = 0.f; \
        _Pragma("unroll") for (int e = 0; e < 16; ++e) ss_ += f_[e] * f_[e]; \
        ss_ += __shfl_xor(ss_, 1); ss_ += __shfl_xor(ss_, 2); \
        const float rs_ = rsqrtf(ss_ * (1.f / 64.f) + EPS); const int d0_ = (kch & 3) * 16; \
        _Pragma("unroll") for (int e = 0; e < 16; ++e) f_[e] *= rs_ * W.dk_n[d0_ + e]; \
        bf16_t* kd_ = (bf16_t*)(lds + ((t) & 1) * ABUF) + ((kch >> 2) * 64 + kkey) * KP + d0_; \
        *(bf16x8*)kd_ = pack8(f_); *(bf16x8*)(kd_ + 8) = pack8(f_ + 8); } while (0)
#define D3_VSTORE(t) do { bf16_t* vd_ = (bf16_t*)(lds + ((t) & 1) * ABUF + KBYTES) + (vch * 16) * VP + vkey; \
        const unsigned vw_[8] = {rv0.x, rv0.y, rv0.z, rv0.w, rv1.x, rv1.y, rv1.z, rv1.w}; \
        _Pragma("unroll") for (int e = 0; e < 8; ++e) { vd_[(2 * e) * VP] = (bf16_t)(vw_[e] & 0xffffu); vd_[(2 * e + 1) * VP] = (bf16_t)(vw_[e] >> 16); } } while (0)
#define D3_QK(t) do { const int k0_ = (t) * 64; const bf16_t* Kb_ = (const bf16_t*)(lds + ((t) & 1) * ABUF) + c * 64 * KP; \
        { const float kb0 = slope2 * (float)(k0_ + 4 * hh), kb1 = kb0 + 32.f * slope2; \
          _Pragma("unroll") for (int r = 0; r < 16; ++r) { const float cr = (float)((r & 3) + 8 * (r >> 2)); s0[r] = fmaf(slope2, cr, kb0); s1[r] = fmaf(slope2, cr, kb1); } } \
        _Pragma("unroll") for (int ks = 0; ks < 4; ++ks) { \
            const bf16x8 a0 = *(const bf16x8*)(Kb_ + l31 * KP + 16 * ks + 8 * hh), a1 = *(const bf16x8*)(Kb_ + (32 + l31) * KP + 16 * ks + 8 * hh); \
            s0 = MFMA32(a0, qf[ks], s0); s1 = MFMA32(a1, qf[ks], s1); } \
        if ((t) == tw) { const int dq = q0 + l31 - k0_; \
            _Pragma("unroll") for (int r = 0; r < 16; ++r) { const int d0 = dq - crow(r, hh), d1 = d0 - 32; if (d0 < 0) s0[r] = -INFINITY; if (d1 < 0) s1[r] = -INFINITY; } } } while (0)
#define D3_PV(tv) do { const bf16_t* Vb_ = (const bf16_t*)(lds + ((tv) & 1) * ABUF + KBYTES); \
        _Pragma("unroll") for (int i4 = 0; i4 < 4; ++i4) \
            _Pragma("unroll") for (int vt = 0; vt < 4; ++vt) { \
                const bf16_t* vp = Vb_ + (32 * vt + l31) * VP + 16 * i4 + 4 * hh; \
                const s16x4 lo = *(const s16x4*)vp, hi = *(const s16x4*)(vp + 8); \
                O[vt] = MFMA32(__builtin_shufflevector(lo, hi, 0, 1, 2, 3, 4, 5, 6, 7), pp[i4], O[vt]); } } while (0)
#define D3_SOFTMAX() do { float mx = -INFINITY; \
        _Pragma("unroll") for (int r = 0; r < 16; ++r) { mx = __builtin_amdgcn_fmed3f(mx, s0[r], INFINITY); mx = __builtin_amdgcn_fmed3f(mx, s1[r], INFINITY); } \
        mx = __builtin_amdgcn_fmed3f(mx, __shfl_xor(mx, 32), INFINITY); \
        const float mn = __builtin_amdgcn_fmed3f(m, mx, INFINITY); alpha = __builtin_amdgcn_exp2f(m - mn); m = mn; \
        float ls = 0.f; \
        _Pragma("unroll") for (int r = 0; r < 16; ++r) { s0[r] = __builtin_amdgcn_exp2f(s0[r] - mn); s1[r] = __builtin_amdgcn_exp2f(s1[r] - mn); ls += s0[r] + s1[r]; } \
        l = l * alpha + ls; } while (0)
#define D3_PACK() do { _Pragma("unroll") for (int i4 = 0; i4 < 4; ++i4) { float pf[8]; \
        _Pragma("unroll") for (int e = 0; e < 8; ++e) pf[e] = (i4 >> 1) ? s1[8 * (i4 & 1) + e] : s0[8 * (i4 & 1) + e]; \
        pp[i4] = pack8(pf); } } while (0)
    const int nt = 2 * qb + 2, tw = (q0 + 31) >> 6;
    D3_KLOAD(0);
    bf16x8 qf[4];
    {
        const bf16_t* qp = P + (tokb + q0 + l31) * NPAD + C_DQ + h * 128 + c * 64;
        float f[4][8]; float ss = 0.f;
#pragma unroll
        for (int ks = 0; ks < 4; ++ks) { unpack8(*(const uint4*)(qp + 16 * ks + 8 * hh), f[ks]);
#pragma unroll
            for (int e = 0; e < 8; ++e) ss += f[ks][e] * f[ks][e]; }
        ss += __shfl_xor(ss, 32);
        const float sc = rsqrtf(ss * (1.f / 64.f) + EPS) * 0.125f * LOG2E;
#pragma unroll
        for (int ks = 0; ks < 4; ++ks) {
#pragma unroll
            for (int e = 0; e < 8; ++e) f[ks][e] *= sc * W.dq_n[16 * ks + 8 * hh + e];
            qf[ks] = pack8(f[ks]); }
    }
    f32x16 O[4];
#pragma unroll
    for (int vt = 0; vt < 4; ++vt)
#pragma unroll
        for (int r = 0; r < 16; ++r) O[vt][r] = 0.f;
    float m = -INFINITY, l = 0.f, alpha = 0.f;
    bf16x8 pp[4];
    f32x16 s0, s1;
    __syncthreads();
    D3_KSTORE(0);
    __syncthreads();
    unsigned* HC = (unsigned*)(lds + 81920);
    const int hbase = 32 * (256 - (qb + 1) * (qb + 1)) + (item & 31) * (2 * qb + 1) - 1;
    f32x4 hc[4]; TrTile Th, Tf; bool hok, fok = false;
    hok = diff_host_tile(p, lay, hbase + 1, Th);
    if (hok) tr_load(Th, tid, hc);
    {
        D3_KLOAD(1); D3_VLOAD(0);
        D3_QK(0);
        D3_SOFTMAX();
        D3_PACK();
        D3_KSTORE(1); D3_VSTORE(0);
        __syncthreads();
    }
#pragma unroll 1
    for (int t = 1; t < nt; ++t) {
        const bool more = (t + 1 < nt);
        if (fok) tr_flush(Tf, tid, HC + ((t - 1) & 1) * 4160);
        if (more) D3_KLOAD(t + 1);
        D3_VLOAD(t);
        if (t <= tw) {
            D3_QK(t);
            {
                float mx = -INFINITY;
#pragma unroll
                for (int r = 0; r < 16; ++r) { mx = __builtin_amdgcn_fmed3f(mx, s0[r], INFINITY); mx = __builtin_amdgcn_fmed3f(mx, s1[r], INFINITY); }
                mx = __builtin_amdgcn_fmed3f(mx, __shfl_xor(mx, 32), INFINITY);
                const float mn = __builtin_amdgcn_fmed3f(m, mx, INFINITY); alpha = __builtin_amdgcn_exp2f(m - mn); m = mn;
                float ls = 0.f;
                const bf16_t* Vb_ = (const bf16_t*)(lds + ((t - 1) & 1) * ABUF + KBYTES);
#pragma unroll
                for (int r = 0; r < 16; ++r) {
                    { const int i4 = r >> 2, vt = r & 3;
                      const bf16_t* vp = Vb_ + (32 * vt + l31) * VP + 16 * i4 + 4 * hh;
                      const s16x4 lo = *(const s16x4*)vp, hi = *(const s16x4*)(vp + 8);
                      O[vt] = MFMA32(__builtin_shufflevector(lo, hi, 0, 1, 2, 3, 4, 5, 6, 7), pp[i4], O[vt]); }
                    s0[r] = __builtin_amdgcn_exp2f(s0[r] - mn); s1[r] = __builtin_amdgcn_exp2f(s1[r] - mn); ls += s0[r] + s1[r];
                    __builtin_amdgcn_sched_barrier(0);
                }
                l = l * alpha + ls;
            }
#pragma unroll
            for (int vt = 0; vt < 4; ++vt)
#pragma unroll
                for (int r = 0; r < 16; ++r) O[vt][r] *= alpha;
            D3_PACK();
        } else if (t == tw + 1) {
            D3_PV(t - 1);
        }
        if (more) D3_KSTORE(t + 1);
        D3_VSTORE(t);
        if (hok) tr_stage(tid, hc, HC + (t & 1) * 4160);
        Tf = Th; fok = hok;
        hok = more && diff_host_tile(p, lay, hbase + t + 1, Th);
        if (hok) tr_load(Th, tid, hc);
        __syncthreads();
    }
    if (fok) tr_flush(Tf, tid, HC + ((nt - 1) & 1) * 4160);
    if (tw == nt - 1) D3_PV(nt - 1);
    __syncthreads();
#undef D3_KLOAD
#undef D3_VLOAD
#undef D3_KSTORE
#undef D3_VSTORE
#undef D3_QK
#undef D3_PV
#undef D3_SOFTMAX
#undef D3_PACK
    l += __shfl_xor(l, 32);
    float* OB = (float*)lds;
    const int orow = (g * 32 + l31) * 129;
    const float sc = (c == 0) ? 1.f / l : lam / l;
    if (c == 1) {
#pragma unroll
        for (int vt = 0; vt < 4; ++vt)
#pragma unroll
            for (int r = 0; r < 16; ++r) OB[orow + 32 * vt + crow(r, hh)] = O[vt][r] * sc; }
    __syncthreads();
    if (c == 0) {
        float ss = 0.f;
#pragma unroll
        for (int vt = 0; vt < 4; ++vt)
#pragma unroll
            for (int r = 0; r < 16; ++r) { const float o = O[vt][r] * sc - OB[orow + 32 * vt + crow(r, hh)]; O[vt][r] = o; ss += o * o; }
        ss += __shfl_xor(ss, 32);
        const float rstd = rsqrtf(ss * (1.f / 128.f) + EPS) * (1.f - W.lambda_init);
#pragma unroll
        for (int vt = 0; vt < 4; ++vt)
#pragma unroll
            for (int r = 0; r < 16; ++r) OB[orow + 32 * vt + crow(r, hh)] = O[vt][r] * rstd; }
    __syncthreads();
    { const int q = tid >> 2, part = tid & 3; const size_t tq = tokb + qb * 128 + q;
      const bf16_t* gp = P + tq * NPAD + C_GATE + 2048 + h * 128 + part * 32; bf16_t* yp = Y + tq * DM + 2048 + h * 128 + part * 32;
#pragma unroll
      for (int ch = 0; ch < 4; ++ch) { float gf[8]; unpack8(*(const uint4*)(gp + ch * 8), gf); float of[8];
#pragma unroll
          for (int e = 0; e < 8; ++e) of[e] = OB[q * 129 + part * 32 + ch * 8 + e] * gf[e] * W.d_on[part * 32 + ch * 8 + e];
          *(bf16x8*)(yp + ch * 8) = pack8(of); } }
    __syncthreads();
}

__device__ __forceinline__ float fast_sigm(float x) { return __builtin_amdgcn_rcpf(1.f + __builtin_amdgcn_exp2f(-x * LOG2E)); }
__device__ __forceinline__ void lru_pre_item(const bf16_t* __restrict__ P, float* __restrict__ HL, float* __restrict__ CP, const LayerW& W, int item, unsigned char* lds) {
    const int tid = tid_opaque(), lane = tid & 63, wave = tid >> 6, l31 = lane & 31, hh = lane >> 5;
    const int b = item >> 6, n = (item >> 3) & 7, seg = item & 7;
    const size_t tokb = (size_t)b * SEQ;
    bf16_t* WrT = (bf16_t*)lds; bf16_t* WiT = WrT + 128 * 136; bf16_t* XC = WiT + 128 * 136; float* A = (float*)(lds + 69632 + 17408); float* U = A + 8192;
    __syncthreads();
#pragma unroll 2
    for (int e = 0; e < 8; ++e) { const int idx = tid + 512 * e, i = idx >> 5, j4 = (idx & 31) * 4;
        const float4 a = *(const float4*)(W.w_r + (size_t)n * 16384 + i * 128 + j4), c = *(const float4*)(W.w_i + (size_t)n * 16384 + i * 128 + j4);
        WrT[(j4 + 0) * 136 + i] = f2bf(a.x); WrT[(j4 + 1) * 136 + i] = f2bf(a.y); WrT[(j4 + 2) * 136 + i] = f2bf(a.z); WrT[(j4 + 3) * 136 + i] = f2bf(a.w);
        WiT[(j4 + 0) * 136 + i] = f2bf(c.x); WiT[(j4 + 1) * 136 + i] = f2bf(c.y); WiT[(j4 + 2) * 136 + i] = f2bf(c.z); WiT[(j4 + 3) * 136 + i] = f2bf(c.w); }
    const int tt = wave >> 2, jt = wave & 3, chl = 32 * jt + l31, ch = n * 128 + chl;
    const float br = W.b_r[ch], bi = W.b_i[ch];
    float sp; { const float x = -W.lam[ch]; sp = (x > 20.f) ? x : log1pf(expf(x)); }
    const float sp8 = -8.f * sp;
    const int cc = 2 * (tid & 63), tg = tid >> 6, cch = n * 128 + cc;
    float cw[4][2], cb[2];
#pragma unroll
    for (int w = 0; w < 4; ++w) { cw[w][0] = W.conv_w[w * 1024 + cch]; cw[w][1] = W.conv_w[w * 1024 + cch + 1]; }
    cb[0] = W.conv_b[cch]; cb[1] = W.conv_b[cch + 1];
    unsigned rx[11];
#define LRU_LOAD(k) do { _Pragma("unroll") for (int i = 0; i < 11; ++i) { const int tp = seg * 256 + (k) * 64 + 8 * tg - 3 + i; rx[i] = (tp >= 0) ? *(const unsigned*)(P + (tokb + tp) * NPAD + C_RX + cch) : 0u; } } while (0)
    LRU_LOAD(0);
    float* XH = (float*)XC; float* XP = XH + 512;
    const int sch = tid & 127, ssub = tid >> 7;
    float hcar = 0.f, ccar = 1.f;
#pragma unroll 1
    for (int k = 0; k < 4; ++k) {
#pragma unroll
        for (int i = 0; i < 8; ++i) { float x0 = cb[0], x1 = cb[1];
#pragma unroll
            for (int w = 0; w < 4; ++w) { const unsigned v = rx[i + w]; x0 += cw[w][0] * __uint_as_float(v << 16); x1 += cw[w][1] * __uint_as_float(v & 0xffff0000u); }
            *(unsigned*)(XC + (8 * tg + i) * 136 + cc) = cvt2(x0, x1); }
        if (k + 1 < 4) LRU_LOAD(k + 1);
        __syncthreads();
        {
            f32x16 ar, ai;
#pragma unroll
            for (int r = 0; r < 16; ++r) { ar[r] = 0.f; ai[r] = 0.f; }
#pragma unroll
            for (int ks = 0; ks < 8; ++ks) {
                const bf16x8 a = *(const bf16x8*)(XC + (32 * tt + l31) * 136 + 16 * ks + 8 * hh);
                const bf16x8 wr = *(const bf16x8*)(WrT + (32 * jt + l31) * 136 + 16 * ks + 8 * hh);
                const bf16x8 wi = *(const bf16x8*)(WiT + (32 * jt + l31) * 136 + 16 * ks + 8 * hh);
                ar = MFMA32(a, wr, ar); ai = MFMA32(a, wi, ai); }
#pragma unroll
            for (int r = 0; r < 16; ++r) { const int t = 32 * tt + crow(r, hh);
                const float rr = fast_sigm(ar[r] + br), ii = fast_sigm(ai[r] + bi), la = sp8 * rr;
                const float av = __builtin_amdgcn_exp2f(la * LOG2E), x2 = 2.f * la;
                const float om = (x2 > -0.1f) ? -x2 * (1.f + x2 * (0.5f + x2 * (0.16666667f + x2 * 0.041666668f))) : 1.f - av * av;
                const float xv = bf2f(XC[t * 136 + chl]);
                A[t * 128 + chl] = av; U[t * 128 + chl] = __builtin_amdgcn_sqrtf(om) * ii * xv; }
        }
        __syncthreads();
        {
            float hl[16], cl[16]; float hh_ = 0.f, cc_ = 1.f;
#pragma unroll
            for (int t = 0; t < 16; ++t) { const float a = A[(16 * ssub + t) * 128 + sch]; hh_ = a * hh_ + U[(16 * ssub + t) * 128 + sch]; cc_ *= a; hl[t] = hh_; cl[t] = cc_; }
            XH[ssub * 128 + sch] = hh_; XP[ssub * 128 + sch] = cc_;
            __syncthreads();
            float hin = hcar, cin = ccar;
            for (int s = 0; s < ssub; ++s) { hin = XH[s * 128 + sch] + XP[s * 128 + sch] * hin; cin *= XP[s * 128 + sch]; }
            float hend = hin, cend = cin;
            for (int s = ssub; s < 4; ++s) { hend = XH[s * 128 + sch] + XP[s * 128 + sch] * hend; cend *= XP[s * 128 + sch]; }
            hcar = hend; ccar = cend;
            const size_t o = (tokb + seg * 256 + k * 64 + 16 * ssub) * 1024 + n * 128 + sch;
#pragma unroll
            for (int t = 0; t < 16; ++t) { HL[o + (size_t)t * 1024] = hl[t] + cl[t] * hin; CP[o + (size_t)t * 1024] = cl[t] * cin; }
            __syncthreads();
        }
    }
#undef LRU_LOAD
    __syncthreads();
}
__device__ __forceinline__ void lru_fix_item(const bf16_t* __restrict__ P, bf16_t* __restrict__ Y, const float* __restrict__ HL, const float* __restrict__ CP, int item) {
    const int tid = tid_opaque();
    const int b = item >> 6, n = (item >> 3) & 7, seg = item & 7;
    const size_t tokb = (size_t)b * SEQ;
    const int c0 = (tid & 15) * 8, tr = tid >> 4;
    float carry[8];
#pragma unroll
    for (int e = 0; e < 8; ++e) carry[e] = 0.f;
    for (int s = 0; s < seg; ++s) { const size_t o = (tokb + s * 256 + 255) * 1024 + n * 128 + c0;
        const float4 h0 = *(const float4*)(HL + o), h1 = *(const float4*)(HL + o + 4), p0 = *(const float4*)(CP + o), p1 = *(const float4*)(CP + o + 4);
        carry[0] = h0.x + p0.x * carry[0]; carry[1] = h0.y + p0.y * carry[1]; carry[2] = h0.z + p0.z * carry[2]; carry[3] = h0.w + p0.w * carry[3];
        carry[4] = h1.x + p1.x * carry[4]; carry[5] = h1.y + p1.y * carry[5]; carry[6] = h1.z + p1.z * carry[6]; carry[7] = h1.w + p1.w * carry[7]; }
#pragma unroll 2
    for (int it = 0; it < 8; ++it) { const size_t tok = tokb + seg * 256 + it * 32 + tr; const size_t o = tok * 1024 + n * 128 + c0;
        const float4 h0 = *(const float4*)(HL + o), h1 = *(const float4*)(HL + o + 4), p0 = *(const float4*)(CP + o), p1 = *(const float4*)(CP + o + 4);
        float gf[8]; unpack8(*(const uint4*)(P + tok * NPAD + C_GATE + 3072 + n * 128 + c0), gf);
        float of[8] = {h0.x + p0.x * carry[0], h0.y + p0.y * carry[1], h0.z + p0.z * carry[2], h0.w + p0.w * carry[3], h1.x + p1.x * carry[4], h1.y + p1.y * carry[5], h1.z + p1.z * carry[6], h1.w + p1.w * carry[7]};
#pragma unroll
        for (int e = 0; e < 8; ++e) of[e] *= gf[e];
        *(bf16x8*)(Y + tok * DM + 3072 + n * 128 + c0) = pack8(of); }
}

constexpr size_t GP_UNIT = 41216;
struct GlaPreRaw { uint4 ra0, ra1, rq, rk, rv0, rv1; };
__device__ __forceinline__ GlaPreRaw gla_pre_load(const bf16_t* __restrict__ P, int unit, int lane, int wave) {
    const int bh = unit >> 5, k = unit & 31, b = bh >> 3, h = bh & 7;
    const bf16_t* row_ = P + ((size_t)b * SEQ + k * 64 + lane) * NPAD;
    GlaPreRaw r;
    r.ra0 = *(const uint4*)(row_ + C_GA); r.ra1 = *(const uint4*)(row_ + C_GA + 8);
    r.rq = *(const uint4*)(row_ + C_GQ + h * 64 + 8 * wave); r.rk = *(const uint4*)(row_ + C_GK + h * 64 + 8 * wave);
    r.rv0 = *(const uint4*)(row_ + C_GV + h * 128 + 16 * wave); r.rv1 = *(const uint4*)(row_ + C_GV + h * 128 + 16 * wave + 8);
    return r;
}
__device__ __forceinline__ void gla_pre_unit(const GlaPreRaw& R, unsigned char* __restrict__ GP, const LayerW& W, int unit, unsigned char* lds, int tid, bool stage) {
    const int lane = tid & 63, wave = tid >> 6;
    const int bh = unit >> 5, h = bh & 7;
    float* WUP = (float*)lds;
    if (stage) {
        __syncthreads();
        for (int i = tid; i < 1024; i += 512) WUP[i] = W.gla_w_up[(i >> 6) * 512 + h * 64 + (i & 63)];
        if (tid < 64) WUP[1024 + tid] = W.gla_b_up[h * 64 + tid];
        __syncthreads(); }
    unsigned char* g = GP + (size_t)unit * GP_UNIT;
    float al[16]; unpack8(R.ra0, al); unpack8(R.ra1, al + 8);
    float bc[8];
    { const float4 b0 = *(const float4*)(WUP + 1024 + 8 * wave), b1 = *(const float4*)(WUP + 1024 + 8 * wave + 4);
      bc[0] = b0.x; bc[1] = b0.y; bc[2] = b0.z; bc[3] = b0.w; bc[4] = b1.x; bc[5] = b1.y; bc[6] = b1.z; bc[7] = b1.w; }
#pragma unroll
    for (int r = 0; r < 16; ++r) { const float4 w0 = *(const float4*)(WUP + r * 64 + 8 * wave), w1 = *(const float4*)(WUP + r * 64 + 8 * wave + 4);
        bc[0] += al[r] * w0.x; bc[1] += al[r] * w0.y; bc[2] += al[r] * w0.z; bc[3] += al[r] * w0.w; bc[4] += al[r] * w1.x; bc[5] += al[r] * w1.y; bc[6] += al[r] * w1.z; bc[7] += al[r] * w1.w; }
#pragma unroll
    for (int e = 0; e < 8; ++e) { const float lg = bc[e]; bc[e] = (fminf(lg, 0.f) - __logf(1.f + __expf(-fabsf(lg)))) * (1.f / 16.f); }
#define DPP_ADD(x, ctrl, rmask) (x) += __int_as_float(__builtin_amdgcn_update_dpp(0, __float_as_int(x), (ctrl), (rmask), 0xf, true))
#pragma unroll
    for (int e = 0; e < 8; ++e) { DPP_ADD(bc[e], 0x111, 0xf); DPP_ADD(bc[e], 0x112, 0xf); DPP_ADD(bc[e], 0x114, 0xf); DPP_ADD(bc[e], 0x118, 0xf); DPP_ADD(bc[e], 0x142, 0xa); DPP_ADD(bc[e], 0x143, 0xc); }
#undef DPP_ADD
    float qv[8], kv[8], qd[8], kd[8]; unpack8(R.rq, qv); unpack8(R.rk, kv);
#pragma unroll
    for (int e = 0; e < 8; ++e) { const float bl = __shfl(bc[e], 63);
        qd[e] = qv[e] * 0.125f * __expf(bc[e]); kd[e] = kv[e] * __expf(-bc[e]);
        ((bf16_t*)(g + 16384))[(8 * wave + e) * 64 + lane] = f2bf(kv[e] * __expf(bl - bc[e]));
        if (lane == 63) ((float*)(g + 40960))[8 * wave + e] = __expf(bl); }
    *(bf16x8*)(g + (lane * 64 + 8 * wave) * 2) = pack8(qd); *(bf16x8*)(g + 8192 + (lane * 64 + 8 * wave) * 2) = pack8(kd);
    const unsigned vw[8] = {R.rv0.x, R.rv0.y, R.rv0.z, R.rv0.w, R.rv1.x, R.rv1.y, R.rv1.z, R.rv1.w};
    bf16_t* vt = (bf16_t*)(g + 24576);
#pragma unroll
    for (int e = 0; e < 8; ++e) { vt[(16 * wave + 2 * e) * 64 + lane] = (bf16_t)(vw[e] & 0xffffu); vt[(16 * wave + 2 * e + 1) * 64 + lane] = (bf16_t)(vw[e] >> 16); }
}
__device__ __forceinline__ void gla_pre_all(const bf16_t* __restrict__ P, unsigned char* __restrict__ GP, const LayerW& W, unsigned char* lds) {
    const int tid = tid_opaque(), lane = tid & 63, wave = tid >> 6;
    const int G = (int)gridDim.x, per = 1024 / G; const bool blk = (1024 % G) == 0;
    int L = blockIdx.x;
    if (L >= 1024) return;
    int u = blk ? (L % G) * per + L / G : L, hs = -1;
    GlaPreRaw cur = gla_pre_load(P, u, lane, wave);
#pragma unroll 1
    while (L < 1024) {
        const int Ln = L + G;
        const int un = blk ? (Ln % G) * per + Ln / G : Ln;
        GlaPreRaw nxt = cur;
        if (Ln < 1024) nxt = gla_pre_load(P, un, lane, wave);
        const int h = (u >> 5) & 7;
        gla_pre_unit(cur, GP, W, u, lds, tid, h != hs);
        hs = h; cur = nxt; L = Ln; u = un;
    }
}

__device__ __forceinline__ void gla_item(const Params& p, int l, const bf16_t* __restrict__ P, bf16_t* __restrict__ Y, const unsigned char* __restrict__ GP, const LayerW& W, int item, unsigned char* lds) {
    const int tid = tid_opaque(), lane = tid & 63, wave = tid >> 6, l31 = lane & 31, hh = lane >> 5;
    const int b = item >> 3, h = item & 7;
    const size_t tokb = (size_t)b * SEQ;
    bf16_t* QD = (bf16_t*)lds; bf16_t* KD = QD + 64 * 72; bf16_t* KST = KD + 64 * 72; bf16_t* VT = KST + 64 * 72; bf16_t* ST = VT + 128 * 72;
    float* OB = (float*)(lds + 64768);
    const int vt = wave >> 1, it = wave & 1;
    const int srow = tid >> 3, sseg = tid & 7, ctok = tid >> 3, cvch = tid & 7;
    f32x16 S;
#pragma unroll
    for (int r = 0; r < 16; ++r) S[r] = 0.f;
    uint4 rQ, rK, rS, rV0, rV1, rg0, rg1; float rdec;
#define GLA_LOAD(k) do { const unsigned char* g_ = GP + (size_t)(item * 32 + (k)) * GP_UNIT + srow * 128 + sseg * 16; \
        rQ = *(const uint4*)g_; rK = *(const uint4*)(g_ + 8192); rS = *(const uint4*)(g_ + 16384); rV0 = *(const uint4*)(g_ + 24576); rV1 = *(const uint4*)(g_ + 24576 + 8192); \
        rdec = ((const float*)(GP + (size_t)(item * 32 + (k)) * GP_UNIT + 40960))[32 * it + l31]; \
        const bf16_t* gp_ = P + (tokb + (k) * 64 + ctok) * NPAD + C_GATE + h * 128 + cvch * 16; rg0 = *(const uint4*)gp_; rg1 = *(const uint4*)(gp_ + 8); } while (0)
    GLA_LOAD(0);
    unsigned* CS0 = (unsigned*)(lds + 98304); unsigned* CS1 = (unsigned*)(lds + 98304 + 16640);
    f32x4 ca[4], cb[4]; TrTile Ta, Tb;
    bool oka = host_tile(p, l, item * 32, Ta), okb = false;
    if (oka) tr_load(Ta, tid, ca);
    if (okb) tr_load(Tb, tid, cb);
    float nw[16];
#pragma unroll
    for (int e = 0; e < 16; ++e) nw[e] = W.gla_nw[cvch * 16 + e];
    __syncthreads();
#pragma unroll 1
    for (int k = 0; k < 32; ++k) {
        *(uint4*)(QD + srow * 72 + sseg * 8) = rQ; *(uint4*)(KD + srow * 72 + sseg * 8) = rK; *(uint4*)(KST + srow * 72 + sseg * 8) = rS;
        *(uint4*)(VT + srow * 72 + sseg * 8) = rV0; *(uint4*)(VT + (64 + srow) * 72 + sseg * 8) = rV1;
#pragma unroll
        for (int r = 0; r < 16; ++r) ST[(32 * vt + crow(r, hh)) * 72 + 32 * it + l31] = f2bf(S[r]);
        const float dec = rdec; const uint4 g0 = rg0, g1 = rg1;
        __syncthreads();
        if (k + 1 < 32) GLA_LOAD(k + 1);
        {
            f32x16 at0, at1, o, u;
#pragma unroll
            for (int r = 0; r < 16; ++r) { at0[r] = 0.f; at1[r] = 0.f; o[r] = 0.f; u[r] = 0.f; }
#pragma unroll
            for (int ks = 0; ks < 4; ++ks) {
                const bf16x8 bq = *(const bf16x8*)(QD + (32 * it + l31) * 72 + 16 * ks + 8 * hh);
                const bf16x8 a0 = *(const bf16x8*)(KD + l31 * 72 + 16 * ks + 8 * hh), a1 = *(const bf16x8*)(KD + (32 + l31) * 72 + 16 * ks + 8 * hh);
                at0 = MFMA32(a0, bq, at0); at1 = MFMA32(a1, bq, at1); }
            const int iq = 32 * it + l31;
#pragma unroll
            for (int r = 0; r < 16; ++r) { const int j0 = crow(r, hh); if (j0 > iq) at0[r] = 0.f; if (j0 + 32 > iq) at1[r] = 0.f; }
#pragma unroll
            for (int jt2 = 0; jt2 < 2; ++jt2)
#pragma unroll
                for (int s2 = 0; s2 < 2; ++s2) { float pf[8];
#pragma unroll
                    for (int e = 0; e < 8; ++e) pf[e] = jt2 ? at1[8 * s2 + e] : at0[8 * s2 + e];
                    const bf16x8 pb = pack8(pf);
                    const bf16_t* vp = VT + (32 * vt + l31) * 72 + 32 * jt2 + 16 * s2 + 4 * hh;
                    const s16x4 lo = *(const s16x4*)vp, hi = *(const s16x4*)(vp + 8);
                    o = MFMA32(__builtin_shufflevector(lo, hi, 0, 1, 2, 3, 4, 5, 6, 7), pb, o); }
#pragma unroll
            for (int ks = 0; ks < 4; ++ks) {
                const bf16x8 a = *(const bf16x8*)(ST + (32 * vt + l31) * 72 + 16 * ks + 8 * hh);
                const bf16x8 bq = *(const bf16x8*)(QD + (32 * it + l31) * 72 + 16 * ks + 8 * hh);
                o = MFMA32(a, bq, o); }
#pragma unroll
            for (int ks = 0; ks < 4; ++ks) {
                const bf16x8 a = *(const bf16x8*)(VT + (32 * vt + l31) * 72 + 16 * ks + 8 * hh);
                const bf16x8 bk = *(const bf16x8*)(KST + (32 * it + l31) * 72 + 16 * ks + 8 * hh);
                u = MFMA32(a, bk, u); }
#pragma unroll
            for (int r = 0; r < 16; ++r) { S[r] = dec * S[r] + u[r]; OB[(32 * it + l31) * 129 + 32 * vt + crow(r, hh)] = o[r]; }
        }
        const TrTile Fa = Ta, Fb = Tb; const bool fa = oka, fb = okb;
        if (fa) tr_stage(tid, ca, CS0);
        if (fb) tr_stage(tid, cb, CS1);
        oka = (k + 1 < 32) && host_tile(p, l, item * 32 + k + 1, Ta); okb = false;
        if (oka) tr_load(Ta, tid, ca);
        if (okb) tr_load(Tb, tid, cb);
        __syncthreads();
        if (fa) tr_flush(Fa, tid, CS0);
        if (fb) tr_flush(Fb, tid, CS1);
        {
            float ov[16]; float ss = 0.f;
#pragma unroll
            for (int e = 0; e < 16; ++e) { ov[e] = OB[ctok * 129 + cvch * 16 + e]; ss += ov[e] * ov[e]; }
            ss += __shfl_xor(ss, 1); ss += __shfl_xor(ss, 2); ss += __shfl_xor(ss, 4);
            const float rstd = rsqrtf(ss * (1.f / 128.f) + EPS);
            float gf[16]; unpack8(g0, gf); unpack8(g1, gf + 8);
#pragma unroll
            for (int e = 0; e < 16; ++e) ov[e] *= rstd * nw[e] * gf[e];
            bf16_t* yp = Y + (tokb + k * 64 + ctok) * DM + h * 128 + cvch * 16;
            *(bf16x8*)yp = pack8(ov); *(bf16x8*)(yp + 8) = pack8(ov + 8);
        }
    }
#undef GLA_LOAD
    __syncthreads();
}

constexpr int QSLOT_OFF = LDS_BYTES - 16;
constexpr size_t WS_CTR = WS_END;
constexpr size_t WS_BAR = WS_END + 512;
constexpr size_t WS_CTL_BYTES = 512 + XCD_BAR_WORDS_C * 4;
__device__ __forceinline__ void phase_mix_fast(const Params& p, int l, unsigned char* lds, int rep) {
    const LayerW W = layer_w(p, l);
    const bf16_t* P = (const bf16_t*)(p.ws + WS_PROJ); bf16_t* Y = (bf16_t*)(p.ws + WS_Y);
    unsigned* ctr = (unsigned*)(p.ws + WS_CTR) + l * 64 + rep * 16;
    const float lam = diff_lambda(W);
    volatile int* slot = (volatile int*)(lds + QSLOT_OFF);
    for (;;) {
        __syncthreads();
        if (tid_opaque() == 0) *slot = (int)atomicAdd(ctr, 1u);
        __syncthreads();
        const int it = __builtin_amdgcn_readfirstlane(*slot);
        if (it >= 1056) break;
        if (it < 32) { gla_item(p, l, P, Y, p.ws + WS_GP, W, it, lds);
#ifdef PROBE_GLA2
            gla_item(p, l, P, Y, p.ws + WS_GP, W, it, lds);
#endif
        }
        else if (it < 544) diff_item3(p, l, P, Y, W, lam, it - 32, lds);
        else if (it < 800) attn_item<true>(P, Y, W, lam, it - 544, lds);
        else lru_fix_item(P, Y, (const float*)(p.ws + WS_LA), (const float*)(p.ws + WS_LU), it - 800);
    }
}

#define XB_TMO      128
#define XB_XCNT(j)  (256  + 64 * (j))
#define XB_XSUB(j)  (1280 + 64 * (j))
#define XB_XGEN(j)  (2304 + 64 * (j))
#define XB_TOP      3328
#define XB_TOPGEN   3392
#define XCD_BAR_WORDS 3456
#define XB_SPIN_CAP (1u << 18)

__device__ __forceinline__ unsigned xb_ld(unsigned* p)              { return __hip_atomic_load(p, __ATOMIC_RELAXED, __HIP_MEMORY_SCOPE_AGENT); }
__device__ __forceinline__ unsigned xb_add(unsigned* p, unsigned v) { return __hip_atomic_fetch_add(p, v, __ATOMIC_RELAXED, __HIP_MEMORY_SCOPE_AGENT); }
__device__ __forceinline__ unsigned xb_xcc_id() { return (unsigned)__builtin_amdgcn_s_getreg((3 << 11) | 20) & 0xFu; }
#define XB_SPIN(cond, bar) do { unsigned _sp = 0; while (cond) { __builtin_amdgcn_s_sleep(1); \
    if ((++_sp & 255u) == 0u) { if (xb_ld(&(bar)[XB_TMO])) break; if (_sp > XB_SPIN_CAP) { atomicAdd(&(bar)[XB_TMO], 1u); break; } } } } while (0)

struct XcdBarrier {
    unsigned* bar; unsigned x;
    volatile LAS unsigned* st;
};

__device__ __forceinline__ XcdBarrier xcd_barrier_post(unsigned* bar, volatile LAS unsigned* st) {
    XcdBarrier b; b.bar = bar; b.x = xb_xcc_id(); b.st = st;
    if (threadIdx.x == 0) (void)xb_add(&bar[XB_XCNT(b.x)], 1u);
    return b;
}
__device__ __forceinline__ void xcd_barrier_complete(unsigned* bar, unsigned x, unsigned& nloc, unsigned& nx) {
    const unsigned G = gridDim.x * gridDim.y * gridDim.z;
    unsigned sum, cnt, mine, sp = 0u;
    for (;;) {
        sum = 0u; cnt = 0u; mine = 0u;
#pragma unroll
        for (unsigned j = 0; j < 16; ++j) { const unsigned c = xb_ld(&bar[XB_XCNT(j)]); sum += c; cnt += (c > 0u) ? 1u : 0u; mine = (j == x) ? c : mine; }
        if (sum == G) break;
        __builtin_amdgcn_s_sleep(1);
        if ((++sp & 255u) == 0u) { if (xb_ld(&bar[XB_TMO])) break; if (sp > XB_SPIN_CAP) { atomicAdd(&bar[XB_TMO], 1u); break; } }
    }
    nloc = mine > 0u ? mine : 1u; nx = cnt > 0u ? cnt : 1u;
}

__device__ __forceinline__ void xcd_barrier(const XcdBarrier& b) {
    asm volatile("s_waitcnt vmcnt(0)" ::: "memory");
    __syncthreads();
    if (threadIdx.x == 0) {
        unsigned* bar = b.bar;
        __builtin_amdgcn_s_waitcnt(0);
        unsigned nloc = b.st[0], nx = b.st[1];
        if (nloc == 0u) { xcd_barrier_complete(bar, b.x, nloc, nx); b.st[0] = nloc; b.st[1] = nx; }
        const unsigned old = xb_add(&bar[XB_XSUB(b.x)], 1u);
        const unsigned gen = old / nloc;
        if (old + 1u == (gen + 1u) * nloc) {
            __builtin_amdgcn_fence(__ATOMIC_RELEASE, "agent");
            asm volatile("s_waitcnt vmcnt(0)" ::: "memory");
            const unsigned og = xb_add(&bar[XB_TOP], 1u);
            const unsigned tg = og / nx;
            if (og + 1u == (tg + 1u) * nx) xb_add(&bar[XB_TOPGEN], 1u);
            else XB_SPIN(xb_ld(&bar[XB_TOPGEN]) == tg, bar);
            __builtin_amdgcn_fence(__ATOMIC_ACQUIRE, "agent");
            xb_add(&bar[XB_XGEN(b.x)], 1u);
            asm volatile("s_waitcnt vmcnt(0)" ::: "memory");
        } else {
            XB_SPIN(xb_ld(&bar[XB_XGEN(b.x)]) == gen, bar);
            __builtin_amdgcn_fence(__ATOMIC_ACQUIRE, "agent");
            asm volatile("s_waitcnt vmcnt(0)" ::: "memory");
        }
    }
    __syncthreads();
}


#ifndef GEMM_SP2
#define GEMM_SP2 true
#endif
#ifndef GEMM_ALIGN
#define GEMM_ALIGN true
#endif
#ifndef REP_M1
#define REP_M1 1
#endif
#ifndef REP_PREP
#define REP_PREP 1
#endif
#ifndef REP_G1
#define REP_G1 1
#endif
#ifndef REP_MIX
#define REP_MIX 1
#endif
__global__ void __launch_bounds__(512, 2) mega(Params p) {
    extern __shared__ __attribute__((aligned(16))) unsigned char lds[];
    cg::grid_group grid = cg::this_grid();
    const int lo = p.ph_lo, hi = p.ph_hi;
#define IN(k) (lo <= (k) && (k) < hi)
#define SYNC(k) do { if (IN(k) && IN((k) + 1)) xcd_barrier(xbar); } while (0)
    if (lo < 0) grid.sync();
    volatile LAS unsigned* xst = (volatile LAS unsigned*)((LAS unsigned char*)lds + (LDS_BYTES - 32));
    if (threadIdx.x < 2) xst[threadIdx.x] = 0u;
    __syncthreads();
    XcdBarrier xbar; xbar.bar = (unsigned*)(p.ws + WS_BAR); xbar.x = xb_xcc_id(); xbar.st = xst;
    if (threadIdx.x == 0) xst[2] = xb_add(&xbar.bar[XB_XCNT(xbar.x)], 1u);
    __syncthreads();
    const int xrank = (int)xst[2];
    int cu_c = (int)blockIdx.x;
#ifdef EXTRA_SYNC
    if (hi - lo > 1) {
#pragma unroll 1
        for (int r = 0; r < EXTRA_SYNC; ++r) grid.sync(); }
#endif
    if (IN(0)) {
#pragma unroll 1
        for (int r = 0; r < REP_PREP; ++r) phase_prep(p, lds); }
    SYNC(0);
    if (hi - lo > 1) {
        bool even = (gridDim.x % 8 == 0);
        for (unsigned j = 0; j < 16; ++j) { const unsigned cnt = xb_ld(&xbar.bar[XB_XCNT(j)]); even = even && (cnt == (j < 8 ? gridDim.x / 8 : 0u)); }
        if (even) cu_c = (int)xbar.x + 8 * xrank;
    }
#pragma unroll 1
    for (int l = 0; l < 2; ++l) {
        const int pb = 1 + 5 * l;
        if (IN(pb)) {
            pg8::Gemm g{(const bf16_t*)(p.ws + WS_H), (const bf16_t*)(p.ws + WS_WIN + l * SZ_WIN), TOK, NPAD, DM};
            pg8::StaticOrder S; S.init(TOK, NPAD, (int)gridDim.x, cu_c);
            EpiProj E{(bf16_t*)(p.ws + WS_PROJ)};
#pragma unroll 1
            for (int r = 0; r < REP_G1; ++r)
            pg8::gemm_phase<EpiProj, pg8::StaticOrder, GEMM_ALIGN, GEMM_SP2>((LAS unsigned char*)lds, g, S, E);
            { const int nwg = (TOK / 256) * (NPAD / 256), G = (int)gridDim.x, rem = nwg % G;
              if (rem == 0) convert_deferred(p, l, cu_c, G, lds);
              else if (cu_c >= rem) convert_deferred(p, l, cu_c - rem, G - rem, lds); }
        }
        SYNC(pb);
        if (IN(pb + 1)) { const LayerW W = layer_w(p, l);
#pragma unroll 1
          for (int r1 = 0; r1 < REP_M1; ++r1) {
            gla_pre_all((const bf16_t*)(p.ws + WS_PROJ), p.ws + WS_GP, W, lds);
            for (int it = blockIdx.x; it < 256; it += gridDim.x) lru_pre_item((const bf16_t*)(p.ws + WS_PROJ), (float*)(p.ws + WS_LA), (float*)(p.ws + WS_LU), W, it, lds); } }
        SYNC(pb + 1);
        if (IN(pb + 2)) {
#pragma unroll 1
            for (int r = 0; r < REP_MIX; ++r) phase_mix_fast(p, l, lds, r); }
        SYNC(pb + 2);
        if (IN(pb + 3)) {
            pg8::Gemm g{(const bf16_t*)(p.ws + WS_Y), (const bf16_t*)(p.ws + WS_WOUT + l * SZ_WOUT), TOK, DM, DM};
            pg8::StaticOrder S; S.init(TOK, DM, (int)gridDim.x, cu_c);
            EpiRes E{l == 0 ? p.in[0] : (const float*)(p.ws + WS_X1), l == 0 ? (float*)(p.ws + WS_X1) : p.out};
            pg8::gemm_phase<EpiRes, pg8::StaticOrder, GEMM_ALIGN, GEMM_SP2>((LAS unsigned char*)lds, g, S, E);
        }
        SYNC(pb + 3);
        if (l == 0) {
            if (IN(pb + 4)) rmsnorm_rows((const float*)(p.ws + WS_X1), p.in[1] + DM, (bf16_t*)(p.ws + WS_H));
            SYNC(pb + 4);
        }
    }
}

#ifndef COOP
#define COOP 1
#endif
extern "C" void kernel_launch(void* const* d_in, const int* in_sizes, int n_in, void* d_out, int out_size, void* d_ws, size_t ws_size, hipStream_t stream) {
    static int grid = 0;
    if (grid == 0) {
        if (n_in != 24 || ws_size < WS_END + 65536) { fprintf(stderr, "kernel_launch: unexpected n_in %d / ws %zu (need %zu)\n", n_in, ws_size, (size_t)WS_END); grid = -1; return; }
        if (hipFuncSetAttribute((const void*)mega, hipFuncAttributeMaxDynamicSharedMemorySize, LDS_BYTES) != hipSuccess) { fprintf(stderr, "kernel_launch: hipFuncSetAttribute failed\n"); grid = -1; return; }
        int dev = 0, cus = 0, per_cu = 0;
        hipGetDevice(&dev); hipDeviceGetAttribute(&cus, hipDeviceAttributeMultiprocessorCount, dev);
        hipOccupancyMaxActiveBlocksPerMultiprocessor(&per_cu, (const void*)mega, 512, LDS_BYTES);
        if (per_cu < 1) { fprintf(stderr, "kernel_launch: occupancy query says %d blocks/CU\n", per_cu); per_cu = 1; }
        grid = cus * 1;
        (void)hipGetLastError();
    }
    if (grid < 0) return;
    Params p{};
    for (int i = 0; i < 24; ++i) p.in[i] = (const float*)d_in[i];
    p.out = (float*)d_out; p.ws = (unsigned char*)d_ws;
    if (hipMemsetAsync((unsigned char*)d_ws + WS_CTR, 0, WS_CTL_BYTES, stream) != hipSuccess) { fprintf(stderr, "kernel_launch: memset failed\n"); return; }
#if COOP
    p.ph_lo = 0; p.ph_hi = NPH - 1 + 0;
    p.ph_hi = NPH;
    void* args[] = {&p};
    hipError_t e = hipLaunchCooperativeKernel((const void*)mega, dim3(grid), dim3(512), args, LDS_BYTES, stream);
    if (e != hipSuccess) fprintf(stderr, "cooperative launch failed: %s (grid %d)\n", hipGetErrorString(e), grid);
#else
    for (int ph = 0; ph < NPH; ++ph) { p.ph_lo = ph; p.ph_hi = ph + 1; hipLaunchKernelGGL(mega, dim3(grid), dim3(512), LDS_BYTES, stream, p); }
#endif
}
```

```cpp
#include <hip/hip_runtime.h>
#include <hip/hip_cooperative_groups.h>
#include <cstdio>
namespace cg = cooperative_groups;
namespace pg8 {
#define PG8_LAS __attribute__((address_space(3)))
typedef unsigned short bf16_t;
typedef short bf16x8 __attribute__((ext_vector_type(8)));
typedef float f32x4 __attribute__((ext_vector_type(4)));
typedef unsigned u32x4 __attribute__((ext_vector_type(4)));
constexpr int BM = 256, BK = 64, HALF = 128, HTB = HALF * BK * 2  , STAGE_BYTES = 8 * HTB, NXCD = 8, WGM = 4;

__host__ __device__ __forceinline__ int lds_byte(int r, int c) { const int st = (r >> 4) * 2 + (c >> 5), rr = r & 15, cc = c & 31, ob = rr * 64 + cc * 2; return st * 1024 + (ob ^ (((ob >> 9) & 1) << 5)); }
__host__ __device__ __forceinline__ void stage_rc(int b, int& R, int& C) { const int st = b / 1024, sb = b % 1024, swz = sb ^ (((sb >> 9) & 1) << 5); R = (st >> 1) * 16 + swz / 64; C = (st & 1) * 32 + (swz % 64) / 2; }
__host__ __device__ __forceinline__ int perm32(int rho) { const int n = rho >> 4, i = rho & 15; return 8 * (i >> 2) + 4 * n + (i & 3); }

struct Unit { int pm, pn; };
struct Gemm { const bf16_t* A; const bf16_t* Bt; int M, N, K; };

struct StaticOrder {
    int nM, nN, nwg, G, c;
    __host__ __device__ void init(int M, int N, int G_, int c_) { nM = M / BM; nN = N / BM; nwg = nM * nN; G = G_; c = c_; }
    __host__ __device__ bool next(int i, Unit& u) const {
        const long L = (long)i * G + c; if (L >= nwg) return false;
        int wgid = (int)L; { const int q = nwg / NXCD, r = nwg % NXCD, xcd = wgid % NXCD, off = wgid / NXCD; wgid = (xcd < r ? xcd * (q + 1) : r * (q + 1) + (xcd - r) * q) + off; }
        const int nig = WGM * nN, gid = wgid / nig, fm = gid * WGM, gsz = (nM - fm) < WGM ? (nM - fm) : WGM;
        u.pm = fm + ((wgid % nig) % gsz); u.pn = (wgid % nig) / gsz; return true;
    }
    __device__ __forceinline__ void a_ready(const Unit&) const {}
    __device__ __forceinline__ void done(const Unit&) const {}
};
__device__ __forceinline__ unsigned cvt_pk_bf16(float lo, float hi) { unsigned r; asm volatile("v_cvt_pk_bf16_f32 %0, %1, %2" : "=v"(r) : "v"(lo), "v"(hi)); return r; }
typedef float f32x2 __attribute__((ext_vector_type(2)));
template <class Epi, class Sched, bool ALIGN_EPI = false, bool SP2 = false>
__device__ __forceinline__ void gemm_phase(PG8_LAS unsigned char* lds, const Gemm g, const Sched& S, const Epi& E) {
    int tid_ = threadIdx.x; asm volatile("" : "+v"(tid_)); const int tid = tid_, wid = __builtin_amdgcn_readfirstlane(tid >> 6), lane = tid & 63, wr = wid >> 2, wc = wid & 3, fr = lane & 15, fq = lane >> 4;
    const int K = g.K, nt = K / BK;
    unsigned voffA[2], voffB[2];
#pragma unroll
    for (int i = 0; i < 2; ++i) { int R, C; stage_rc(tid * 16 + i * 8192, R, C); const int Rb = Epi::PERM ? ((R & ~31) + perm32(R & 31)) : R;
        voffA[i] = (unsigned)(R * K + C) * 2u; voffB[i] = (unsigned)(Rb * K + C) * 2u; }
    const size_t kstep = (size_t)(BK * 2);
    const size_t hstep = (size_t)HALF * K * 2;
    const size_t tstep = 2 * hstep;
    const unsigned ldsw = (unsigned)wid * 1024u;
    const int aoff = lds_byte(wr * 64 + fr, fq * 8), boff = lds_byte(wc * 32 + fr, fq * 8);
#define PG8_SA(b, h) (((b) * 2 + (h)) * HTB)
#define PG8_SB(b, h) ((4 + (b) * 2 + (h)) * HTB)
#define PG8_STAGE(bufoff, gbase, voff) do { _Pragma("unroll") for (int _i = 0; _i < 2; ++_i) \
        __builtin_amdgcn_global_load_lds((const unsigned*)((const char*)(gbase) + (voff)[_i]), (PG8_LAS unsigned*)(lds + (bufoff) + ldsw + _i * 8192), 16, 0, 0); } while (0)
#define PG8_LDA(dst, b, h) do { _Pragma("unroll") for (int m = 0; m < 4; ++m) _Pragma("unroll") for (int k = 0; k < 2; ++k) dst[m][k] = *(const PG8_LAS bf16x8*)(lds + PG8_SA(b, h) + aoff + m * 2048 + k * 1024); } while (0)
#define PG8_LDB(dst, b, h) do { _Pragma("unroll") for (int n = 0; n < 2; ++n) _Pragma("unroll") for (int k = 0; k < 2; ++k) dst[n][k] = *(const PG8_LAS bf16x8*)(lds + PG8_SB(b, h) + boff + n * 2048 + k * 1024); } while (0)
#define PG8_MMA(ai, bj, At, Bt) do { __builtin_amdgcn_s_setprio(1); _Pragma("unroll") for (int m = 0; m < 4; ++m) _Pragma("unroll") for (int n = 0; n < 2; ++n) _Pragma("unroll") for (int k = 0; k < 2; ++k) \
        acc[ai][bj][m][n] = __builtin_amdgcn_mfma_f32_16x16x32_bf16(Bt[n][k], At[m][k], acc[ai][bj][m][n], 0, 0, 0); __builtin_amdgcn_s_setprio(0); } while (0)
#define PG8_WAIT_V(n) asm volatile("s_waitcnt vmcnt(" #n ")" ::: "memory")
#define PG8_WAIT_L(n) asm volatile("s_waitcnt lgkmcnt(" #n ")" ::: "memory")
#define PG8_BAR __builtin_amdgcn_s_barrier()
#define PG8_SCHED __builtin_amdgcn_sched_barrier(0)
    Unit cur, nxt; int ui = 0;
    if (!S.next(0, cur)) return;
    f32x4 acc[2][2][4][2];
    E.init(acc, cur, wr, wc, fr, fq);
    bf16x8 At[4][2], B0[2][2], B1[2][2];
    const char* cA = (const char*)g.A + (size_t)cur.pm * tstep; const char* cB = (const char*)g.Bt + (size_t)cur.pn * tstep;
    S.a_ready(cur);
    if constexpr (SP2) {
        PG8_STAGE(PG8_SB(0, 0), cB, voffB); PG8_STAGE(PG8_SB(0, 1), cB + hstep, voffB); PG8_STAGE(PG8_SA(0, 0), cA, voffA); PG8_STAGE(PG8_SA(0, 1), cA + hstep, voffA);
        if (wr == 1) PG8_BAR;
        PG8_WAIT_V(2); PG8_BAR;
        PG8_STAGE(PG8_SB(1, 0), cB + kstep, voffB); PG8_STAGE(PG8_SA(1, 0), cA + kstep, voffA); PG8_STAGE(PG8_SB(1, 1), cB + hstep + kstep, voffB);
        PG8_WAIT_V(6); PG8_BAR;
    } else {
        PG8_STAGE(PG8_SB(0, 0), cB, voffB); PG8_STAGE(PG8_SA(0, 0), cA, voffA); PG8_STAGE(PG8_SB(0, 1), cB + hstep, voffB); PG8_STAGE(PG8_SA(0, 1), cA + hstep, voffA);
        if (wr == 1) PG8_BAR;
        PG8_WAIT_V(4); PG8_BAR;
        PG8_STAGE(PG8_SB(1, 0), cB + kstep, voffB); PG8_STAGE(PG8_SA(1, 0), cA + kstep, voffA); PG8_STAGE(PG8_SB(1, 1), cB + hstep + kstep, voffB);
        PG8_WAIT_V(6); PG8_BAR;
    }
    for (;;) {
        const bool has_next = S.next(ui + 1, nxt);
        const char* nA = has_next ? (const char*)g.A + (size_t)nxt.pm * tstep : cA; const char* nB = has_next ? (const char*)g.Bt + (size_t)nxt.pn * tstep : cB;
        for (int t = 0; t < nt; t += 2) {
            const bool last = (t == nt - 2);
            const char* a1 = cA + (size_t)(t + 1) * kstep;
            const char* a2 = last ? nA : cA + (size_t)(t + 2) * kstep; const char* b2 = last ? nB : cB + (size_t)(t + 2) * kstep;
            const char* a3 = a2 + kstep; const char* b3 = b2 + kstep;
            if (last && has_next) S.a_ready(nxt);
            if constexpr (SP2) {
            PG8_LDB(B0, 0, 0); PG8_LDB(B1, 0, 1); PG8_SCHED; PG8_LDA(At, 0, 0); PG8_STAGE(PG8_SA(1, 1), a1 + hstep, voffA);
            PG8_WAIT_V(8); PG8_WAIT_L(0); PG8_BAR; PG8_MMA(0, 0, At, B0); PG8_MMA(0, 1, At, B1); PG8_BAR; PG8_SCHED;
            PG8_LDA(At, 0, 1); PG8_STAGE(PG8_SB(0, 0), b2, voffB); PG8_STAGE(PG8_SB(0, 1), b2 + hstep, voffB); PG8_STAGE(PG8_SA(0, 0), a2, voffA);
            PG8_WAIT_V(8); PG8_WAIT_L(0); PG8_BAR; PG8_MMA(1, 0, At, B0); PG8_MMA(1, 1, At, B1); PG8_BAR; PG8_SCHED;
            PG8_LDB(B0, 1, 0); PG8_LDB(B1, 1, 1); PG8_SCHED; PG8_LDA(At, 1, 0); PG8_STAGE(PG8_SA(0, 1), a2 + hstep, voffA);
            PG8_WAIT_V(8); PG8_WAIT_L(0); PG8_BAR; PG8_MMA(0, 0, At, B0); PG8_MMA(0, 1, At, B1); PG8_BAR; PG8_SCHED;
            PG8_LDA(At, 1, 1); PG8_STAGE(PG8_SB(1, 0), b3, voffB); PG8_STAGE(PG8_SB(1, 1), b3 + hstep, voffB); PG8_STAGE(PG8_SA(1, 0), a3, voffA);
            PG8_WAIT_V(8); PG8_WAIT_L(0); PG8_BAR; PG8_MMA(1, 0, At, B0); PG8_MMA(1, 1, At, B1); PG8_BAR; PG8_SCHED;
            } else {
            PG8_LDB(B0, 0, 0); PG8_SCHED; PG8_LDA(At, 0, 0); PG8_STAGE(PG8_SA(1, 1), a1 + hstep, voffA);
            PG8_WAIT_L(8); PG8_BAR; PG8_WAIT_L(0); PG8_MMA(0, 0, At, B0); PG8_BAR; PG8_SCHED;
            PG8_LDB(B1, 0, 1); PG8_STAGE(PG8_SB(0, 0), b2, voffB);
            PG8_BAR; PG8_WAIT_L(0); PG8_MMA(0, 1, At, B1); PG8_BAR;
            PG8_LDA(At, 0, 1); PG8_STAGE(PG8_SA(0, 0), a2, voffA);
            PG8_BAR; PG8_WAIT_L(0); PG8_MMA(1, 0, At, B0); PG8_BAR; PG8_SCHED;
            PG8_STAGE(PG8_SB(0, 1), b2 + hstep, voffB);
            PG8_WAIT_V(6); PG8_BAR; PG8_MMA(1, 1, At, B1); PG8_BAR;
            PG8_LDB(B0, 1, 0); PG8_SCHED; PG8_LDA(At, 1, 0); PG8_STAGE(PG8_SA(0, 1), a2 + hstep, voffA);
            PG8_WAIT_L(8); PG8_BAR; PG8_WAIT_L(0); PG8_MMA(0, 0, At, B0); PG8_BAR; PG8_SCHED;
            PG8_LDB(B1, 1, 1); PG8_STAGE(PG8_SB(1, 0), b3, voffB);
            PG8_BAR; PG8_WAIT_L(0); PG8_MMA(0, 1, At, B1); PG8_BAR;
            PG8_LDA(At, 1, 1); PG8_STAGE(PG8_SA(1, 0), a3, voffA);
            PG8_BAR; PG8_WAIT_L(0); PG8_MMA(1, 0, At, B0); PG8_BAR; PG8_SCHED;
            PG8_STAGE(PG8_SB(1, 1), b3 + hstep, voffB);
            PG8_WAIT_V(6); PG8_BAR; PG8_MMA(1, 1, At, B1); PG8_BAR;
            }
        }
        if constexpr (ALIGN_EPI) { if (wr == 0) PG8_BAR; }
        if constexpr (!Epi::AFTER_DRAIN) { E(acc, cur, wr, wc, fr, fq); S.done(cur); }
        if (!has_next) break;
        E.init(acc, nxt, wr, wc, fr, fq);
        cur = nxt; cA = nA; cB = nB; ++ui;
        if constexpr (ALIGN_EPI) { if (wr == 1) PG8_BAR; }
    }
    PG8_WAIT_V(0);
    if constexpr (!ALIGN_EPI) { if (wr == 0) PG8_BAR; }
    PG8_BAR;
    if constexpr (Epi::AFTER_DRAIN) { E.fused(acc, cur, wr, wc, fr, fq, lds, wid, lane); S.done(cur); }
#undef PG8_SA
#undef PG8_SB
#undef PG8_STAGE
#undef PG8_LDA
#undef PG8_LDB
#undef PG8_MMA
#undef PG8_WAIT_V
#undef PG8_WAIT_L
#undef PG8_BAR
#undef PG8_SCHED
}
}

#define LAS __attribute__((address_space(3)))
typedef unsigned short bf16_t;
typedef float f32x4 __attribute__((ext_vector_type(4)));
typedef unsigned u32x4 __attribute__((ext_vector_type(4)));
constexpr int TOK = 8192, SEQ = 2048, DM = 4096, NIN = 11792, NPAD = 12032;
constexpr int C_GQ = 0, C_GK = 512, C_GV = 1024, C_SQ = 2048, C_SK = 3072, C_SV = 3328, C_DQ = 3584, C_DK = 4608, C_DV = 5632, C_RX = 6656, C_GATE = 7680, C_GA = 11776;
constexpr float EPS = 1e-6f;
constexpr int LDS_BYTES = 152 * 1024;
constexpr int NPH = 10;
constexpr int XCD_BAR_WORDS_C = 3456;
constexpr size_t WS_WIN = 0;
constexpr size_t SZ_WIN = (size_t)NPAD * DM * 2;
constexpr size_t WS_WOUT = WS_WIN + 2 * SZ_WIN;
constexpr size_t SZ_WOUT = (size_t)DM * DM * 2;
constexpr size_t WS_H = WS_WOUT + 2 * SZ_WOUT;
constexpr size_t WS_PROJ = WS_H + (size_t)TOK * DM * 2;
constexpr size_t WS_Y = WS_PROJ + (size_t)TOK * NPAD * 2;
constexpr size_t WS_X1 = WS_Y + (size_t)TOK * DM * 2;
constexpr size_t WS_LA = WS_X1 + (size_t)TOK * DM * 4;
constexpr size_t WS_LU = WS_LA + (size_t)TOK * 1024 * 4;
constexpr size_t WS_GP = WS_LU + (size_t)TOK * 1024 * 4;
constexpr size_t WS_END = WS_GP + (size_t)1024 * 41216;

struct Params { const float* in[24]; float* out; unsigned char* ws; int ph_lo, ph_hi; };

__device__ __forceinline__ int tid_opaque() { int t = threadIdx.x; asm volatile("" : "+v"(t)); return t; }
__device__ __forceinline__ float bf2f(bf16_t b) { return __uint_as_float(((unsigned)b) << 16); }
typedef __bf16 bf16v2_t __attribute__((ext_vector_type(2)));
typedef float f32v2_t __attribute__((ext_vector_type(2)));
__device__ __forceinline__ unsigned cvt2(float lo, float hi) { f32v2_t f = {lo, hi}; bf16v2_t b = __builtin_convertvector(f, bf16v2_t); return __builtin_bit_cast(unsigned, b); }
__device__ __forceinline__ bf16_t f2bf(float f) { return (bf16_t)(cvt2(f, f) & 0xffffu); }
__device__ __forceinline__ unsigned pk2(float lo, float hi) { return cvt2(lo, hi); }
__device__ __forceinline__ float wsum(float v) { for (int o = 32; o; o >>= 1) v += __shfl_xor(v, o); return v; }
__device__ __forceinline__ float wmax(float v) { for (int o = 32; o; o >>= 1) v = fmaxf(v, __shfl_xor(v, o)); return v; }
__device__ __forceinline__ float siluf(float x) { return x / (1.f + __expf(-x)); }
__device__ __forceinline__ float sigmf(float x) { return 1.f / (1.f + __expf(-x)); }
__device__ __forceinline__ void unpack8(const uint4 u, float* f) {
    f[0] = __uint_as_float(u.x << 16); f[1] = __uint_as_float(u.x & 0xffff0000u); f[2] = __uint_as_float(u.y << 16); f[3] = __uint_as_float(u.y & 0xffff0000u);
    f[4] = __uint_as_float(u.z << 16); f[5] = __uint_as_float(u.z & 0xffff0000u); f[6] = __uint_as_float(u.w << 16); f[7] = __uint_as_float(u.w & 0xffff0000u);
}

struct EpiProj {
    static constexpr bool PERM = true, AFTER_DRAIN = false;
    bf16_t* O;
    __device__ __forceinline__ void init(f32x4 (&acc)[2][2][4][2], const pg8::Unit&, int, int, int, int) const {
#pragma unroll
        for (int a = 0; a < 2; ++a)
#pragma unroll
            for (int b = 0; b < 2; ++b)
#pragma unroll
                for (int m = 0; m < 4; ++m)
#pragma unroll
                    for (int n = 0; n < 2; ++n) acc[a][b][m][n] = (f32x4){0.f, 0.f, 0.f, 0.f};
    }
    __device__ __forceinline__ void operator()(const f32x4 (&acc)[2][2][4][2], const pg8::Unit& u, int wr, int wc, int fr, int fq) const {
        const int row0 = u.pm * 256 + wr * 64 + fr, col0 = u.pn * 256 + wc * 32 + 8 * fq;
        const bool act = (u.pn >= 30 && u.pn < 46);
#pragma unroll
        for (int ai = 0; ai < 2; ++ai)
#pragma unroll
            for (int m = 0; m < 4; ++m) { bf16_t* rowp = O + (size_t)(row0 + ai * 128 + m * 16) * NPAD + col0;
#pragma unroll
                for (int bj = 0; bj < 2; ++bj) { f32x4 v0 = acc[ai][bj][m][0], v1 = acc[ai][bj][m][1];
                    if (act) {
#pragma unroll
                        for (int j = 0; j < 4; ++j) { v0[j] = v0[j] * __builtin_amdgcn_rcpf(1.f + __builtin_amdgcn_exp2f(-1.4426950408889634f * v0[j])); v1[j] = v1[j] * __builtin_amdgcn_rcpf(1.f + __builtin_amdgcn_exp2f(-1.4426950408889634f * v1[j])); } }
                    u32x4 w; w.x = pg8::cvt_pk_bf16(v0[0], v0[1]); w.y = pg8::cvt_pk_bf16(v0[2], v0[3]); w.z = pg8::cvt_pk_bf16(v1[0], v1[1]); w.w = pg8::cvt_pk_bf16(v1[2], v1[3]);
                    *(u32x4*)(rowp + bj * 128) = w; } }
    }
};
struct EpiRes {
    static constexpr bool PERM = false, AFTER_DRAIN = false;
    const float* R; float* C;
    __device__ __forceinline__ void init(f32x4 (&acc)[2][2][4][2], const pg8::Unit& u, int wr, int wc, int fr, int fq) const {
        const int row0 = u.pm * 256 + wr * 64 + fr, col0 = u.pn * 256 + wc * 32 + 4 * fq;
#pragma unroll
        for (int ai = 0; ai < 2; ++ai)
#pragma unroll
            for (int m = 0; m < 4; ++m) { const size_t off = (size_t)(row0 + ai * 128 + m * 16) * DM + col0;
#pragma unroll
                for (int bj = 0; bj < 2; ++bj)
#pragma unroll
                    for (int n = 0; n < 2; ++n) acc[ai][bj][m][n] = *(const f32x4*)(R + off + bj * 128 + n * 16); }
    }
    __device__ __forceinline__ void operator()(const f32x4 (&acc)[2][2][4][2], const pg8::Unit& u, int wr, int wc, int fr, int fq) const {
        const int row0 = u.pm * 256 + wr * 64 + fr, col0 = u.pn * 256 + wc * 32 + 4 * fq;
#pragma unroll
        for (int ai = 0; ai < 2; ++ai)
#pragma unroll
            for (int m = 0; m < 4; ++m) { const size_t off = (size_t)(row0 + ai * 128 + m * 16) * DM + col0;
#pragma unroll
                for (int bj = 0; bj < 2; ++bj)
#pragma unroll
                    for (int n = 0; n < 2; ++n) *(f32x4*)(C + off + bj * 128 + n * 16) = acc[ai][bj][m][n]; }
    }
};

constexpr int NDEF = 1536;
constexpr int HOST0 = 1024;
constexpr int PREP_TILES = 6016;
constexpr int DHOST_WIN = 6016 - HOST0, DHOST = DHOST_WIN + 2048 - NDEF;
struct TrTile { const float* W; bf16_t* WT; int ld, nt, kt; bool permute; };
__device__ __forceinline__ TrTile tr_tile(const Params& p, int t) {
    TrTile r; int q = t; const int l = 0;
    r.W = p.in[2] + (size_t)l * DM * NIN; r.WT = (bf16_t*)(p.ws + WS_WIN + l * SZ_WIN); r.ld = NIN; r.permute = true;
    r.nt = q >> 5; r.kt = q & 31; return r;
}
__device__ __forceinline__ void tr_load(const TrTile& T, int tid, f32x4 (&v)[4]) {
#pragma unroll
    for (int i = 0; i < 2; ++i) {
        const int idx = tid + 512 * i, kp = idx >> 4, c4 = idx & 15;
        const int nd = T.nt * 64 + c4 * 4;
        int ns = nd;
        if (T.permute) { ns = (nd < 2048) ? nd : ((nd < 11776) ? nd + 16 : ((nd < 11792) ? nd - 11776 + 2048 : -1)); }
        v[2 * i] = (f32x4){0.f, 0.f, 0.f, 0.f}; v[2 * i + 1] = v[2 * i];
        if (ns >= 0) { const float* q = T.W + (size_t)(T.kt * 128 + 2 * kp) * T.ld + ns; v[2 * i] = __builtin_nontemporal_load((const f32x4*)q); v[2 * i + 1] = __builtin_nontemporal_load((const f32x4*)(q + T.ld)); }
    }
}
__device__ __forceinline__ void tr_stage(int tid, const f32x4 (&v)[4], unsigned* lds) {
#pragma unroll
    for (int i = 0; i < 2; ++i) {
        const int idx = tid + 512 * i, kp = idx >> 4, c4 = idx & 15;
        const f32x4 a = v[2 * i], b = v[2 * i + 1];
        unsigned* d = lds + kp * 65 + c4 * 4;
        d[0] = pk2(a[0], b[0]); d[1] = pk2(a[1], b[1]); d[2] = pk2(a[2], b[2]); d[3] = pk2(a[3], b[3]);
    }
}
__device__ __forceinline__ void tr_flush(const TrTile& T, int tid, const unsigned* lds) {
#pragma unroll
    for (int i = 0; i < 2; ++i) {
        const int idx = tid + 512 * i, kc = idx & 15, n = idx >> 4;
        uint4 o; o.x = lds[(kc * 4 + 0) * 65 + n]; o.y = lds[(kc * 4 + 1) * 65 + n]; o.z = lds[(kc * 4 + 2) * 65 + n]; o.w = lds[(kc * 4 + 3) * 65 + n];
        *(uint4*)(T.WT + (size_t)(T.nt * 64 + n) * DM + T.kt * 128 + kc * 8) = o;
    }
}
__device__ __forceinline__ void tr_store(const TrTile& T, int tid, const f32x4 (&v)[4], unsigned* lds) {
#pragma unroll
    for (int i = 0; i < 2; ++i) {
        const int idx = tid + 512 * i, kp = idx >> 4, c4 = idx & 15;
        const f32x4 a = v[2 * i], b = v[2 * i + 1];
        unsigned* d = lds + kp * 65 + c4 * 4;
        d[0] = pk2(a[0], b[0]); d[1] = pk2(a[1], b[1]); d[2] = pk2(a[2], b[2]); d[3] = pk2(a[3], b[3]);
    }
    __syncthreads();
#pragma unroll
    for (int i = 0; i < 2; ++i) {
        const int idx = tid + 512 * i, kc = idx & 15, n = idx >> 4;
        uint4 o; o.x = lds[(kc * 4 + 0) * 65 + n]; o.y = lds[(kc * 4 + 1) * 65 + n]; o.z = lds[(kc * 4 + 2) * 65 + n]; o.w = lds[(kc * 4 + 3) * 65 + n];
        *(uint4*)(T.WT + (size_t)(T.nt * 64 + n) * DM + T.kt * 128 + kc * 8) = o;
    }
    __syncthreads();
}

__device__ __forceinline__ void rmsnorm_rows(const float* __restrict__ X, const float* __restrict__ w, bf16_t* __restrict__ H) {
    const int tid = tid_opaque(), lane = tid & 63, wave = tid >> 6;
    for (int row = blockIdx.x * 8 + wave; row < TOK; row += gridDim.x * 8) {
        const float4* xp = (const float4*)(X + (size_t)row * DM);
        float4 v[16]; float ss = 0.f;
#pragma unroll
        for (int i = 0; i < 16; ++i) { v[i] = xp[lane + 64 * i]; ss += v[i].x * v[i].x + v[i].y * v[i].y + v[i].z * v[i].z + v[i].w * v[i].w; }
        ss = wsum(ss);
        const float rstd = rsqrtf(ss * (1.f / DM) + EPS);
#pragma unroll
        for (int i = 0; i < 16; ++i) { const float4 g = ((const float4*)w)[lane + 64 * i];
            uint2 o; o.x = pk2(v[i].x * rstd * g.x, v[i].y * rstd * g.y); o.y = pk2(v[i].z * rstd * g.z, v[i].w * rstd * g.w);
            *(uint2*)(H + (size_t)row * DM + 4 * (lane + 64 * i)) = o; }
    }
}

__device__ __forceinline__ void phase_prep(const Params& p, unsigned char* lds) {
    const bool rows_first = (blockIdx.x & 1) != 0;
    if (rows_first) rmsnorm_rows(p.in[0], p.in[1], (bf16_t*)(p.ws + WS_H));
    { const int tid = tid_opaque();
      f32x4 va[4], vb[4];
      int t = blockIdx.x;
      TrTile T = tr_tile(p, t < PREP_TILES ? t : 0);
      if (t < PREP_TILES) tr_load(T, tid, va);
#pragma unroll 1
      while (t < PREP_TILES) {
          const int tn = t + gridDim.x;
          const TrTile Tn = tr_tile(p, tn < PREP_TILES ? tn : 0);
          if (tn < PREP_TILES) tr_load(Tn, tid, vb);
          tr_store(T, tid, va, (unsigned*)lds);
#pragma unroll
          for (int i = 0; i < 4; ++i) va[i] = vb[i];
          T = Tn; t = tn;
      } }
    if (!rows_first) rmsnorm_rows(p.in[0], p.in[1], (bf16_t*)(p.ws + WS_H));
}

__device__ __forceinline__ bool host_tile(const Params& p, int l, int hidx, TrTile& T) {
    if (l == 0) { if (hidx >= HOST0) return false;
        T.W = p.in[2] + (size_t)DM * NIN; T.WT = (bf16_t*)(p.ws + WS_WIN + SZ_WIN); T.ld = NIN; T.permute = true; T.nt = hidx >> 5; T.kt = hidx & 31; return true; }
    const int r = NDEF + hidx; if (r >= 2048) return false;
    T.W = p.in[3] + (size_t)DM * DM; T.WT = (bf16_t*)(p.ws + WS_WOUT + SZ_WOUT); T.ld = DM; T.permute = false; T.nt = r >> 5; T.kt = r & 31; return true;
}
__device__ __forceinline__ bool diff_host_tile(const Params& p, int l, int s, TrTile& T) {
    if (l != 0 || s >= DHOST) return false;
    if (s < DHOST_WIN) { const int q = HOST0 + s; T.W = p.in[2] + (size_t)DM * NIN; T.WT = (bf16_t*)(p.ws + WS_WIN + SZ_WIN); T.ld = NIN; T.permute = true; T.nt = q >> 5; T.kt = q & 31; return true; }
    const int r = NDEF + (s - DHOST_WIN); T.W = p.in[3]; T.WT = (bf16_t*)(p.ws + WS_WOUT); T.ld = DM; T.permute = false; T.nt = r >> 5; T.kt = r & 31; return true;
}
__device__ __forceinline__ TrTile tr_tile_wout(const Params& p, int l, int r) {
    TrTile T; T.W = p.in[3] + (size_t)l * DM * DM; T.WT = (bf16_t*)(p.ws + WS_WOUT + l * SZ_WOUT); T.ld = DM; T.permute = false; T.nt = r >> 5; T.kt = r & 31; return T;
}
__device__ __forceinline__ void convert_deferred(const Params& p, int l, int rank, int nidle, unsigned char* lds) {
    const int tid = tid_opaque();
    f32x4 va[4], vb[4];
    int r = rank;
    TrTile T = tr_tile_wout(p, l, r < NDEF ? r : 0);
    if (r < NDEF) tr_load(T, tid, va);
#pragma unroll 1
    while (r < NDEF) {
        const int rn = r + nidle;
        const TrTile Tn = tr_tile_wout(p, l, rn < NDEF ? rn : 0);
        if (rn < NDEF) tr_load(Tn, tid, vb);
        tr_store(T, tid, va, (unsigned*)lds);
#pragma unroll
        for (int i = 0; i < 4; ++i) va[i] = vb[i];
        T = Tn; r = rn;
    }
}

struct LayerW {
    const float *gla_w_up, *gla_b_up, *gla_nw, *swa_qn, *swa_kn, *swa_sinks, *dq_n, *dk_n, *lq1, *lk1, *lq2, *lk2, *d_on, *conv_w, *conv_b, *w_r, *b_r, *w_i, *b_i, *lam;
    float lambda_init;
};
__device__ __forceinline__ LayerW layer_w(const Params& p, int l) {
    LayerW w;
    w.gla_w_up = p.in[4] + l * 16 * 512; w.gla_b_up = p.in[5] + l * 512; w.gla_nw = p.in[6] + l * 128;
    w.swa_qn = p.in[7] + l * 128; w.swa_kn = p.in[8] + l * 128; w.swa_sinks = p.in[9] + l * 8;
    w.dq_n = p.in[10] + l * 64; w.dk_n = p.in[11] + l * 64; w.lq1 = p.in[12] + l * 64; w.lk1 = p.in[13] + l * 64; w.lq2 = p.in[14] + l * 64; w.lk2 = p.in[15] + l * 64;
    w.d_on = p.in[16] + l * 128; w.conv_w = p.in[17] + l * 4096; w.conv_b = p.in[18] + l * 1024;
    w.w_r = p.in[19] + l * 8 * 128 * 128; w.b_r = p.in[20] + l * 1024; w.w_i = p.in[21] + l * 8 * 128 * 128; w.b_i = p.in[22] + l * 1024; w.lam = p.in[23] + l * 1024;
    w.lambda_init = 0.8f - 0.6f * expf(-0.3f * (float)l);
    return w;
}

__device__ void gla_simple(const bf16_t* __restrict__ P, bf16_t* __restrict__ Y, const LayerW& W, int bh, float* lds) {
    const int b = bh >> 3, h = bh & 7, tid = tid_opaque();
    float* sAl = lds; float* sQ = sAl + 2048; float* sK = sQ + 2048; float* sV = sK + 2048; float* sPo = sV + 4096; float* sW = sPo + 16384;
    __syncthreads();
    for (int i = tid; i < 1024; i += 512) sW[i] = W.gla_w_up[(i >> 6) * 512 + h * 64 + (i & 63)];
    if (tid < 64) sW[1024 + tid] = W.gla_b_up[h * 64 + tid];
    const int v = tid & 127, dg = tid >> 7;
    float s[16];
#pragma unroll
    for (int i = 0; i < 16; ++i) s[i] = 0.f;
    for (int c = 0; c < 64; ++c) {
        __syncthreads();
        const int tok0 = b * SEQ + c * 32;
        for (int i = tid; i < 2048; i += 512) { const int tt = i >> 6, d = i & 63; const bf16_t* row = P + (size_t)(tok0 + tt) * NPAD;
            float lg = sW[1024 + d];
#pragma unroll
            for (int r = 0; r < 16; ++r) lg += bf2f(row[C_GA + r]) * sW[r * 64 + d];
            const float ls = fminf(lg, 0.f) - log1pf(expf(-fabsf(lg)));
            sAl[i] = expf(ls * (1.f / 16.f));
            sQ[i] = bf2f(row[C_GQ + h * 64 + d]) * 0.125f;
            sK[i] = bf2f(row[C_GK + h * 64 + d]); }
        for (int i = tid; i < 4096; i += 512) { const int tt = i >> 7, vv = i & 127; sV[i] = bf2f(P[(size_t)(tok0 + tt) * NPAD + C_GV + h * 128 + vv]); }
        __syncthreads();
        for (int tt = 0; tt < 32; ++tt) {
            const float vt = sV[tt * 128 + v]; float po = 0.f;
#pragma unroll
            for (int i = 0; i < 16; ++i) { const int d = dg * 16 + i; s[i] = sAl[tt * 64 + d] * s[i] + sK[tt * 64 + d] * vt; po += sQ[tt * 64 + d] * s[i]; }
            sPo[(dg * 32 + tt) * 128 + v] = po;
        }
        __syncthreads();
        { const int tt = tid >> 4, v0 = (tid & 15) * 8; float o[8]; float ss = 0.f;
#pragma unroll
            for (int j = 0; j < 8; ++j) { o[j] = sPo[(0 * 32 + tt) * 128 + v0 + j] + sPo[(1 * 32 + tt) * 128 + v0 + j] + sPo[(2 * 32 + tt) * 128 + v0 + j] + sPo[(3 * 32 + tt) * 128 + v0 + j]; ss += o[j] * o[j]; }
            ss += __shfl_xor(ss, 1); ss += __shfl_xor(ss, 2); ss += __shfl_xor(ss, 4); ss += __shfl_xor(ss, 8);
            const float rstd = rsqrtf(ss * (1.f / 128.f) + EPS);
            const bf16_t* gp = P + (size_t)(tok0 + tt) * NPAD + C_GATE + h * 128 + v0;
            bf16_t* yp = Y + (size_t)(tok0 + tt) * DM + h * 128 + v0;
#pragma unroll
            for (int j = 0; j < 8; ++j) yp[j] = f2bf(o[j] * rstd * W.gla_nw[v0 + j] * bf2f(gp[j])); }
    }
    __syncthreads();
}

__device__ void swa_simple_row(const bf16_t* __restrict__ P, bf16_t* __restrict__ Y, const LayerW& W, int row, float* wl) {
    const int lane = tid_opaque() & 63;
    const int bh = row & 31, b = bh >> 3, hq = bh & 7, q = row >> 5, kvh = hq >> 2;
    const size_t tok = (size_t)b * SEQ + q;
    const bf16_t* qp = P + tok * NPAD + C_SQ + hq * 128;
    const float q0 = bf2f(qp[2 * lane]), q1 = bf2f(qp[2 * lane + 1]);
    const float rq = rsqrtf(wsum(q0 * q0 + q1 * q1) * (1.f / 128.f) + EPS) * 0.08838834764831845f;
    __threadfence_block();
    wl[2 * lane] = q0 * rq * W.swa_qn[2 * lane] * W.swa_kn[2 * lane];
    wl[2 * lane + 1] = q1 * rq * W.swa_qn[2 * lane + 1] * W.swa_kn[2 * lane + 1];
    __threadfence_block();
    const float slope = exp2f(-(float)(hq + 1)), sink = W.swa_sinks[hq];
    float sc[2];
#pragma unroll
    for (int i = 0; i < 2; ++i) {
        const int j = q - 127 + lane + 64 * i;
        sc[i] = -INFINITY;
        if (j >= 0) { const uint4* kp = (const uint4*)(P + ((size_t)b * SEQ + j) * NPAD + C_SK + kvh * 128);
            float dot = 0.f, ssk = 0.f;
            for (int c = 0; c < 16; ++c) { float f[8]; unpack8(kp[c], f);
#pragma unroll
                for (int e = 0; e < 8; ++e) { dot += wl[c * 8 + e] * f[e]; ssk += f[e] * f[e]; } }
            sc[i] = dot * rsqrtf(ssk * (1.f / 128.f) + EPS) - slope * (float)(q - j); }
    }
    const float m = fmaxf(wmax(fmaxf(sc[0], sc[1])), sink);
    const float p0 = (sc[0] == -INFINITY) ? 0.f : __expf(sc[0] - m), p1 = (sc[1] == -INFINITY) ? 0.f : __expf(sc[1] - m);
    const float inv = 1.f / (wsum(p0 + p1) + __expf(sink - m));
    wl[128 + lane] = p0 * inv; wl[192 + lane] = p1 * inv;
    __threadfence_block();
    float o0 = 0.f, o1 = 0.f;
    for (int jj = 0; jj < 128; ++jj) { const int j = q - 127 + jj; if (j < 0) continue;
        const unsigned vv = *(const unsigned*)(P + ((size_t)b * SEQ + j) * NPAD + C_SV + kvh * 128 + 2 * lane);
        const float pj = wl[128 + jj]; o0 += pj * __uint_as_float(vv << 16); o1 += pj * __uint_as_float(vv & 0xffff0000u); }
    const unsigned gg = *(const unsigned*)(P + tok * NPAD + C_GATE + 1024 + hq * 128 + 2 * lane);
    *(unsigned*)(Y + tok * DM + 1024 + hq * 128 + 2 * lane) = pk2(o0 * __uint_as_float(gg << 16), o1 * __uint_as_float(gg & 0xffff0000u));
    __threadfence_block();
}

__device__ void diff_simple_row(const bf16_t* __restrict__ P, bf16_t* __restrict__ Y, const LayerW& W, float lam, int row, float* wl) {
    const int lane = tid_opaque() & 63;
    const int bh = row & 31, b = bh >> 3, h = bh & 7, q = row >> 5;
    const size_t tok = (size_t)b * SEQ + q;
    const bf16_t* qp = P + tok * NPAD + C_DQ + h * 128;
    const float x0 = bf2f(qp[lane]), x1 = bf2f(qp[64 + lane]);
    const float r0 = rsqrtf(wsum(x0 * x0) * (1.f / 64.f) + EPS) * 0.125f, r1 = rsqrtf(wsum(x1 * x1) * (1.f / 64.f) + EPS) * 0.125f;
    __threadfence_block();
    wl[lane] = x0 * r0 * W.dq_n[lane] * W.dk_n[lane]; wl[64 + lane] = x1 * r1 * W.dq_n[lane] * W.dk_n[lane];
    __threadfence_block();
    float* S0 = wl + 128; float* S1 = S0 + 2048;
    const float slope = exp2f(-(float)(h + 1));
    const int nk = q + 1;
    float m0 = -INFINITY, m1 = -INFINITY;
    for (int j = lane; j < nk; j += 64) {
        const uint4* kp = (const uint4*)(P + ((size_t)b * SEQ + j) * NPAD + C_DK + h * 128);
        float d0 = 0.f, k0 = 0.f, d1 = 0.f, k1 = 0.f;
        for (int c = 0; c < 8; ++c) { float f[8]; unpack8(kp[c], f);
#pragma unroll
            for (int e = 0; e < 8; ++e) { d0 += wl[c * 8 + e] * f[e]; k0 += f[e] * f[e]; } }
        for (int c = 0; c < 8; ++c) { float f[8]; unpack8(kp[8 + c], f);
#pragma unroll
            for (int e = 0; e < 8; ++e) { d1 += wl[64 + c * 8 + e] * f[e]; k1 += f[e] * f[e]; } }
        const float al = slope * (float)(q - j);
        const float s0 = d0 * rsqrtf(k0 * (1.f / 64.f) + EPS) - al, s1 = d1 * rsqrtf(k1 * (1.f / 64.f) + EPS) - al;
        S0[j] = s0; S1[j] = s1; m0 = fmaxf(m0, s0); m1 = fmaxf(m1, s1);
    }
    m0 = wmax(m0); m1 = wmax(m1);
    float l0 = 0.f, l1 = 0.f;
    for (int j = lane; j < nk; j += 64) { l0 += __expf(S0[j] - m0); l1 += __expf(S1[j] - m1); }
    l0 = 1.f / wsum(l0); l1 = lam / wsum(l1);
    for (int j = lane; j < nk; j += 64) S0[j] = __expf(S0[j] - m0) * l0 - __expf(S1[j] - m1) * l1;
    __threadfence_block();
    float o0 = 0.f, o1 = 0.f;
    const bf16_t* vp = P + (size_t)b * SEQ * NPAD + C_DV + h * 128 + 2 * lane;
    for (int j = 0; j < nk; ++j) { const unsigned vv = *(const unsigned*)(vp + (size_t)j * NPAD); const float wj = S0[j];
        o0 += wj * __uint_as_float(vv << 16); o1 += wj * __uint_as_float(vv & 0xffff0000u); }
    const float rstd = rsqrtf(wsum(o0 * o0 + o1 * o1) * (1.f / 128.f) + EPS) * (1.f - W.lambda_init);
    const unsigned gg = *(const unsigned*)(P + tok * NPAD + C_GATE + 2048 + h * 128 + 2 * lane);
    *(unsigned*)(Y + tok * DM + 2048 + h * 128 + 2 * lane) = pk2(o0 * rstd * W.d_on[2 * lane] * __uint_as_float(gg << 16), o1 * rstd * W.d_on[2 * lane + 1] * __uint_as_float(gg & 0xffff0000u));
    __threadfence_block();
}

__device__ void lru_gates_simple(const bf16_t* __restrict__ P, float* __restrict__ LA, float* __restrict__ LU, const LayerW& W, int unit, float* sXc) {
    const int tid = tid_opaque(), tg = unit >> 3, n = unit & 7, tok0 = tg * 16, t0 = tok0 & (SEQ - 1);
    __syncthreads();
#pragma unroll
    for (int e = 0; e < 4; ++e) { const int i = tid + 512 * e, tt = i >> 7, c = i & 127, ch = n * 128 + c;
        float xc = W.conv_b[ch];
#pragma unroll
        for (int w = 0; w < 4; ++w) { const int tp = t0 + tt - 3 + w; if (tp >= 0) xc += W.conv_w[w * 1024 + ch] * bf2f(P[(size_t)(tok0 + tt - 3 + w) * NPAD + C_RX + ch]); }
        sXc[i] = xc; }
    __syncthreads();
    const int tt = tid >> 5, jg = tid & 31, ch0 = n * 128 + jg * 4;
    float4 r = *(const float4*)(W.b_r + ch0), g = *(const float4*)(W.b_i + ch0);
    const float* wr = W.w_r + (size_t)n * 16384 + jg * 4; const float* wi = W.w_i + (size_t)n * 16384 + jg * 4;
    for (int i = 0; i < 128; ++i) { const float x = sXc[tt * 128 + i]; const float4 a = *(const float4*)(wr + i * 128), c = *(const float4*)(wi + i * 128);
        r.x += x * a.x; r.y += x * a.y; r.z += x * a.z; r.w += x * a.w; g.x += x * c.x; g.y += x * c.y; g.z += x * c.z; g.w += x * c.w; }
    float rr[4] = {r.x, r.y, r.z, r.w}, gg[4] = {g.x, g.y, g.z, g.w}, av[4], uv[4];
#pragma unroll
    for (int e = 0; e < 4; ++e) { const float x = -W.lam[ch0 + e]; const float sp = (x > 20.f) ? x : log1pf(expf(x));
        const float la = -8.f * sigmf(rr[e]) * sp; av[e] = expf(la); uv[e] = sqrtf(-expm1f(2.f * la)) * sigmf(gg[e]) * sXc[tt * 128 + jg * 4 + e]; }
    *(float4*)(LA + (size_t)(tok0 + tt) * 1024 + ch0) = make_float4(av[0], av[1], av[2], av[3]);
    *(float4*)(LU + (size_t)(tok0 + tt) * 1024 + ch0) = make_float4(uv[0], uv[1], uv[2], uv[3]);
}

__device__ void lru_scan_simple(const bf16_t* __restrict__ P, bf16_t* __restrict__ Y, const float* __restrict__ LA, const float* __restrict__ LU) {
    const int tid = tid_opaque();
    if (blockIdx.x >= 64 || tid >= 64) return;
    const int gid = blockIdx.x * 64 + tid, b = gid >> 10, ch = gid & 1023;
    float h = 0.f;
    for (int t = 0; t < SEQ; t += 8) {
        float a[8], u[8], g[8];
#pragma unroll
        for (int e = 0; e < 8; ++e) { const size_t tok = (size_t)b * SEQ + t + e; a[e] = LA[tok * 1024 + ch]; u[e] = LU[tok * 1024 + ch]; g[e] = bf2f(P[tok * NPAD + C_GATE + 3072 + ch]); }
#pragma unroll
        for (int e = 0; e < 8; ++e) { h = a[e] * h + u[e]; Y[((size_t)b * SEQ + t + e) * DM + 3072 + ch] = f2bf(h * g[e]); }
    }
}

__device__ __forceinline__ float diff_lambda(const LayerW& W) {
    float a = 0.f, b = 0.f;
    for (int i = 0; i < 64; ++i) { a += W.lq1[i] * W.lk1[i]; b += W.lq2[i] * W.lk2[i]; }
    return expf(a) - expf(b) + W.lambda_init;
}


typedef short bf16x8 __attribute__((ext_vector_type(8)));
typedef short s16x4 __attribute__((ext_vector_type(4)));
typedef float f32x16 __attribute__((ext_vector_type(16)));
#define MFMA32(a, b, c) __builtin_amdgcn_mfma_f32_32x32x16_bf16((a), (b), (c), 0, 0, 0)
constexpr float LOG2E = 1.4426950408889634f;
__device__ __forceinline__ int crow(int r, int h) { return (r & 3) + 8 * (r >> 2) + 4 * h; }
__device__ __forceinline__ bf16x8 pack8(const float* f) { u32x4 u; u.x = cvt2(f[0], f[1]); u.y = cvt2(f[2], f[3]); u.z = cvt2(f[4], f[5]); u.w = cvt2(f[6], f[7]); return __builtin_bit_cast(bf16x8, u); }

template <bool SWA> struct AttnCfg {
    static constexpr int DQK = SWA ? 128 : 64, NKS = DQK / 16;
    static constexpr int KP = DQK + 8;
    static constexpr int KMAPS = SWA ? 1 : 2;
    static constexpr int KBYTES = KMAPS * 64 * KP * 2;
    static constexpr int VP = 72;
    static constexpr int VBYTES = 128 * VP * 2;
    static constexpr int ABUF = KBYTES + VBYTES;
};

template <bool SWA>
__device__ __forceinline__ void attn_item(const bf16_t* __restrict__ P, bf16_t* __restrict__ Y, const LayerW& W, float lam, int item, unsigned char* lds) {
    typedef AttnCfg<SWA> C;
    const int tid = tid_opaque(), lane = tid & 63, wave = tid >> 6, c = wave & 1, g = wave >> 1, l31 = lane & 31, hh = lane >> 5;
    int b, qb, hk  , hq  ;
    if (SWA) { qb = 15 - (item >> 4); const int r = item & 15; b = r >> 2; const int kvh = (r >> 1) & 1, gp = r & 1; hk = kvh; hq = kvh * 4 + gp * 2 + c; }
    else { qb = 15 - (item >> 5); const int r = item & 31; b = r >> 3; hk = r & 7; hq = hk; }
    const size_t tokb = (size_t)b * SEQ;
    const int q0 = qb * 128 + g * 32;
    const int qcol = SWA ? (C_SQ + hq * 128) : (C_DQ + hq * 128 + c * 64);
    const int kcol = SWA ? (C_SK + hk * 128) : (C_DK + hk * 128);
    const int vcol = SWA ? (C_SV + hk * 128) : (C_DV + hk * 128);
    const float* qnw = SWA ? W.swa_qn : W.dq_n; const float* knw = SWA ? W.swa_kn : W.dk_n;
    const float slope2 = exp2f(-(float)(hq + 1)) * LOG2E;
    bf16x8 qf[C::NKS];
    {
        const bf16_t* qp = P + (tokb + q0 + l31) * NPAD + qcol;
        float f[C::NKS][8]; float ss = 0.f;
#pragma unroll
        for (int ks = 0; ks < C::NKS; ++ks) { unpack8(*(const uint4*)(qp + 16 * ks + 8 * hh), f[ks]);
#pragma unroll
            for (int e = 0; e < 8; ++e) ss += f[ks][e] * f[ks][e]; }
        ss += __shfl_xor(ss, 32);
        const float sc = rsqrtf(ss * (1.f / C::DQK) + EPS) * (SWA ? 0.08838834764831845f : 0.125f) * LOG2E;
#pragma unroll
        for (int ks = 0; ks < C::NKS; ++ks) {
#pragma unroll
            for (int e = 0; e < 8; ++e) f[ks][e] *= sc * qnw[16 * ks + 8 * hh + e];
            qf[ks] = pack8(f[ks]); }
    }
    int t_lo = 0, t_hi = 2 * qb + 2;
    if (SWA) t_lo = (qb == 0) ? 0 : 2 * qb - 2;
    const int kkey = SWA ? (tid >> 3) : (tid >> 3), kch = tid & 7;
    const int vkey = tid & 63, vch = tid >> 6;
    uint4 rk0, rk1, rv0, rv1;
#define ATT_LOAD(t) do { const bf16_t* kp_ = P + (tokb + (t) * 64 + kkey) * NPAD + kcol + kch * 16; rk0 = ((const uint4*)kp_)[0]; rk1 = ((const uint4*)kp_)[1]; \
        const bf16_t* vp_ = P + (tokb + (t) * 64 + vkey) * NPAD + vcol + vch * 16; rv0 = ((const uint4*)vp_)[0]; rv1 = ((const uint4*)vp_)[1]; } while (0)
#define ATT_STORE(bufp) do { float f_[16]; unpack8(rk0, f_); unpack8(rk1, f_ + 8); float ss_ = 0.f; \
        _Pragma("unroll") for (int e = 0; e < 16; ++e) ss_ += f_[e] * f_[e]; \
        ss_ += __shfl_xor(ss_, 1); ss_ += __shfl_xor(ss_, 2); if (SWA) ss_ += __shfl_xor(ss_, 4); \
        const float rs_ = rsqrtf(ss_ * (1.f / C::DQK) + EPS); const int d0_ = SWA ? kch * 16 : (kch & 3) * 16; \
        _Pragma("unroll") for (int e = 0; e < 16; ++e) f_[e] *= rs_ * knw[d0_ + e]; \
        bf16_t* kd_ = (bf16_t*)(bufp) + ((SWA ? 0 : (kch >> 2) * 64) + kkey) * C::KP + d0_; \
        *(bf16x8*)kd_ = pack8(f_); *(bf16x8*)(kd_ + 8) = pack8(f_ + 8); \
        bf16_t* vd_ = (bf16_t*)((bufp) + C::KBYTES) + (vch * 16) * C::VP + vkey; \
        const unsigned vw_[8] = {rv0.x, rv0.y, rv0.z, rv0.w, rv1.x, rv1.y, rv1.z, rv1.w}; \
        _Pragma("unroll") for (int e = 0; e < 8; ++e) { vd_[(2 * e) * C::VP] = (bf16_t)(vw_[e] & 0xffffu); vd_[(2 * e + 1) * C::VP] = (bf16_t)(vw_[e] >> 16); } } while (0)

    f32x16 O[4];
#pragma unroll
    for (int vt = 0; vt < 4; ++vt)
#pragma unroll
        for (int r = 0; r < 16; ++r) O[vt][r] = 0.f;
    float m = SWA ? W.swa_sinks[hq] * LOG2E + slope2 * (float)(q0 + l31) : -INFINITY, l = SWA ? 0.5f : 0.f;
    __syncthreads();
    ATT_LOAD(t_lo);
    ATT_STORE(lds);
    __syncthreads();
    for (int t = t_lo; t < t_hi; ++t) {
        unsigned char* buf = lds + ((t - t_lo) & 1) * C::ABUF;
        unsigned char* nbuf = lds + (((t - t_lo) & 1) ^ 1) * C::ABUF;
        const bool more = (t + 1 < t_hi);
        if (more) ATT_LOAD(t + 1);
        const int k0 = t * 64;
        bool act = (k0 <= q0 + 31);
        if (SWA) act = act && (k0 + 63 >= q0 - 127);
        if (act) {
            const bf16_t* Kb = (const bf16_t*)buf + (SWA ? 0 : c * 64 * C::KP);
            f32x16 s0, s1;
            { const float kb0 = slope2 * (float)(k0 + 4 * hh), kb1 = kb0 + 32.f * slope2;
#pragma unroll
              for (int r = 0; r < 16; ++r) { const float cr = (float)((r & 3) + 8 * (r >> 2)); s0[r] = fmaf(slope2, cr, kb0); s1[r] = fmaf(slope2, cr, kb1); } }
#pragma unroll
            for (int ks = 0; ks < C::NKS; ++ks) {
                const bf16x8 a0 = *(const bf16x8*)(Kb + l31 * C::KP + 16 * ks + 8 * hh);
                const bf16x8 a1 = *(const bf16x8*)(Kb + (32 + l31) * C::KP + 16 * ks + 8 * hh);
                s0 = MFMA32(a0, qf[ks], s0); s1 = MFMA32(a1, qf[ks], s1); }
            const int dq = q0 + l31 - k0;
            const bool edge = SWA ? (k0 + 63 > q0 || k0 < q0 + 31 - 127) : (k0 + 63 > q0);
            float mx = -INFINITY;
            if (edge) {
#pragma unroll
                for (int r = 0; r < 16; ++r) { const int d0 = dq - crow(r, hh), d1 = d0 - 32;
                    if (d0 < 0 || (SWA && d0 > 127)) s0[r] = -INFINITY;
                    if (d1 < 0 || (SWA && d1 > 127)) s1[r] = -INFINITY; } }
#pragma unroll
            for (int r = 0; r < 16; ++r) { mx = __builtin_amdgcn_fmed3f(mx, s0[r], INFINITY); mx = __builtin_amdgcn_fmed3f(mx, s1[r], INFINITY); }
            mx = __builtin_amdgcn_fmed3f(mx, __shfl_xor(mx, 32), INFINITY);
            const float mn = __builtin_amdgcn_fmed3f(m, mx, INFINITY), alpha = __builtin_amdgcn_exp2f(m - mn);
            m = mn;
            s0 = s0 - mn; s1 = s1 - mn;
            f32v2_t ls2 = {0.f, 0.f};
#pragma unroll
            for (int r = 0; r < 16; r += 2) { s0[r] = __builtin_amdgcn_exp2f(s0[r]); s0[r + 1] = __builtin_amdgcn_exp2f(s0[r + 1]); s1[r] = __builtin_amdgcn_exp2f(s1[r]); s1[r + 1] = __builtin_amdgcn_exp2f(s1[r + 1]);
                ls2 += (f32v2_t){s0[r], s0[r + 1]}; ls2 += (f32v2_t){s1[r], s1[r + 1]}; }
            l = l * alpha + (ls2[0] + ls2[1]);
#pragma unroll
            for (int vt = 0; vt < 4; ++vt)
#pragma unroll
                for (int r = 0; r < 16; ++r) O[vt][r] *= alpha;
            const bf16_t* Vb = (const bf16_t*)(buf + C::KBYTES);
#pragma unroll
            for (int kt2 = 0; kt2 < 2; ++kt2)
#pragma unroll
                for (int s2 = 0; s2 < 2; ++s2) {
                    float pf[8];
#pragma unroll
                    for (int e = 0; e < 8; ++e) pf[e] = kt2 ? s1[8 * s2 + e] : s0[8 * s2 + e];
                    const bf16x8 pb = pack8(pf);
#pragma unroll
                    for (int vt = 0; vt < 4; ++vt) {
                        const bf16_t* vp = Vb + (32 * vt + l31) * C::VP + 32 * kt2 + 16 * s2 + 4 * hh;
                        const s16x4 lo = *(const s16x4*)vp, hi = *(const s16x4*)(vp + 8);
                        const bf16x8 a = __builtin_shufflevector(lo, hi, 0, 1, 2, 3, 4, 5, 6, 7);
                        O[vt] = MFMA32(a, pb, O[vt]); }
                }
        }
        if (more) ATT_STORE(nbuf);
        __syncthreads();
    }
#undef ATT_LOAD
#undef ATT_STORE
    l += __shfl_xor(l, 32);
    float* OB = (float*)lds;
    const int orow = (g * 32 + l31) * 129;
    if (SWA) {
        const float sc = 1.f / l;
#pragma unroll 1
        for (int pass = 0; pass < 2; ++pass) {
            if (c == pass) {
#pragma unroll
                for (int vt = 0; vt < 4; ++vt)
#pragma unroll
                    for (int r = 0; r < 16; ++r) OB[orow + 32 * vt + crow(r, hh)] = O[vt][r] * sc; }
            __syncthreads();
            { const int q = tid >> 2, part = tid & 3; const size_t tq = tokb + qb * 128 + q; const int hq2 = hq - c + pass;
              const bf16_t* gp = P + tq * NPAD + C_GATE + 1024 + hq2 * 128 + part * 32; bf16_t* yp = Y + tq * DM + 1024 + hq2 * 128 + part * 32;
#pragma unroll
              for (int ch = 0; ch < 4; ++ch) { float gf[8]; unpack8(*(const uint4*)(gp + ch * 8), gf); float of[8];
#pragma unroll
                  for (int e = 0; e < 8; ++e) of[e] = OB[q * 129 + part * 32 + ch * 8 + e] * gf[e];
                  *(bf16x8*)(yp + ch * 8) = pack8(of); } }
            __syncthreads();
        }
    } else {
        const float sc = (c == 0) ? 1.f / l : lam / l;
        if (c == 1) {
#pragma unroll
            for (int vt = 0; vt < 4; ++vt)
#pragma unroll
                for (int r = 0; r < 16; ++r) OB[orow + 32 * vt + crow(r, hh)] = O[vt][r] * sc; }
        __syncthreads();
        if (c == 0) {
            float ss = 0.f;
#pragma unroll
            for (int vt = 0; vt < 4; ++vt)
#pragma unroll
                for (int r = 0; r < 16; ++r) { const float o = O[vt][r] * sc - OB[orow + 32 * vt + crow(r, hh)]; O[vt][r] = o; ss += o * o; }
            ss += __shfl_xor(ss, 32);
            const float rstd = rsqrtf(ss * (1.f / 128.f) + EPS) * (1.f - W.lambda_init);
#pragma unroll
            for (int vt = 0; vt < 4; ++vt)
#pragma unroll
                for (int r = 0; r < 16; ++r) OB[orow + 32 * vt + crow(r, hh)] = O[vt][r] * rstd; }
        __syncthreads();
        { const int q = tid >> 2, part = tid & 3; const size_t tq = tokb + qb * 128 + q;
          const bf16_t* gp = P + tq * NPAD + C_GATE + 2048 + hq * 128 + part * 32; bf16_t* yp = Y + tq * DM + 2048 + hq * 128 + part * 32;
#pragma unroll
          for (int ch = 0; ch < 4; ++ch) { float gf[8]; unpack8(*(const uint4*)(gp + ch * 8), gf); float of[8];
#pragma unroll
              for (int e = 0; e < 8; ++e) of[e] = OB[q * 129 + part * 32 + ch * 8 + e] * gf[e] * W.d_on[part * 32 + ch * 8 + e];
              *(bf16x8*)(yp + ch * 8) = pack8(of); } }
        __syncthreads();
    }
}


__device__ __forceinline__ void diff_item3(const Params& p, int lay, const bf16_t* __restrict__ P, bf16_t* __restrict__ Y, const LayerW& W, float lam, int item, unsigned char* lds) {
    constexpr int KP = 72, VP = 72, KBYTES = 2 * 64 * KP * 2, ABUF = KBYTES + 128 * VP * 2;
    const int tid = tid_opaque(), lane = tid & 63, wave = tid >> 6, c = wave & 1, g = wave >> 1, l31 = lane & 31, hh = lane >> 5;
    const int qb = 15 - (item >> 5), r_ = item & 31, b = r_ >> 3, h = r_ & 7;
    const size_t tokb = (size_t)b * SEQ;
    const int q0 = qb * 128 + g * 32;
    const int kcol = C_DK + h * 128, vcol = C_DV + h * 128;
    const float slope2 = exp2f(-(float)(h + 1)) * LOG2E;
    const int kkey = tid >> 3, kch = tid & 7, vkey = tid & 63, vch = tid >> 6;
    uint4 rk0, rk1, rv0, rv1;
#define D3_KLOAD(t) do { const bf16_t* kp_ = P + (tokb + (t) * 64 + kkey) * NPAD + kcol + kch * 16; rk0 = ((const uint4*)kp_)[0]; rk1 = ((const uint4*)kp_)[1]; } while (0)
#define D3_VLOAD(t) do { const bf16_t* vp_ = P + (tokb + (t) * 64 + vkey) * NPAD + vcol + vch * 16; rv0 = ((const uint4*)vp_)[0]; rv1 = ((const uint4*)vp_)[1]; } while (0)
#define D3_KSTORE(t) do { float f_[16]; unpack8(rk0, f_); unpack8(rk1, f_ + 8); float ss_ = 0.f; \
        _Pragma("unroll") for (int e = 0; e < 16; ++e) ss_ += f_[e] * f_[e]; \
        ss_ += __shfl_xor(ss_, 1); ss_ += __shfl_xor(ss_, 2); \
        const float rs_ = rsqrtf(ss_ * (1.f / 64.f) + EPS); const int d0_ = (kch & 3) * 16; \
        _Pragma("unroll") for (int e = 0; e < 16; ++e) f_[e] *= rs_ * W.dk_n[d0_ + e]; \
        bf16_t* kd_ = (bf16_t*)(lds + ((t) & 1) * ABUF) + ((kch >> 2) * 64 + kkey) * KP + d0_; \
        *(bf16x8*)kd_ = pack8(f_); *(bf16x8*)(kd_ + 8) = pack8(f_ + 8); } while (0)
#define D3_VSTORE(t) do { bf16_t* vd_ = (bf16_t*)(lds + ((t) & 1) * ABUF + KBYTES) + (vch * 16) * VP + vkey; \
        const unsigned vw_[8] = {rv0.x, rv0.y, rv0.z, rv0.w, rv1.x, rv1.y, rv1.z, rv1.w}; \
        _Pragma("unroll") for (int e = 0; e < 8; ++e) { vd_[(2 * e) * VP] = (bf16_t)(vw_[e] & 0xffffu); vd_[(2 * e + 1) * VP] = (bf16_t)(vw_[e] >> 16); } } while (0)
#define D3_QK(t) do { const int k0_ = (t) * 64; const bf16_t* Kb_ = (const bf16_t*)(lds + ((t) & 1) * ABUF) + c * 64 * KP; \
        { const float kb0 = slope2 * (float)(k0_ + 4 * hh), kb1 = kb0 + 32.f * slope2; \
          _Pragma("unroll") for (int r = 0; r < 16; ++r) { const float cr = (float)((r & 3) + 8 * (r >> 2)); s0[r] = fmaf(slope2, cr, kb0); s1[r] = fmaf(slope2, cr, kb1); } } \
        _Pragma("unroll") for (int ks = 0; ks < 4; ++ks) { \
            const bf16x8 a0 = *(const bf16x8*)(Kb_ + l31 * KP + 16 * ks + 8 * hh), a1 = *(const bf16x8*)(Kb_ + (32 + l31) * KP + 16 * ks + 8 * hh); \
            s0 = MFMA32(a0, qf[ks], s0); s1 = MFMA32(a1, qf[ks], s1); } \
        if ((t) == tw) { const int dq = q0 + l31 - k0_; \
            _Pragma("unroll") for (int r = 0; r < 16; ++r) { const int d0 = dq - crow(r, hh), d1 = d0 - 32; if (d0 < 0) s0[r] = -INFINITY; if (d1 < 0) s1[r] = -INFINITY; } } } while (0)
#define D3_PV(tv) do { const bf16_t* Vb_ = (const bf16_t*)(lds + ((tv) & 1) * ABUF + KBYTES); \
        _Pragma("unroll") for (int i4 = 0; i4 < 4; ++i4) \
            _Pragma("unroll") for (int vt = 0; vt < 4; ++vt) { \
                const bf16_t* vp = Vb_ + (32 * vt + l31) * VP + 16 * i4 + 4 * hh; \
                const s16x4 lo = *(const s16x4*)vp, hi = *(const s16x4*)(vp + 8); \
                O[vt] = MFMA32(__builtin_shufflevector(lo, hi, 0, 1, 2, 3, 4, 5, 6, 7), pp[i4], O[vt]); } } while (0)
#define D3_SOFTMAX() do { float mx = -INFINITY; \
        _Pragma("unroll") for (int r = 0; r < 16; ++r) { mx = __builtin_amdgcn_fmed3f(mx, s0[r], INFINITY); mx = __builtin_amdgcn_fmed3f(mx, s1[r], INFINITY); } \
        mx = __builtin_amdgcn_fmed3f(mx, __shfl_xor(mx, 32), INFINITY); \
        const float mn = __builtin_amdgcn_fmed3f(m, mx, INFINITY); alpha = __builtin_amdgcn_exp2f(m - mn); m = mn; \
        float ls = 0.f; \
        _Pragma("unroll") for (int r = 0; r < 16; ++r) { s0[r] = __builtin_amdgcn_exp2f(s0[r] - mn); s1[r] = __builtin_amdgcn_exp2f(s1[r] - mn); ls += s0[r] + s1[r]; } \
        l = l * alpha + ls; } while (0)
#define D3_PACK() do { _Pragma("unroll") for (int i4 = 0; i4 < 4; ++i4) { float pf[8]; \
        _Pragma("unroll") for (int e = 0; e < 8; ++e) pf[e] = (i4 >> 1) ? s1[8 * (i4 & 1) + e] : s0[8 * (i4 & 1) + e]; \
        pp[i4] = pack8(pf); } } while (0)
    const int nt = 2 * qb + 2, tw = (q0 + 31) >> 6;
    D3_KLOAD(0);
    bf16x8 qf[4];
    {
        const bf16_t* qp = P + (tokb + q0 + l31) * NPAD + C_DQ + h * 128 + c * 64;
        float f[4][8]; float ss = 0.f;
#pragma unroll
        for (int ks = 0; ks < 4; ++ks) { unpack8(*(const uint4*)(qp + 16 * ks + 8 * hh), f[ks]);
#pragma unroll
            for (int e = 0; e < 8; ++e) ss += f[ks][e] * f[ks][e]; }
        ss += __shfl_xor(ss, 32);
        const float sc = rsqrtf(ss * (1.f / 64.f) + EPS) * 0.125f * LOG2E;
#pragma unroll
        for (int ks = 0; ks < 4; ++ks) {
#pragma unroll
            for (int e = 0; e < 8; ++e) f[ks][e] *= sc * W.dq_n[16 * ks + 8 * hh + e];
            qf[ks] = pack8(f[ks]); }
    }
    f32x16 O[4];
#pragma unroll
    for (int vt = 0; vt < 4; ++vt)
#pragma unroll
        for (int r = 0; r < 16; ++r) O[vt][r] = 0.f;
    float m = -INFINITY, l = 0.f, alpha = 0.f;
    bf16x8 pp[4];
    f32x16 s0, s1;
    __syncthreads();
    D3_KSTORE(0);
    __syncthreads();
    unsigned* HC = (unsigned*)(lds + 81920);
    const int hbase = 32 * (256 - (qb + 1) * (qb + 1)) + (item & 31) * (2 * qb + 1) - 1;
    f32x4 hc[4]; TrTile Th, Tf; bool hok, fok = false;
    hok = diff_host_tile(p, lay, hbase + 1, Th);
    if (hok) tr_load(Th, tid, hc);
    {
        D3_KLOAD(1); D3_VLOAD(0);
        D3_QK(0);
        D3_SOFTMAX();
        D3_PACK();
        D3_KSTORE(1); D3_VSTORE(0);
        __syncthreads();
    }
#pragma unroll 1
    for (int t = 1; t < nt; ++t) {
        const bool more = (t + 1 < nt);
        if (fok) tr_flush(Tf, tid, HC + ((t - 1) & 1) * 4160);
        if (more) D3_KLOAD(t + 1);
        D3_VLOAD(t);
        if (t <= tw) {
            D3_QK(t);
            {
                float mx = -INFINITY;
#pragma unroll
                for (int r = 0; r < 16; ++r) { mx = __builtin_amdgcn_fmed3f(mx, s0[r], INFINITY); mx = __builtin_amdgcn_fmed3f(mx, s1[r], INFINITY); }
                mx = __builtin_amdgcn_fmed3f(mx, __shfl_xor(mx, 32), INFINITY);
                const float mn = __builtin_amdgcn_fmed3f(m, mx, INFINITY); alpha = __builtin_amdgcn_exp2f(m - mn); m = mn;
                float ls = 0.f;
                const bf16_t* Vb_ = (const bf16_t*)(lds + ((t - 1) & 1) * ABUF + KBYTES);
#pragma unroll
                for (int r = 0; r < 16; ++r) {
                    { const int i4 = r >> 2, vt = r & 3;
                      const bf16_t* vp = Vb_ + (32 * vt + l31) * VP + 16 * i4 + 4 * hh;
                      const s16x4 lo = *(const s16x4*)vp, hi = *(const s16x4*)(vp + 8);
                      O[vt] = MFMA32(__builtin_shufflevector(lo, hi, 0, 1, 2, 3, 4, 5, 6, 7), pp[i4], O[vt]); }
                    s0[r] = __builtin_amdgcn_exp2f(s0[r] - mn); s1[r] = __builtin_amdgcn_exp2f(s1[r] - mn); ls += s0[r] + s1[r];
                    __builtin_amdgcn_sched_barrier(0);
                }
                l = l * alpha + ls;
            }
#pragma unroll
            for (int vt = 0; vt < 4; ++vt)
#pragma unroll
                for (int r = 0; r < 16; ++r) O[vt][r] *= alpha;
            D3_PACK();
        } else if (t == tw + 1) {
            D3_PV(t - 1);
        }
        if (more) D3_KSTORE(t + 1);
        D3_VSTORE(t);
        if (hok) tr_stage(tid, hc, HC + (t & 1) * 4160);
        Tf = Th; fok = hok;
        hok = more && diff_host_tile(p, lay, hbase + t + 1, Th);
        if (hok) tr_load(Th, tid, hc);
        __syncthreads();
    }
    if (fok) tr_flush(Tf, tid, HC + ((nt - 1) & 1) * 4160);
    if (tw == nt - 1) D3_PV(nt - 1);
    __syncthreads();
#undef D3_KLOAD
#undef D3_VLOAD
#undef D3_KSTORE
#undef D3_VSTORE
#undef D3_QK
#undef D3_PV
#undef D3_SOFTMAX
#undef D3_PACK
    l += __shfl_xor(l, 32);
    float* OB = (float*)lds;
    const int orow = (g * 32 + l31) * 129;
    const float sc = (c == 0) ? 1.f / l : lam / l;
    if (c == 1) {
#pragma unroll
        for (int vt = 0; vt < 4; ++vt)
#pragma unroll
            for (int r = 0; r < 16; ++r) OB[orow + 32 * vt + crow(r, hh)] = O[vt][r] * sc; }
    __syncthreads();
    if (c == 0) {
        float ss = 0.f;
#pragma unroll
        for (int vt = 0; vt < 4; ++vt)
#pragma unroll
            for (int r = 0; r < 16; ++r) { const float o = O[vt][r] * sc - OB[orow + 32 * vt + crow(r, hh)]; O[vt][r] = o; ss += o * o; }
        ss += __shfl_xor(ss, 32);
        const float rstd = rsqrtf(ss * (1.f / 128.f) + EPS) * (1.f - W.lambda_init);
#pragma unroll
        for (int vt = 0; vt < 4; ++vt)
#pragma unroll
            for (int r = 0; r < 16; ++r) OB[orow + 32 * vt + crow(r, hh)] = O[vt][r] * rstd; }
    __syncthreads();
    { const int q = tid >> 2, part = tid & 3; const size_t tq = tokb + qb * 128 + q;
      const bf16_t* gp = P + tq * NPAD + C_GATE + 2048 + h * 128 + part * 32; bf16_t* yp = Y + tq * DM + 2048 + h * 128 + part * 32;
#pragma unroll
      for (int ch = 0; ch < 4; ++ch) { float gf[8]; unpack8(*(const uint4*)(gp + ch * 8), gf); float of[8];
#pragma unroll
          for (int e = 0; e < 8; ++e) of[e] = OB[q * 129 + part * 32 + ch * 8 + e] * gf[e] * W.d_on[part * 32 + ch * 8 + e];
          *(bf16x8*)(yp + ch * 8) = pack8(of); } }
    __syncthreads();
}

__device__ __forceinline__ float fast_sigm(float x) { return __builtin_amdgcn_rcpf(1.f + __builtin_amdgcn_exp2f(-x * LOG2E)); }
__device__ __forceinline__ void lru_pre_item(const bf16_t* __restrict__ P, float* __restrict__ HL, float* __restrict__ CP, const LayerW& W, int item, unsigned char* lds) {
    const int tid = tid_opaque(), lane = tid & 63, wave = tid >> 6, l31 = lane & 31, hh = lane >> 5;
    const int b = item >> 6, n = (item >> 3) & 7, seg = item & 7;
    const size_t tokb = (size_t)b * SEQ;
    bf16_t* WrT = (bf16_t*)lds; bf16_t* WiT = WrT + 128 * 136; bf16_t* XC = WiT + 128 * 136; float* A = (float*)(lds + 69632 + 17408); float* U = A + 8192;
    __syncthreads();
#pragma unroll 2
    for (int e = 0; e < 8; ++e) { const int idx = tid + 512 * e, i = idx >> 5, j4 = (idx & 31) * 4;
        const float4 a = *(const float4*)(W.w_r + (size_t)n * 16384 + i * 128 + j4), c = *(const float4*)(W.w_i + (size_t)n * 16384 + i * 128 + j4);
        WrT[(j4 + 0) * 136 + i] = f2bf(a.x); WrT[(j4 + 1) * 136 + i] = f2bf(a.y); WrT[(j4 + 2) * 136 + i] = f2bf(a.z); WrT[(j4 + 3) * 136 + i] = f2bf(a.w);
        WiT[(j4 + 0) * 136 + i] = f2bf(c.x); WiT[(j4 + 1) * 136 + i] = f2bf(c.y); WiT[(j4 + 2) * 136 + i] = f2bf(c.z); WiT[(j4 + 3) * 136 + i] = f2bf(c.w); }
    const int tt = wave >> 2, jt = wave & 3, chl = 32 * jt + l31, ch = n * 128 + chl;
    const float br = W.b_r[ch], bi = W.b_i[ch];
    float sp; { const float x = -W.lam[ch]; sp = (x > 20.f) ? x : log1pf(expf(x)); }
    const float sp8 = -8.f * sp;
    const int cc = 2 * (tid & 63), tg = tid >> 6, cch = n * 128 + cc;
    float cw[4][2], cb[2];
#pragma unroll
    for (int w = 0; w < 4; ++w) { cw[w][0] = W.conv_w[w * 1024 + cch]; cw[w][1] = W.conv_w[w * 1024 + cch + 1]; }
    cb[0] = W.conv_b[cch]; cb[1] = W.conv_b[cch + 1];
    unsigned rx[11];
#define LRU_LOAD(k) do { _Pragma("unroll") for (int i = 0; i < 11; ++i) { const int tp = seg * 256 + (k) * 64 + 8 * tg - 3 + i; rx[i] = (tp >= 0) ? *(const unsigned*)(P + (tokb + tp) * NPAD + C_RX + cch) : 0u; } } while (0)
    LRU_LOAD(0);
    float* XH = (float*)XC; float* XP = XH + 512;
    const int sch = tid & 127, ssub = tid >> 7;
    float hcar = 0.f, ccar = 1.f;
#pragma unroll 1
    for (int k = 0; k < 4; ++k) {
#pragma unroll
        for (int i = 0; i < 8; ++i) { float x0 = cb[0], x1 = cb[1];
#pragma unroll
            for (int w = 0; w < 4; ++w) { const unsigned v = rx[i + w]; x0 += cw[w][0] * __uint_as_float(v << 16); x1 += cw[w][1] * __uint_as_float(v & 0xffff0000u); }
            *(unsigned*)(XC + (8 * tg + i) * 136 + cc) = cvt2(x0, x1); }
        if (k + 1 < 4) LRU_LOAD(k + 1);
        __syncthreads();
        {
            f32x16 ar, ai;
#pragma unroll
            for (int r = 0; r < 16; ++r) { ar[r] = 0.f; ai[r] = 0.f; }
#pragma unroll
            for (int ks = 0; ks < 8; ++ks) {
                const bf16x8 a = *(const bf16x8*)(XC + (32 * tt + l31) * 136 + 16 * ks + 8 * hh);
                const bf16x8 wr = *(const bf16x8*)(WrT + (32 * jt + l31) * 136 + 16 * ks + 8 * hh);
                const bf16x8 wi = *(const bf16x8*)(WiT + (32 * jt + l31) * 136 + 16 * ks + 8 * hh);
                ar = MFMA32(a, wr, ar); ai = MFMA32(a, wi, ai); }
#pragma unroll
            for (int r = 0; r < 16; ++r) { const int t = 32 * tt + crow(r, hh);
                const float rr = fast_sigm(ar[r] + br), ii = fast_sigm(ai[r] + bi), la = sp8 * rr;
                const float av = __builtin_amdgcn_exp2f(la * LOG2E), x2 = 2.f * la;
                const float om = (x2 > -0.1f) ? -x2 * (1.f + x2 * (0.5f + x2 * (0.16666667f + x2 * 0.041666668f))) : 1.f - av * av;
                const float xv = bf2f(XC[t * 136 + chl]);
                A[t * 128 + chl] = av; U[t * 128 + chl] = __builtin_amdgcn_sqrtf(om) * ii * xv; }
        }
        __syncthreads();
        {
            float hl[16], cl[16]; float hh_ = 0.f, cc_ = 1.f;
#pragma unroll
            for (int t = 0; t < 16; ++t) { const float a = A[(16 * ssub + t) * 128 + sch]; hh_ = a * hh_ + U[(16 * ssub + t) * 128 + sch]; cc_ *= a; hl[t] = hh_; cl[t] = cc_; }
            XH[ssub * 128 + sch] = hh_; XP[ssub * 128 + sch] = cc_;
            __syncthreads();
            float hin = hcar, cin = ccar;
            for (int s = 0; s < ssub; ++s) { hin = XH[s * 128 + sch] + XP[s * 128 + sch] * hin; cin *= XP[s * 128 + sch]; }
            float hend = hin, cend = cin;
            for (int s = ssub; s < 4; ++s) { hend = XH[s * 128 + sch] + XP[s * 128 + sch] * hend; cend *= XP[s * 128 + sch]; }
            hcar = hend; ccar = cend;
            const size_t o = (tokb + seg * 256 + k * 64 + 16 * ssub) * 1024 + n * 128 + sch;
#pragma unroll
            for (int t = 0; t < 16; ++t) { HL[o + (size_t)t * 1024] = hl[t] + cl[t] * hin; CP[o + (size_t)t * 1024] = cl[t] * cin; }
            __syncthreads();
        }
    }
#undef LRU_LOAD
    __syncthreads();
}
__device__ __forceinline__ void lru_fix_item(const bf16_t* __restrict__ P, bf16_t* __restrict__ Y, const float* __restrict__ HL, const float* __restrict__ CP, int item) {
    const int tid = tid_opaque();
    const int b = item >> 6, n = (item >> 3) & 7, seg = item & 7;
    const size_t tokb = (size_t)b * SEQ;
    const int c0 = (tid & 15) * 8, tr = tid >> 4;
    float carry[8];
#pragma unroll
    for (int e = 0; e < 8; ++e) carry[e] = 0.f;
    for (int s = 0; s < seg; ++s) { const size_t o = (tokb + s * 256 + 255) * 1024 + n * 128 + c0;
        const float4 h0 = *(const float4*)(HL + o), h1 = *(const float4*)(HL + o + 4), p0 = *(const float4*)(CP + o), p1 = *(const float4*)(CP + o + 4);
        carry[0] = h0.x + p0.x * carry[0]; carry[1] = h0.y + p0.y * carry[1]; carry[2] = h0.z + p0.z * carry[2]; carry[3] = h0.w + p0.w * carry[3];
        carry[4] = h1.x + p1.x * carry[4]; carry[5] = h1.y + p1.y * carry[5]; carry[6] = h1.z + p1.z * carry[6]; carry[7] = h1.w + p1.w * carry[7]; }
#pragma unroll 2
    for (int it = 0; it < 8; ++it) { const size_t tok = tokb + seg * 256 + it * 32 + tr; const size_t o = tok * 1024 + n * 128 + c0;
        const float4 h0 = *(const float4*)(HL + o), h1 = *(const float4*)(HL + o + 4), p0 = *(const float4*)(CP + o), p1 = *(const float4*)(CP + o + 4);
        float gf[8]; unpack8(*(const uint4*)(P + tok * NPAD + C_GATE + 3072 + n * 128 + c0), gf);
        float of[8] = {h0.x + p0.x * carry[0], h0.y + p0.y * carry[1], h0.z + p0.z * carry[2], h0.w + p0.w * carry[3], h1.x + p1.x * carry[4], h1.y + p1.y * carry[5], h1.z + p1.z * carry[6], h1.w + p1.w * carry[7]};
#pragma unroll
        for (int e = 0; e < 8; ++e) of[e] *= gf[e];
        *(bf16x8*)(Y + tok * DM + 3072 + n * 128 + c0) = pack8(of); }
}

constexpr size_t GP_UNIT = 41216;
struct GlaPreRaw { uint4 ra0, ra1, rq, rk, rv0, rv1; };
__device__ __forceinline__ GlaPreRaw gla_pre_load(const bf16_t* __restrict__ P, int unit, int lane, int wave) {
    const int bh = unit >> 5, k = unit & 31, b = bh >> 3, h = bh & 7;
    const bf16_t* row_ = P + ((size_t)b * SEQ + k * 64 + lane) * NPAD;
    GlaPreRaw r;
    r.ra0 = *(const uint4*)(row_ + C_GA); r.ra1 = *(const uint4*)(row_ + C_GA + 8);
    r.rq = *(const uint4*)(row_ + C_GQ + h * 64 + 8 * wave); r.rk = *(const uint4*)(row_ + C_GK + h * 64 + 8 * wave);
    r.rv0 = *(const uint4*)(row_ + C_GV + h * 128 + 16 * wave); r.rv1 = *(const uint4*)(row_ + C_GV + h * 128 + 16 * wave + 8);
    return r;
}
__device__ __forceinline__ void gla_pre_unit(const GlaPreRaw& R, unsigned char* __restrict__ GP, const LayerW& W, int unit, unsigned char* lds, int tid) {
    const int lane = tid & 63, wave = tid >> 6;
    const int bh = unit >> 5, h = bh & 7;
    float* WUP = (float*)lds;
    __syncthreads();
    for (int i = tid; i < 1024; i += 512) WUP[i] = W.gla_w_up[(i >> 6) * 512 + h * 64 + (i & 63)];
    if (tid < 64) WUP[1024 + tid] = W.gla_b_up[h * 64 + tid];
    __syncthreads();
    unsigned char* g = GP + (size_t)unit * GP_UNIT;
    float al[16]; unpack8(R.ra0, al); unpack8(R.ra1, al + 8);
    float bc[8];
    { const float4 b0 = *(const float4*)(WUP + 1024 + 8 * wave), b1 = *(const float4*)(WUP + 1024 + 8 * wave + 4);
      bc[0] = b0.x; bc[1] = b0.y; bc[2] = b0.z; bc[3] = b0.w; bc[4] = b1.x; bc[5] = b1.y; bc[6] = b1.z; bc[7] = b1.w; }
#pragma unroll
    for (int r = 0; r < 16; ++r) { const float4 w0 = *(const float4*)(WUP + r * 64 + 8 * wave), w1 = *(const float4*)(WUP + r * 64 + 8 * wave + 4);
        bc[0] += al[r] * w0.x; bc[1] += al[r] * w0.y; bc[2] += al[r] * w0.z; bc[3] += al[r] * w0.w; bc[4] += al[r] * w1.x; bc[5] += al[r] * w1.y; bc[6] += al[r] * w1.z; bc[7] += al[r] * w1.w; }
#pragma unroll
    for (int e = 0; e < 8; ++e) { const float lg = bc[e]; bc[e] = (fminf(lg, 0.f) - __logf(1.f + __expf(-fabsf(lg)))) * (1.f / 16.f); }
#define DPP_ADD(x, ctrl, rmask) (x) += __int_as_float(__builtin_amdgcn_update_dpp(0, __float_as_int(x), (ctrl), (rmask), 0xf, true))
#pragma unroll
    for (int e = 0; e < 8; ++e) { DPP_ADD(bc[e], 0x111, 0xf); DPP_ADD(bc[e], 0x112, 0xf); DPP_ADD(bc[e], 0x114, 0xf); DPP_ADD(bc[e], 0x118, 0xf); DPP_ADD(bc[e], 0x142, 0xa); DPP_ADD(bc[e], 0x143, 0xc); }
#undef DPP_ADD
    float qv[8], kv[8], qd[8], kd[8]; unpack8(R.rq, qv); unpack8(R.rk, kv);
#pragma unroll
    for (int e = 0; e < 8; ++e) { const float bl = __shfl(bc[e], 63);
        qd[e] = qv[e] * 0.125f * __expf(bc[e]); kd[e] = kv[e] * __expf(-bc[e]);
        ((bf16_t*)(g + 16384))[(8 * wave + e) * 64 + lane] = f2bf(kv[e] * __expf(bl - bc[e]));
        if (lane == 63) ((float*)(g + 40960))[8 * wave + e] = __expf(bl); }
    *(bf16x8*)(g + (lane * 64 + 8 * wave) * 2) = pack8(qd); *(bf16x8*)(g + 8192 + (lane * 64 + 8 * wave) * 2) = pack8(kd);
    const unsigned vw[8] = {R.rv0.x, R.rv0.y, R.rv0.z, R.rv0.w, R.rv1.x, R.rv1.y, R.rv1.z, R.rv1.w};
    bf16_t* vt = (bf16_t*)(g + 24576);
#pragma unroll
    for (int e = 0; e < 8; ++e) { vt[(16 * wave + 2 * e) * 64 + lane] = (bf16_t)(vw[e] & 0xffffu); vt[(16 * wave + 2 * e + 1) * 64 + lane] = (bf16_t)(vw[e] >> 16); }
}
__device__ __forceinline__ void gla_pre_all(const bf16_t* __restrict__ P, unsigned char* __restrict__ GP, const LayerW& W, unsigned char* lds) {
    const int tid = tid_opaque(), lane = tid & 63, wave = tid >> 6;
    int u = blockIdx.x;
    if (u >= 1024) return;
    GlaPreRaw cur = gla_pre_load(P, u, lane, wave);
#pragma unroll 1
    while (u < 1024) {
        const int un = u + gridDim.x;
        GlaPreRaw nxt = cur;
        if (un < 1024) nxt = gla_pre_load(P, un, lane, wave);
        gla_pre_unit(cur, GP, W, u, lds, tid);
        cur = nxt; u = un;
    }
}

__device__ __forceinline__ void gla_item(const Params& p, int l, const bf16_t* __restrict__ P, bf16_t* __restrict__ Y, const unsigned char* __restrict__ GP, const LayerW& W, int item, unsigned char* lds) {
    const int tid = tid_opaque(), lane = tid & 63, wave = tid >> 6, l31 = lane & 31, hh = lane >> 5;
    const int b = item >> 3, h = item & 7;
    const size_t tokb = (size_t)b * SEQ;
    bf16_t* QD = (bf16_t*)lds; bf16_t* KD = QD + 64 * 72; bf16_t* KST = KD + 64 * 72; bf16_t* VT = KST + 64 * 72; bf16_t* ST = VT + 128 * 72;
    float* OB = (float*)(lds + 64768);
    const int vt = wave >> 1, it = wave & 1;
    const int srow = tid >> 3, sseg = tid & 7, ctok = tid >> 3, cvch = tid & 7;
    f32x16 S;
#pragma unroll
    for (int r = 0; r < 16; ++r) S[r] = 0.f;
    uint4 rQ, rK, rS, rV0, rV1, rg0, rg1; float rdec;
#define GLA_LOAD(k) do { const unsigned char* g_ = GP + (size_t)(item * 32 + (k)) * GP_UNIT + srow * 128 + sseg * 16; \
        rQ = *(const uint4*)g_; rK = *(const uint4*)(g_ + 8192); rS = *(const uint4*)(g_ + 16384); rV0 = *(const uint4*)(g_ + 24576); rV1 = *(const uint4*)(g_ + 24576 + 8192); \
        rdec = ((const float*)(GP + (size_t)(item * 32 + (k)) * GP_UNIT + 40960))[32 * it + l31]; \
        const bf16_t* gp_ = P + (tokb + (k) * 64 + ctok) * NPAD + C_GATE + h * 128 + cvch * 16; rg0 = *(const uint4*)gp_; rg1 = *(const uint4*)(gp_ + 8); } while (0)
    GLA_LOAD(0);
    unsigned* CS0 = (unsigned*)(lds + 98304); unsigned* CS1 = (unsigned*)(lds + 98304 + 16640);
    f32x4 ca[4], cb[4]; TrTile Ta, Tb;
    bool oka = host_tile(p, l, item * 32, Ta), okb = false;
    if (oka) tr_load(Ta, tid, ca);
    if (okb) tr_load(Tb, tid, cb);
    float nw[16];
#pragma unroll
    for (int e = 0; e < 16; ++e) nw[e] = W.gla_nw[cvch * 16 + e];
    __syncthreads();
#pragma unroll 1
    for (int k = 0; k < 32; ++k) {
        *(uint4*)(QD + srow * 72 + sseg * 8) = rQ; *(uint4*)(KD + srow * 72 + sseg * 8) = rK; *(uint4*)(KST + srow * 72 + sseg * 8) = rS;
        *(uint4*)(VT + srow * 72 + sseg * 8) = rV0; *(uint4*)(VT + (64 + srow) * 72 + sseg * 8) = rV1;
#pragma unroll
        for (int r = 0; r < 16; ++r) ST[(32 * vt + crow(r, hh)) * 72 + 32 * it + l31] = f2bf(S[r]);
        const float dec = rdec; const uint4 g0 = rg0, g1 = rg1;
        __syncthreads();
        if (k + 1 < 32) GLA_LOAD(k + 1);
        {
            f32x16 at0, at1, o, u;
#pragma unroll
            for (int r = 0; r < 16; ++r) { at0[r] = 0.f; at1[r] = 0.f; o[r] = 0.f; u[r] = 0.f; }
#pragma unroll
            for (int ks = 0; ks < 4; ++ks) {
                const bf16x8 bq = *(const bf16x8*)(QD + (32 * it + l31) * 72 + 16 * ks + 8 * hh);
                const bf16x8 a0 = *(const bf16x8*)(KD + l31 * 72 + 16 * ks + 8 * hh), a1 = *(const bf16x8*)(KD + (32 + l31) * 72 + 16 * ks + 8 * hh);
                at0 = MFMA32(a0, bq, at0); at1 = MFMA32(a1, bq, at1); }
            const int iq = 32 * it + l31;
#pragma unroll
            for (int r = 0; r < 16; ++r) { const int j0 = crow(r, hh); if (j0 > iq) at0[r] = 0.f; if (j0 + 32 > iq) at1[r] = 0.f; }
#pragma unroll
            for (int jt2 = 0; jt2 < 2; ++jt2)
#pragma unroll
                for (int s2 = 0; s2 < 2; ++s2) { float pf[8];
#pragma unroll
                    for (int e = 0; e < 8; ++e) pf[e] = jt2 ? at1[8 * s2 + e] : at0[8 * s2 + e];
                    const bf16x8 pb = pack8(pf);
                    const bf16_t* vp = VT + (32 * vt + l31) * 72 + 32 * jt2 + 16 * s2 + 4 * hh;
                    const s16x4 lo = *(const s16x4*)vp, hi = *(const s16x4*)(vp + 8);
                    o = MFMA32(__builtin_shufflevector(lo, hi, 0, 1, 2, 3, 4, 5, 6, 7), pb, o); }
#pragma unroll
            for (int ks = 0; ks < 4; ++ks) {
                const bf16x8 a = *(const bf16x8*)(ST + (32 * vt + l31) * 72 + 16 * ks + 8 * hh);
                const bf16x8 bq = *(const bf16x8*)(QD + (32 * it + l31) * 72 + 16 * ks + 8 * hh);
                o = MFMA32(a, bq, o); }
#pragma unroll
            for (int ks = 0; ks < 4; ++ks) {
                const bf16x8 a = *(const bf16x8*)(VT + (32 * vt + l31) * 72 + 16 * ks + 8 * hh);
                const bf16x8 bk = *(const bf16x8*)(KST + (32 * it + l31) * 72 + 16 * ks + 8 * hh);
                u = MFMA32(a, bk, u); }
#pragma unroll
            for (int r = 0; r < 16; ++r) { S[r] = dec * S[r] + u[r]; OB[(32 * it + l31) * 129 + 32 * vt + crow(r, hh)] = o[r]; }
        }
        const TrTile Fa = Ta, Fb = Tb; const bool fa = oka, fb = okb;
        if (fa) tr_stage(tid, ca, CS0);
        if (fb) tr_stage(tid, cb, CS1);
        oka = (k + 1 < 32) && host_tile(p, l, item * 32 + k + 1, Ta); okb = false;
        if (oka) tr_load(Ta, tid, ca);
        if (okb) tr_load(Tb, tid, cb);
        __syncthreads();
        if (fa) tr_flush(Fa, tid, CS0);
        if (fb) tr_flush(Fb, tid, CS1);
        {
            float ov[16]; float ss = 0.f;
#pragma unroll
            for (int e = 0; e < 16; ++e) { ov[e] = OB[ctok * 129 + cvch * 16 + e]; ss += ov[e] * ov[e]; }
            ss += __shfl_xor(ss, 1); ss += __shfl_xor(ss, 2); ss += __shfl_xor(ss, 4);
            const float rstd = rsqrtf(ss * (1.f / 128.f) + EPS);
            float gf[16]; unpack8(g0, gf); unpack8(g1, gf + 8);
#pragma unroll
            for (int e = 0; e < 16; ++e) ov[e] *= rstd * nw[e] * gf[e];
            bf16_t* yp = Y + (tokb + k * 64 + ctok) * DM + h * 128 + cvch * 16;
            *(bf16x8*)yp = pack8(ov); *(bf16x8*)(yp + 8) = pack8(ov + 8);
        }
    }
#undef GLA_LOAD
    __syncthreads();
}

constexpr int QSLOT_OFF = LDS_BYTES - 16;
constexpr size_t WS_CTR = WS_END;
constexpr size_t WS_BAR = WS_END + 512;
constexpr size_t WS_CTL_BYTES = 512 + XCD_BAR_WORDS_C * 4;
__device__ __forceinline__ void phase_mix_fast(const Params& p, int l, unsigned char* lds, int rep) {
    const LayerW W = layer_w(p, l);
    const bf16_t* P = (const bf16_t*)(p.ws + WS_PROJ); bf16_t* Y = (bf16_t*)(p.ws + WS_Y);
    unsigned* ctr = (unsigned*)(p.ws + WS_CTR) + l * 64 + rep * 16;
    const float lam = diff_lambda(W);
    volatile int* slot = (volatile int*)(lds + QSLOT_OFF);
    for (;;) {
        __syncthreads();
        if (tid_opaque() == 0) *slot = (int)atomicAdd(ctr, 1u);
        __syncthreads();
        const int it = __builtin_amdgcn_readfirstlane(*slot);
        if (it >= 1056) break;
        if (it < 32) { gla_item(p, l, P, Y, p.ws + WS_GP, W, it, lds);
#ifdef PROBE_GLA2
            gla_item(p, l, P, Y, p.ws + WS_GP, W, it, lds);
#endif
        }
        else if (it < 544) diff_item3(p, l, P, Y, W, lam, it - 32, lds);
        else if (it < 800) attn_item<true>(P, Y, W, lam, it - 544, lds);
        else lru_fix_item(P, Y, (const float*)(p.ws + WS_LA), (const float*)(p.ws + WS_LU), it - 800);
    }
}

#define XB_TMO      128
#define XB_XCNT(j)  (256  + 64 * (j))
#define XB_XSUB(j)  (1280 + 64 * (j))
#define XB_XGEN(j)  (2304 + 64 * (j))
#define XB_TOP      3328
#define XB_TOPGEN   3392
#define XCD_BAR_WORDS 3456
#define XB_SPIN_CAP (1u << 18)

__device__ __forceinline__ unsigned xb_ld(unsigned* p)              { return __hip_atomic_load(p, __ATOMIC_RELAXED, __HIP_MEMORY_SCOPE_AGENT); }
__device__ __forceinline__ unsigned xb_add(unsigned* p, unsigned v) { return __hip_atomic_fetch_add(p, v, __ATOMIC_RELAXED, __HIP_MEMORY_SCOPE_AGENT); }
__device__ __forceinline__ unsigned xb_xcc_id() { return (unsigned)__builtin_amdgcn_s_getreg((3 << 11) | 20) & 0xFu; }
#define XB_SPIN(cond, bar) do { unsigned _sp = 0; while (cond) { __builtin_amdgcn_s_sleep(1); \
    if ((++_sp & 255u) == 0u) { if (xb_ld(&(bar)[XB_TMO])) break; if (_sp > XB_SPIN_CAP) { atomicAdd(&(bar)[XB_TMO], 1u); break; } } } } while (0)

struct XcdBarrier {
    unsigned* bar; unsigned x;
    volatile LAS unsigned* st;
};

__device__ __forceinline__ XcdBarrier xcd_barrier_post(unsigned* bar, volatile LAS unsigned* st) {
    XcdBarrier b; b.bar = bar; b.x = xb_xcc_id(); b.st = st;
    if (threadIdx.x == 0) (void)xb_add(&bar[XB_XCNT(b.x)], 1u);
    return b;
}
__device__ __forceinline__ void xcd_barrier_complete(unsigned* bar, unsigned x, unsigned& nloc, unsigned& nx) {
    const unsigned G = gridDim.x * gridDim.y * gridDim.z;
    unsigned sum, cnt, mine, sp = 0u;
    for (;;) {
        sum = 0u; cnt = 0u; mine = 0u;
#pragma unroll
        for (unsigned j = 0; j < 16; ++j) { const unsigned c = xb_ld(&bar[XB_XCNT(j)]); sum += c; cnt += (c > 0u) ? 1u : 0u; mine = (j == x) ? c : mine; }
        if (sum == G) break;
        __builtin_amdgcn_s_sleep(1);
        if ((++sp & 255u) == 0u) { if (xb_ld(&bar[XB_TMO])) break; if (sp > XB_SPIN_CAP) { atomicAdd(&bar[XB_TMO], 1u); break; } }
    }
    nloc = mine > 0u ? mine : 1u; nx = cnt > 0u ? cnt : 1u;
}

__device__ __forceinline__ void xcd_barrier(const XcdBarrier& b) {
    asm volatile("s_waitcnt vmcnt(0)" ::: "memory");
    __syncthreads();
    if (threadIdx.x == 0) {
        unsigned* bar = b.bar;
        __builtin_amdgcn_s_waitcnt(0);
        unsigned nloc = b.st[0], nx = b.st[1];
        if (nloc == 0u) { xcd_barrier_complete(bar, b.x, nloc, nx); b.st[0] = nloc; b.st[1] = nx; }
        const unsigned old = xb_add(&bar[XB_XSUB(b.x)], 1u);
        const unsigned gen = old / nloc;
        if (old + 1u == (gen + 1u) * nloc) {
            __builtin_amdgcn_fence(__ATOMIC_RELEASE, "agent");
            asm volatile("s_waitcnt vmcnt(0)" ::: "memory");
            const unsigned og = xb_add(&bar[XB_TOP], 1u);
            const unsigned tg = og / nx;
            if (og + 1u == (tg + 1u) * nx) xb_add(&bar[XB_TOPGEN], 1u);
            else XB_SPIN(xb_ld(&bar[XB_TOPGEN]) == tg, bar);
            __builtin_amdgcn_fence(__ATOMIC_ACQUIRE, "agent");
            xb_add(&bar[XB_XGEN(b.x)], 1u);
            asm volatile("s_waitcnt vmcnt(0)" ::: "memory");
        } else {
            XB_SPIN(xb_ld(&bar[XB_XGEN(b.x)]) == gen, bar);
            __builtin_amdgcn_fence(__ATOMIC_ACQUIRE, "agent");
            asm volatile("s_waitcnt vmcnt(0)" ::: "memory");
        }
    }
    __syncthreads();
}


#ifndef GEMM_SP2
#define GEMM_SP2 true
#endif
#ifndef GEMM_ALIGN
#define GEMM_ALIGN true
#endif
#ifndef REP_M1
#define REP_M1 1
#endif
#ifndef REP_PREP
#define REP_PREP 1
#endif
#ifndef REP_G1
#define REP_G1 1
#endif
#ifndef REP_MIX
#define REP_MIX 1
#endif
__global__ void __launch_bounds__(512, 2) mega(Params p) {
    extern __shared__ __attribute__((aligned(16))) unsigned char lds[];
    cg::grid_group grid = cg::this_grid();
    const int lo = p.ph_lo, hi = p.ph_hi;
#define IN(k) (lo <= (k) && (k) < hi)
#define SYNC(k) do { if (IN(k) && IN((k) + 1)) xcd_barrier(xbar); } while (0)
    if (lo < 0) grid.sync();
    volatile LAS unsigned* xst = (volatile LAS unsigned*)((LAS unsigned char*)lds + (LDS_BYTES - 32));
    if (threadIdx.x < 2) xst[threadIdx.x] = 0u;
    __syncthreads();
    XcdBarrier xbar; xbar.bar = (unsigned*)(p.ws + WS_BAR); xbar.x = xb_xcc_id(); xbar.st = xst;
    if (threadIdx.x == 0) xst[2] = xb_add(&xbar.bar[XB_XCNT(xbar.x)], 1u);
    __syncthreads();
    const int xrank = (int)xst[2];
    int cu_c = (int)blockIdx.x;
#ifdef EXTRA_SYNC
    if (hi - lo > 1) {
#pragma unroll 1
        for (int r = 0; r < EXTRA_SYNC; ++r) grid.sync(); }
#endif
    if (IN(0)) {
#pragma unroll 1
        for (int r = 0; r < REP_PREP; ++r) phase_prep(p, lds); }
    SYNC(0);
    if (hi - lo > 1) {
        bool even = (gridDim.x % 8 == 0);
        for (unsigned j = 0; j < 16; ++j) { const unsigned cnt = xb_ld(&xbar.bar[XB_XCNT(j)]); even = even && (cnt == (j < 8 ? gridDim.x / 8 : 0u)); }
        if (even) cu_c = (int)xbar.x + 8 * xrank;
    }
#pragma unroll 1
    for (int l = 0; l < 2; ++l) {
        const int pb = 1 + 5 * l;
        if (IN(pb)) {
            pg8::Gemm g{(const bf16_t*)(p.ws + WS_H), (const bf16_t*)(p.ws + WS_WIN + l * SZ_WIN), TOK, NPAD, DM};
            pg8::StaticOrder S; S.init(TOK, NPAD, (int)gridDim.x, cu_c);
            EpiProj E{(bf16_t*)(p.ws + WS_PROJ)};
#pragma unroll 1
            for (int r = 0; r < REP_G1; ++r)
            pg8::gemm_phase<EpiProj, pg8::StaticOrder, GEMM_ALIGN, GEMM_SP2>((LAS unsigned char*)lds, g, S, E);
            { const int nwg = (TOK / 256) * (NPAD / 256), G = (int)gridDim.x, rem = nwg % G;
              if (rem == 0) convert_deferred(p, l, cu_c, G, lds);
              else if (cu_c >= rem) convert_deferred(p, l, cu_c - rem, G - rem, lds); }
        }
        SYNC(pb);
        if (IN(pb + 1)) { const LayerW W = layer_w(p, l);
#pragma unroll 1
          for (int r1 = 0; r1 < REP_M1; ++r1) {
            gla_pre_all((const bf16_t*)(p.ws + WS_PROJ), p.ws + WS_GP, W, lds);
            for (int it = blockIdx.x; it < 256; it += gridDim.x) lru_pre_item((const bf16_t*)(p.ws + WS_PROJ), (float*)(p.ws + WS_LA), (float*)(p.ws + WS_LU), W, it, lds); } }
        SYNC(pb + 1);
        if (IN(pb + 2)) {
#pragma unroll 1
            for (int r = 0; r < REP_MIX; ++r) phase_mix_fast(p, l, lds, r); }
        SYNC(pb + 2);
        if (IN(pb + 3)) {
            pg8::Gemm g{(const bf16_t*)(p.ws + WS_Y), (const bf16_t*)(p.ws + WS_WOUT + l * SZ_WOUT), TOK, DM, DM};
            pg8::StaticOrder S; S.init(TOK, DM, (int)gridDim.x, cu_c);
            EpiRes E{l == 0 ? p.in[0] : (const float*)(p.ws + WS_X1), l == 0 ? (float*)(p.ws + WS_X1) : p.out};
            pg8::gemm_phase<EpiRes, pg8::StaticOrder, GEMM_ALIGN, GEMM_SP2>((LAS unsigned char*)lds, g, S, E);
        }
        SYNC(pb + 3);
        if (l == 0) {
            if (IN(pb + 4)) rmsnorm_rows((const float*)(p.ws + WS_X1), p.in[1] + DM, (bf16_t*)(p.ws + WS_H));
            SYNC(pb + 4);
        }
    }
}

#ifndef COOP
#define COOP 1
#endif
extern "C" void kernel_launch(void* const* d_in, const int* in_sizes, int n_in, void* d_out, int out_size, void* d_ws, size_t ws_size, hipStream_t stream) {
    static int grid = 0;
    if (grid == 0) {
        if (n_in != 24 || ws_size < WS_END + 65536) { fprintf(stderr, "kernel_launch: unexpected n_in %d / ws %zu (need %zu)\n", n_in, ws_size, (size_t)WS_END); grid = -1; return; }
        if (hipFuncSetAttribute((const void*)mega, hipFuncAttributeMaxDynamicSharedMemorySize, LDS_BYTES) != hipSuccess) { fprintf(stderr, "kernel_launch: hipFuncSetAttribute failed\n"); grid = -1; return; }
        int dev = 0, cus = 0, per_cu = 0;
        hipGetDevice(&dev); hipDeviceGetAttribute(&cus, hipDeviceAttributeMultiprocessorCount, dev);
        hipOccupancyMaxActiveBlocksPerMultiprocessor(&per_cu, (const void*)mega, 512, LDS_BYTES);
        if (per_cu < 1) { fprintf(stderr, "kernel_launch: occupancy query says %d blocks/CU\n", per_cu); per_cu = 1; }
        grid = cus * 1;
        (void)hipGetLastError();
    }
    if (grid < 0) return;
    Params p{};
    for (int i = 0; i < 24; ++i) p.in[i] = (const float*)d_in[i];
    p.out = (float*)d_out; p.ws = (unsigned char*)d_ws;
    if (hipMemsetAsync((unsigned char*)d_ws + WS_CTR, 0, WS_CTL_BYTES, stream) != hipSuccess) { fprintf(stderr, "kernel_launch: memset failed\n"); return; }
#if COOP
    p.ph_lo = 0; p.ph_hi = NPH - 1 + 0;
    p.ph_hi = NPH;
    void* args[] = {&p};
    hipError_t e = hipLaunchCooperativeKernel((const void*)mega, dim3(grid), dim3(512), args, LDS_BYTES, stream);
    if (e != hipSuccess) fprintf(stderr, "cooperative launch failed: %s (grid %d)\n", hipGetErrorString(e), grid);
#else
    for (int ph = 0; ph < NPH; ++ph) { p.ph_lo = ph; p.ph_hi = ph + 1; hipLaunchKernelGGL(mega, dim3(grid), dim3(512), LDS_BYTES, stream, p); }
#endif
}
```

```cpp
#include <hip/hip_runtime.h>
#include <hip/hip_cooperative_groups.h>
#include <cstdio>
namespace cg = cooperative_groups;
namespace pg8 {
#define PG8_LAS __attribute__((address_space(3)))
typedef unsigned short bf16_t;
typedef short bf16x8 __attribute__((ext_vector_type(8)));
typedef float f32x4 __attribute__((ext_vector_type(4)));
typedef unsigned u32x4 __attribute__((ext_vector_type(4)));
constexpr int BM = 256, BK = 64, HALF = 128, HTB = HALF * BK * 2  , STAGE_BYTES = 8 * HTB, NXCD = 8, WGM = 4;

__host__ __device__ __forceinline__ int lds_byte(int r, int c) { const int st = (r >> 4) * 2 + (c >> 5), rr = r & 15, cc = c & 31, ob = rr * 64 + cc * 2; return st * 1024 + (ob ^ (((ob >> 9) & 1) << 5)); }
__host__ __device__ __forceinline__ void stage_rc(int b, int& R, int& C) { const int st = b / 1024, sb = b % 1024, swz = sb ^ (((sb >> 9) & 1) << 5); R = (st >> 1) * 16 + swz / 64; C = (st & 1) * 32 + (swz % 64) / 2; }
__host__ __device__ __forceinline__ int perm32(int rho) { const int n = rho >> 4, i = rho & 15; return 8 * (i >> 2) + 4 * n + (i & 3); }

struct Unit { int pm, pn; };
struct Gemm { const bf16_t* A; const bf16_t* Bt; int M, N, K; };

struct StaticOrder {
    int nM, nN, nwg, G, c;
    __host__ __device__ void init(int M, int N, int G_, int c_) { nM = M / BM; nN = N / BM; nwg = nM * nN; G = G_; c = c_; }
    __host__ __device__ bool next(int i, Unit& u) const {
        const long L = (long)i * G + c; if (L >= nwg) return false;
        int wgid = (int)L; { const int q = nwg / NXCD, r = nwg % NXCD, xcd = wgid % NXCD, off = wgid / NXCD; wgid = (xcd < r ? xcd * (q + 1) : r * (q + 1) + (xcd - r) * q) + off; }
        const int nig = WGM * nN, gid = wgid / nig, fm = gid * WGM, gsz = (nM - fm) < WGM ? (nM - fm) : WGM;
        u.pm = fm + ((wgid % nig) % gsz); u.pn = (wgid % nig) / gsz; return true;
    }
    __device__ __forceinline__ void a_ready(const Unit&) const {}
    __device__ __forceinline__ void done(const Unit&) const {}
};
__device__ __forceinline__ unsigned cvt_pk_bf16(float lo, float hi) { unsigned r; asm volatile("v_cvt_pk_bf16_f32 %0, %1, %2" : "=v"(r) : "v"(lo), "v"(hi)); return r; }
typedef float f32x2 __attribute__((ext_vector_type(2)));
template <class Epi, class Sched, bool ALIGN_EPI = false, bool SP2 = false>
__device__ __forceinline__ void gemm_phase(PG8_LAS unsigned char* lds, const Gemm g, const Sched& S, const Epi& E) {
    int tid_ = threadIdx.x; asm volatile("" : "+v"(tid_)); const int tid = tid_, wid = __builtin_amdgcn_readfirstlane(tid >> 6), lane = tid & 63, wr = wid >> 2, wc = wid & 3, fr = lane & 15, fq = lane >> 4;
    const int K = g.K, nt = K / BK;
    unsigned voffA[2], voffB[2];
#pragma unroll
    for (int i = 0; i < 2; ++i) { int R, C; stage_rc(tid * 16 + i * 8192, R, C); const int Rb = Epi::PERM ? ((R & ~31) + perm32(R & 31)) : R;
        voffA[i] = (unsigned)(R * K + C) * 2u; voffB[i] = (unsigned)(Rb * K + C) * 2u; }
    const size_t kstep = (size_t)(BK * 2);
    const size_t hstep = (size_t)HALF * K * 2;
    const size_t tstep = 2 * hstep;
    const unsigned ldsw = (unsigned)wid * 1024u;
    const int aoff = lds_byte(wr * 64 + fr, fq * 8), boff = lds_byte(wc * 32 + fr, fq * 8);
#define PG8_SA(b, h) (((b) * 2 + (h)) * HTB)
#define PG8_SB(b, h) ((4 + (b) * 2 + (h)) * HTB)
#define PG8_STAGE(bufoff, gbase, voff) do { _Pragma("unroll") for (int _i = 0; _i < 2; ++_i) \
        __builtin_amdgcn_global_load_lds((const unsigned*)((const char*)(gbase) + (voff)[_i]), (PG8_LAS unsigned*)(lds + (bufoff) + ldsw + _i * 8192), 16, 0, 0); } while (0)
#define PG8_LDA(dst, b, h) do { _Pragma("unroll") for (int m = 0; m < 4; ++m) _Pragma("unroll") for (int k = 0; k < 2; ++k) dst[m][k] = *(const PG8_LAS bf16x8*)(lds + PG8_SA(b, h) + aoff + m * 2048 + k * 1024); } while (0)
#define PG8_LDB(dst, b, h) do { _Pragma("unroll") for (int n = 0; n < 2; ++n) _Pragma("unroll") for (int k = 0; k < 2; ++k) dst[n][k] = *(const PG8_LAS bf16x8*)(lds + PG8_SB(b, h) + boff + n * 2048 + k * 1024); } while (0)
#define PG8_MMA(ai, bj, At, Bt) do { __builtin_amdgcn_s_setprio(1); _Pragma("unroll") for (int m = 0; m < 4; ++m) _Pragma("unroll") for (int n = 0; n < 2; ++n) _Pragma("unroll") for (int k = 0; k < 2; ++k) \
        acc[ai][bj][m][n] = __builtin_amdgcn_mfma_f32_16x16x32_bf16(Bt[n][k], At[m][k], acc[ai][bj][m][n], 0, 0, 0); __builtin_amdgcn_s_setprio(0); } while (0)
#define PG8_WAIT_V(n) asm volatile("s_waitcnt vmcnt(" #n ")" ::: "memory")
#define PG8_WAIT_L(n) asm volatile("s_waitcnt lgkmcnt(" #n ")" ::: "memory")
#define PG8_BAR __builtin_amdgcn_s_barrier()
#define PG8_SCHED __builtin_amdgcn_sched_barrier(0)
    Unit cur, nxt; int ui = 0;
    if (!S.next(0, cur)) return;
    f32x4 acc[2][2][4][2];
    E.init(acc, cur, wr, wc, fr, fq);
    bf16x8 At[4][2], B0[2][2], B1[2][2];
    const char* cA = (const char*)g.A + (size_t)cur.pm * tstep; const char* cB = (const char*)g.Bt + (size_t)cur.pn * tstep;
    S.a_ready(cur);
    if constexpr (SP2) {
        PG8_STAGE(PG8_SB(0, 0), cB, voffB); PG8_STAGE(PG8_SB(0, 1), cB + hstep, voffB); PG8_STAGE(PG8_SA(0, 0), cA, voffA); PG8_STAGE(PG8_SA(0, 1), cA + hstep, voffA);
        if (wr == 1) PG8_BAR;
        PG8_WAIT_V(2); PG8_BAR;
        PG8_STAGE(PG8_SB(1, 0), cB + kstep, voffB); PG8_STAGE(PG8_SA(1, 0), cA + kstep, voffA); PG8_STAGE(PG8_SB(1, 1), cB + hstep + kstep, voffB);
        PG8_WAIT_V(6); PG8_BAR;
    } else {
        PG8_STAGE(PG8_SB(0, 0), cB, voffB); PG8_STAGE(PG8_SA(0, 0), cA, voffA); PG8_STAGE(PG8_SB(0, 1), cB + hstep, voffB); PG8_STAGE(PG8_SA(0, 1), cA + hstep, voffA);
        if (wr == 1) PG8_BAR;
        PG8_WAIT_V(4); PG8_BAR;
        PG8_STAGE(PG8_SB(1, 0), cB + kstep, voffB); PG8_STAGE(PG8_SA(1, 0), cA + kstep, voffA); PG8_STAGE(PG8_SB(1, 1), cB + hstep + kstep, voffB);
        PG8_WAIT_V(6); PG8_BAR;
    }
    for (;;) {
        const bool has_next = S.next(ui + 1, nxt);
        const char* nA = has_next ? (const char*)g.A + (size_t)nxt.pm * tstep : cA; const char* nB = has_next ? (const char*)g.Bt + (size_t)nxt.pn * tstep : cB;
        for (int t = 0; t < nt; t += 2) {
            const bool last = (t == nt - 2);
            const char* a1 = cA + (size_t)(t + 1) * kstep;
            const char* a2 = last ? nA : cA + (size_t)(t + 2) * kstep; const char* b2 = last ? nB : cB + (size_t)(t + 2) * kstep;
            const char* a3 = a2 + kstep; const char* b3 = b2 + kstep;
            if (last && has_next) S.a_ready(nxt);
            if constexpr (SP2) {
            PG8_LDB(B0, 0, 0); PG8_LDB(B1, 0, 1); PG8_SCHED; PG8_LDA(At, 0, 0); PG8_STAGE(PG8_SA(1, 1), a1 + hstep, voffA);
            PG8_WAIT_V(8); PG8_WAIT_L(0); PG8_BAR; PG8_MMA(0, 0, At, B0); PG8_MMA(0, 1, At, B1); PG8_BAR; PG8_SCHED;
            PG8_LDA(At, 0, 1); PG8_STAGE(PG8_SB(0, 0), b2, voffB); PG8_STAGE(PG8_SB(0, 1), b2 + hstep, voffB); PG8_STAGE(PG8_SA(0, 0), a2, voffA);
            PG8_WAIT_V(8); PG8_WAIT_L(0); PG8_BAR; PG8_MMA(1, 0, At, B0); PG8_MMA(1, 1, At, B1); PG8_BAR; PG8_SCHED;
            PG8_LDB(B0, 1, 0); PG8_LDB(B1, 1, 1); PG8_SCHED; PG8_LDA(At, 1, 0); PG8_STAGE(PG8_SA(0, 1), a2 + hstep, voffA);
            PG8_WAIT_V(8); PG8_WAIT_L(0); PG8_BAR; PG8_MMA(0, 0, At, B0); PG8_MMA(0, 1, At, B1); PG8_BAR; PG8_SCHED;
            PG8_LDA(At, 1, 1); PG8_STAGE(PG8_SB(1, 0), b3, voffB); PG8_STAGE(PG8_SB(1, 1), b3 + hstep, voffB); PG8_STAGE(PG8_SA(1, 0), a3, voffA);
            PG8_WAIT_V(8); PG8_WAIT_L(0); PG8_BAR; PG8_MMA(1, 0, At, B0); PG8_MMA(1, 1, At, B1); PG8_BAR; PG8_SCHED;
            } else {
            PG8_LDB(B0, 0, 0); PG8_SCHED; PG8_LDA(At, 0, 0); PG8_STAGE(PG8_SA(1, 1), a1 + hstep, voffA);
            PG8_WAIT_L(8); PG8_BAR; PG8_WAIT_L(0); PG8_MMA(0, 0, At, B0); PG8_BAR; PG8_SCHED;
            PG8_LDB(B1, 0, 1); PG8_STAGE(PG8_SB(0, 0), b2, voffB);
            PG8_BAR; PG8_WAIT_L(0); PG8_MMA(0, 1, At, B1); PG8_BAR;
            PG8_LDA(At, 0, 1); PG8_STAGE(PG8_SA(0, 0), a2, voffA);
            PG8_BAR; PG8_WAIT_L(0); PG8_MMA(1, 0, At, B0); PG8_BAR; PG8_SCHED;
            PG8_STAGE(PG8_SB(0, 1), b2 + hstep, voffB);
            PG8_WAIT_V(6); PG8_BAR; PG8_MMA(1, 1, At, B1); PG8_BAR;
            PG8_LDB(B0, 1, 0); PG8_SCHED; PG8_LDA(At, 1, 0); PG8_STAGE(PG8_SA(0, 1), a2 + hstep, voffA);
            PG8_WAIT_L(8); PG8_BAR; PG8_WAIT_L(0); PG8_MMA(0, 0, At, B0); PG8_BAR; PG8_SCHED;
            PG8_LDB(B1, 1, 1); PG8_STAGE(PG8_SB(1, 0), b3, voffB);
            PG8_BAR; PG8_WAIT_L(0); PG8_MMA(0, 1, At, B1); PG8_BAR;
            PG8_LDA(At, 1, 1); PG8_STAGE(PG8_SA(1, 0), a3, voffA);
            PG8_BAR; PG8_WAIT_L(0); PG8_MMA(1, 0, At, B0); PG8_BAR; PG8_SCHED;
            PG8_STAGE(PG8_SB(1, 1), b3 + hstep, voffB);
            PG8_WAIT_V(6); PG8_BAR; PG8_MMA(1, 1, At, B1); PG8_BAR;
            }
        }
        if constexpr (ALIGN_EPI) { if (wr == 0) PG8_BAR; }
        if constexpr (!Epi::AFTER_DRAIN) { E(acc, cur, wr, wc, fr, fq); S.done(cur); }
        if (!has_next) break;
        E.init(acc, nxt, wr, wc, fr, fq);
        cur = nxt; cA = nA; cB = nB; ++ui;
        if constexpr (ALIGN_EPI) { if (wr == 1) PG8_BAR; }
    }
    PG8_WAIT_V(0);
    if constexpr (!ALIGN_EPI) { if (wr == 0) PG8_BAR; }
    PG8_BAR;
    if constexpr (Epi::AFTER_DRAIN) { E.fused(acc, cur, wr, wc, fr, fq, lds, wid, lane); S.done(cur); }
#undef PG8_SA
#undef PG8_SB
#undef PG8_STAGE
#undef PG8_LDA
#undef PG8_LDB
#undef PG8_MMA
#undef PG8_WAIT_V
#undef PG8_WAIT_L
#undef PG8_BAR
#undef PG8_SCHED
}
}

#define LAS __attribute__((address_space(3)))
typedef unsigned short bf16_t;
typedef float f32x4 __attribute__((ext_vector_type(4)));
typedef unsigned u32x4 __attribute__((ext_vector_type(4)));
constexpr int TOK = 8192, SEQ = 2048, DM = 4096, NIN = 11792, NPAD = 12032;
constexpr int C_GQ = 0, C_GK = 512, C_GV = 1024, C_SQ = 2048, C_SK = 3072, C_SV = 3328, C_DQ = 3584, C_DK = 4608, C_DV = 5632, C_RX = 6656, C_GATE = 7680, C_GA = 11776;
constexpr float EPS = 1e-6f;
constexpr int LDS_BYTES = 152 * 1024;
constexpr int NPH = 10;
constexpr int XCD_BAR_WORDS_C = 3456;
constexpr size_t WS_WIN = 0;
constexpr size_t SZ_WIN = (size_t)NPAD * DM * 2;
constexpr size_t WS_WOUT = WS_WIN + 2 * SZ_WIN;
constexpr size_t SZ_WOUT = (size_t)DM * DM * 2;
constexpr size_t WS_H = WS_WOUT + 2 * SZ_WOUT;
constexpr size_t WS_PROJ = WS_H + (size_t)TOK * DM * 2;
constexpr size_t WS_Y = WS_PROJ + (size_t)TOK * NPAD * 2;
constexpr size_t WS_X1 = WS_Y + (size_t)TOK * DM * 2;
constexpr size_t WS_LA = WS_X1 + (size_t)TOK * DM * 4;
constexpr size_t WS_LU = WS_LA + (size_t)TOK * 1024 * 4;
constexpr size_t WS_GP = WS_LU + (size_t)TOK * 1024 * 4;
constexpr size_t WS_END = WS_GP + (size_t)1024 * 41216;

struct Params { const float* in[24]; float* out; unsigned char* ws; int ph_lo, ph_hi; };

__device__ __forceinline__ int tid_opaque() { int t = threadIdx.x; asm volatile("" : "+v"(t)); return t; }
__device__ __forceinline__ float bf2f(bf16_t b) { return __uint_as_float(((unsigned)b) << 16); }
typedef __bf16 bf16v2_t __attribute__((ext_vector_type(2)));
typedef float f32v2_t __attribute__((ext_vector_type(2)));
__device__ __forceinline__ unsigned cvt2(float lo, float hi) { f32v2_t f = {lo, hi}; bf16v2_t b = __builtin_convertvector(f, bf16v2_t); return __builtin_bit_cast(unsigned, b); }
__device__ __forceinline__ bf16_t f2bf(float f) { return (bf16_t)(cvt2(f, f) & 0xffffu); }
__device__ __forceinline__ unsigned pk2(float lo, float hi) { return cvt2(lo, hi); }
__device__ __forceinline__ float wsum(float v) { for (int o = 32; o; o >>= 1) v += __shfl_xor(v, o); return v; }
__device__ __forceinline__ float wmax(float v) { for (int o = 32; o; o >>= 1) v = fmaxf(v, __shfl_xor(v, o)); return v; }
__device__ __forceinline__ float siluf(float x) { return x / (1.f + __expf(-x)); }
__device__ __forceinline__ float sigmf(float x) { return 1.f / (1.f + __expf(-x)); }
__device__ __forceinline__ void unpack8(const uint4 u, float* f) {
    f[0] = __uint_as_float(u.x << 16); f[1] = __uint_as_float(u.x & 0xffff0000u); f[2] = __uint_as_float(u.y << 16); f[3] = __uint_as_float(u.y & 0xffff0000u);
    f[4] = __uint_as_float(u.z << 16); f[5] = __uint_as_float(u.z & 0xffff0000u); f[6] = __uint_as_float(u.w << 16); f[7] = __uint_as_float(u.w & 0xffff0000u);
}

struct EpiProj {
    static constexpr bool PERM = true, AFTER_DRAIN = false;
    bf16_t* O;
    __device__ __forceinline__ void init(f32x4 (&acc)[2][2][4][2], const pg8::Unit&, int, int, int, int) const {
#pragma unroll
        for (int a = 0; a < 2; ++a)
#pragma unroll
            for (int b = 0; b < 2; ++b)
#pragma unroll
                for (int m = 0; m < 4; ++m)
#pragma unroll
                    for (int n = 0; n < 2; ++n) acc[a][b][m][n] = (f32x4){0.f, 0.f, 0.f, 0.f};
    }
    __device__ __forceinline__ void operator()(const f32x4 (&acc)[2][2][4][2], const pg8::Unit& u, int wr, int wc, int fr, int fq) const {
        const int row0 = u.pm * 256 + wr * 64 + fr, col0 = u.pn * 256 + wc * 32 + 8 * fq;
        const bool act = (u.pn >= 30 && u.pn < 46);
#pragma unroll
        for (int ai = 0; ai < 2; ++ai)
#pragma unroll
            for (int m = 0; m < 4; ++m) { bf16_t* rowp = O + (size_t)(row0 + ai * 128 + m * 16) * NPAD + col0;
#pragma unroll
                for (int bj = 0; bj < 2; ++bj) { f32x4 v0 = acc[ai][bj][m][0], v1 = acc[ai][bj][m][1];
                    if (act) {
#pragma unroll
                        for (int j = 0; j < 4; ++j) { v0[j] = v0[j] * __builtin_amdgcn_rcpf(1.f + __builtin_amdgcn_exp2f(-1.4426950408889634f * v0[j])); v1[j] = v1[j] * __builtin_amdgcn_rcpf(1.f + __builtin_amdgcn_exp2f(-1.4426950408889634f * v1[j])); } }
                    u32x4 w; w.x = pg8::cvt_pk_bf16(v0[0], v0[1]); w.y = pg8::cvt_pk_bf16(v0[2], v0[3]); w.z = pg8::cvt_pk_bf16(v1[0], v1[1]); w.w = pg8::cvt_pk_bf16(v1[2], v1[3]);
                    *(u32x4*)(rowp + bj * 128) = w; } }
    }
};
struct EpiRes {
    static constexpr bool PERM = false, AFTER_DRAIN = false;
    const float* R; float* C;
    __device__ __forceinline__ void init(f32x4 (&acc)[2][2][4][2], const pg8::Unit& u, int wr, int wc, int fr, int fq) const {
        const int row0 = u.pm * 256 + wr * 64 + fr, col0 = u.pn * 256 + wc * 32 + 4 * fq;
#pragma unroll
        for (int ai = 0; ai < 2; ++ai)
#pragma unroll
            for (int m = 0; m < 4; ++m) { const size_t off = (size_t)(row0 + ai * 128 + m * 16) * DM + col0;
#pragma unroll
                for (int bj = 0; bj < 2; ++bj)
#pragma unroll
                    for (int n = 0; n < 2; ++n) acc[ai][bj][m][n] = *(const f32x4*)(R + off + bj * 128 + n * 16); }
    }
    __device__ __forceinline__ void operator()(const f32x4 (&acc)[2][2][4][2], const pg8::Unit& u, int wr, int wc, int fr, int fq) const {
        const int row0 = u.pm * 256 + wr * 64 + fr, col0 = u.pn * 256 + wc * 32 + 4 * fq;
#pragma unroll
        for (int ai = 0; ai < 2; ++ai)
#pragma unroll
            for (int m = 0; m < 4; ++m) { const size_t off = (size_t)(row0 + ai * 128 + m * 16) * DM + col0;
#pragma unroll
                for (int bj = 0; bj < 2; ++bj)
#pragma unroll
                    for (int n = 0; n < 2; ++n) *(f32x4*)(C + off + bj * 128 + n * 16) = acc[ai][bj][m][n]; }
    }
};

constexpr int NDEF = 1536;
constexpr int HOST0 = 1024;
constexpr int PREP_TILES = 6016;
constexpr int DHOST_WIN = 6016 - HOST0, DHOST = DHOST_WIN + 2048 - NDEF;
struct TrTile { const float* W; bf16_t* WT; int ld, nt, kt; bool permute; };
__device__ __forceinline__ TrTile tr_tile(const Params& p, int t) {
    TrTile r; int q = t; const int l = 0;
    r.W = p.in[2] + (size_t)l * DM * NIN; r.WT = (bf16_t*)(p.ws + WS_WIN + l * SZ_WIN); r.ld = NIN; r.permute = true;
    r.nt = q >> 5; r.kt = q & 31; return r;
}
__device__ __forceinline__ void tr_load(const TrTile& T, int tid, f32x4 (&v)[4]) {
#pragma unroll
    for (int i = 0; i < 2; ++i) {
        const int idx = tid + 512 * i, kp = idx >> 4, c4 = idx & 15;
        const int nd = T.nt * 64 + c4 * 4;
        int ns = nd;
        if (T.permute) { ns = (nd < 2048) ? nd : ((nd < 11776) ? nd + 16 : ((nd < 11792) ? nd - 11776 + 2048 : -1)); }
        v[2 * i] = (f32x4){0.f, 0.f, 0.f, 0.f}; v[2 * i + 1] = v[2 * i];
        if (ns >= 0) { const float* q = T.W + (size_t)(T.kt * 128 + 2 * kp) * T.ld + ns; v[2 * i] = __builtin_nontemporal_load((const f32x4*)q); v[2 * i + 1] = __builtin_nontemporal_load((const f32x4*)(q + T.ld)); }
    }
}
__device__ __forceinline__ void tr_stage(int tid, const f32x4 (&v)[4], unsigned* lds) {
#pragma unroll
    for (int i = 0; i < 2; ++i) {
        const int idx = tid + 512 * i, kp = idx >> 4, c4 = idx & 15;
        const f32x4 a = v[2 * i], b = v[2 * i + 1];
        unsigned* d = lds + kp * 65 + c4 * 4;
        d[0] = pk2(a[0], b[0]); d[1] = pk2(a[1], b[1]); d[2] = pk2(a[2], b[2]); d[3] = pk2(a[3], b[3]);
    }
}
__device__ __forceinline__ void tr_flush(const TrTile& T, int tid, const unsigned* lds) {
#pragma unroll
    for (int i = 0; i < 2; ++i) {
        const int idx = tid + 512 * i, kc = idx & 15, n = idx >> 4;
        uint4 o; o.x = lds[(kc * 4 + 0) * 65 + n]; o.y = lds[(kc * 4 + 1) * 65 + n]; o.z = lds[(kc * 4 + 2) * 65 + n]; o.w = lds[(kc * 4 + 3) * 65 + n];
        *(uint4*)(T.WT + (size_t)(T.nt * 64 + n) * DM + T.kt * 128 + kc * 8) = o;
    }
}
__device__ __forceinline__ void tr_store(const TrTile& T, int tid, const f32x4 (&v)[4], unsigned* lds) {
#pragma unroll
    for (int i = 0; i < 2; ++i) {
        const int idx = tid + 512 * i, kp = idx >> 4, c4 = idx & 15;
        const f32x4 a = v[2 * i], b = v[2 * i + 1];
        unsigned* d = lds + kp * 65 + c4 * 4;
        d[0] = pk2(a[0], b[0]); d[1] = pk2(a[1], b[1]); d[2] = pk2(a[2], b[2]); d[3] = pk2(a[3], b[3]);
    }
    __syncthreads();
#pragma unroll
    for (int i = 0; i < 2; ++i) {
        const int idx = tid + 512 * i, kc = idx & 15, n = idx >> 4;
        uint4 o; o.x = lds[(kc * 4 + 0) * 65 + n]; o.y = lds[(kc * 4 + 1) * 65 + n]; o.z = lds[(kc * 4 + 2) * 65 + n]; o.w = lds[(kc * 4 + 3) * 65 + n];
        *(uint4*)(T.WT + (size_t)(T.nt * 64 + n) * DM + T.kt * 128 + kc * 8) = o;
    }
    __syncthreads();
}

__device__ __forceinline__ void rmsnorm_rows(const float* __restrict__ X, const float* __restrict__ w, bf16_t* __restrict__ H) {
    const int tid = tid_opaque(), lane = tid & 63, wave = tid >> 6;
    for (int row = blockIdx.x * 8 + wave; row < TOK; row += gridDim.x * 8) {
        const float4* xp = (const float4*)(X + (size_t)row * DM);
        float4 v[16]; float ss = 0.f;
#pragma unroll
        for (int i = 0; i < 16; ++i) { v[i] = xp[lane + 64 * i]; ss += v[i].x * v[i].x + v[i].y * v[i].y + v[i].z * v[i].z + v[i].w * v[i].w; }
        ss = wsum(ss);
        const float rstd = rsqrtf(ss * (1.f / DM) + EPS);
#pragma unroll
        for (int i = 0; i < 16; ++i) { const float4 g = ((const float4*)w)[lane + 64 * i];
            uint2 o; o.x = pk2(v[i].x * rstd * g.x, v[i].y * rstd * g.y); o.y = pk2(v[i].z * rstd * g.z, v[i].w * rstd * g.w);
            *(uint2*)(H + (size_t)row * DM + 4 * (lane + 64 * i)) = o; }
    }
}

__device__ __forceinline__ void phase_prep(const Params& p, unsigned char* lds) {
    const bool rows_first = (blockIdx.x & 1) != 0;
    if (rows_first) rmsnorm_rows(p.in[0], p.in[1], (bf16_t*)(p.ws + WS_H));
    { const int tid = tid_opaque();
      f32x4 va[4], vb[4];
      int t = blockIdx.x;
      TrTile T = tr_tile(p, t < PREP_TILES ? t : 0);
      if (t < PREP_TILES) tr_load(T, tid, va);
#pragma unroll 1
      while (t < PREP_TILES) {
          const int tn = t + gridDim.x;
          const TrTile Tn = tr_tile(p, tn < PREP_TILES ? tn : 0);
          if (tn < PREP_TILES) tr_load(Tn, tid, vb);
          tr_store(T, tid, va, (unsigned*)lds);
#pragma unroll
          for (int i = 0; i < 4; ++i) va[i] = vb[i];
          T = Tn; t = tn;
      } }
    if (!rows_first) rmsnorm_rows(p.in[0], p.in[1], (bf16_t*)(p.ws + WS_H));
}

__device__ __forceinline__ bool host_tile(const Params& p, int l, int hidx, TrTile& T) {
    if (l == 0) { if (hidx >= HOST0) return false;
        T.W = p.in[2] + (size_t)DM * NIN; T.WT = (bf16_t*)(p.ws + WS_WIN + SZ_WIN); T.ld = NIN; T.permute = true; T.nt = hidx >> 5; T.kt = hidx & 31; return true; }
    const int r = NDEF + hidx; if (r >= 2048) return false;
    T.W = p.in[3] + (size_t)DM * DM; T.WT = (bf16_t*)(p.ws + WS_WOUT + SZ_WOUT); T.ld = DM; T.permute = false; T.nt = r >> 5; T.kt = r & 31; return true;
}
__device__ __forceinline__ bool diff_host_tile(const Params& p, int l, int s, TrTile& T) {
    if (l != 0 || s >= DHOST) return false;
    if (s < DHOST_WIN) { const int q = HOST0 + s; T.W = p.in[2] + (size_t)DM * NIN; T.WT = (bf16_t*)(p.ws + WS_WIN + SZ_WIN); T.ld = NIN; T.permute = true; T.nt = q >> 5; T.kt = q & 31; return true; }
    const int r = NDEF + (s - DHOST_WIN); T.W = p.in[3]; T.WT = (bf16_t*)(p.ws + WS_WOUT); T.ld = DM; T.permute = false; T.nt = r >> 5; T.kt = r & 31; return true;
}
__device__ __forceinline__ TrTile tr_tile_wout(const Params& p, int l, int r) {
    TrTile T; T.W = p.in[3] + (size_t)l * DM * DM; T.WT = (bf16_t*)(p.ws + WS_WOUT + l * SZ_WOUT); T.ld = DM; T.permute = false; T.nt = r >> 5; T.kt = r & 31; return T;
}
__device__ __forceinline__ void convert_deferred(const Params& p, int l, int rank, int nidle, unsigned char* lds) {
    const int tid = tid_opaque();
    f32x4 va[4], vb[4];
    int r = rank;
    TrTile T = tr_tile_wout(p, l, r < NDEF ? r : 0);
    if (r < NDEF) tr_load(T, tid, va);
#pragma unroll 1
    while (r < NDEF) {
        const int rn = r + nidle;
        const TrTile Tn = tr_tile_wout(p, l, rn < NDEF ? rn : 0);
        if (rn < NDEF) tr_load(Tn, tid, vb);
        tr_store(T, tid, va, (unsigned*)lds);
#pragma unroll
        for (int i = 0; i < 4; ++i) va[i] = vb[i];
        T = Tn; r = rn;
    }
}

struct LayerW {
    const float *gla_w_up, *gla_b_up, *gla_nw, *swa_qn, *swa_kn, *swa_sinks, *dq_n, *dk_n, *lq1, *lk1, *lq2, *lk2, *d_on, *conv_w, *conv_b, *w_r, *b_r, *w_i, *b_i, *lam;
    float lambda_init;
};
__device__ __forceinline__ LayerW layer_w(const Params& p, int l) {
    LayerW w;
    w.gla_w_up = p.in[4] + l * 16 * 512; w.gla_b_up = p.in[5] + l * 512; w.gla_nw = p.in[6] + l * 128;
    w.swa_qn = p.in[7] + l * 128; w.swa_kn = p.in[8] + l * 128; w.swa_sinks = p.in[9] + l * 8;
    w.dq_n = p.in[10] + l * 64; w.dk_n = p.in[11] + l * 64; w.lq1 = p.in[12] + l * 64; w.lk1 = p.in[13] + l * 64; w.lq2 = p.in[14] + l * 64; w.lk2 = p.in[15] + l * 64;
    w.d_on = p.in[16] + l * 128; w.conv_w = p.in[17] + l * 4096; w.conv_b = p.in[18] + l * 1024;
    w.w_r = p.in[19] + l * 8 * 128 * 128; w.b_r = p.in[20] + l * 1024; w.w_i = p.in[21] + l * 8 * 128 * 128; w.b_i = p.in[22] + l * 1024; w.lam = p.in[23] + l * 1024;
    w.lambda_init = 0.8f - 0.6f * expf(-0.3f * (float)l);
    return w;
}

__device__ void gla_simple(const bf16_t* __restrict__ P, bf16_t* __restrict__ Y, const LayerW& W, int bh, float* lds) {
    const int b = bh >> 3, h = bh & 7, tid = tid_opaque();
    float* sAl = lds; float* sQ = sAl + 2048; float* sK = sQ + 2048; float* sV = sK + 2048; float* sPo = sV + 4096; float* sW = sPo + 16384;
    __syncthreads();
    for (int i = tid; i < 1024; i += 512) sW[i] = W.gla_w_up[(i >> 6) * 512 + h * 64 + (i & 63)];
    if (tid < 64) sW[1024 + tid] = W.gla_b_up[h * 64 + tid];
    const int v = tid & 127, dg = tid >> 7;
    float s[16];
#pragma unroll
    for (int i = 0; i < 16; ++i) s[i] = 0.f;
    for (int c = 0; c < 64; ++c) {
        __syncthreads();
        const int tok0 = b * SEQ + c * 32;
        for (int i = tid; i < 2048; i += 512) { const int tt = i >> 6, d = i & 63; const bf16_t* row = P + (size_t)(tok0 + tt) * NPAD;
            float lg = sW[1024 + d];
#pragma unroll
            for (int r = 0; r < 16; ++r) lg += bf2f(row[C_GA + r]) * sW[r * 64 + d];
            const float ls = fminf(lg, 0.f) - log1pf(expf(-fabsf(lg)));
            sAl[i] = expf(ls * (1.f / 16.f));
            sQ[i] = bf2f(row[C_GQ + h * 64 + d]) * 0.125f;
            sK[i] = bf2f(row[C_GK + h * 64 + d]); }
        for (int i = tid; i < 4096; i += 512) { const int tt = i >> 7, vv = i & 127; sV[i] = bf2f(P[(size_t)(tok0 + tt) * NPAD + C_GV + h * 128 + vv]); }
        __syncthreads();
        for (int tt = 0; tt < 32; ++tt) {
            const float vt = sV[tt * 128 + v]; float po = 0.f;
#pragma unroll
            for (int i = 0; i < 16; ++i) { const int d = dg * 16 + i; s[i] = sAl[tt * 64 + d] * s[i] + sK[tt * 64 + d] * vt; po += sQ[tt * 64 + d] * s[i]; }
            sPo[(dg * 32 + tt) * 128 + v] = po;
        }
        __syncthreads();
        { const int tt = tid >> 4, v0 = (tid & 15) * 8; float o[8]; float ss = 0.f;
#pragma unroll
            for (int j = 0; j < 8; ++j) { o[j] = sPo[(0 * 32 + tt) * 128 + v0 + j] + sPo[(1 * 32 + tt) * 128 + v0 + j] + sPo[(2 * 32 + tt) * 128 + v0 + j] + sPo[(3 * 32 + tt) * 128 + v0 + j]; ss += o[j] * o[j]; }
            ss += __shfl_xor(ss, 1); ss += __shfl_xor(ss, 2); ss += __shfl_xor(ss, 4); ss += __shfl_xor(ss, 8);
            const float rstd = rsqrtf(ss * (1.f / 128.f) + EPS);
            const bf16_t* gp = P + (size_t)(tok0 + tt) * NPAD + C_GATE + h * 128 + v0;
            bf16_t* yp = Y + (size_t)(tok0 + tt) * DM + h * 128 + v0;
#pragma unroll
            for (int j = 0; j < 8; ++j) yp[j] = f2bf(o[j] * rstd * W.gla_nw[v0 + j] * bf2f(gp[j])); }
    }
    __syncthreads();
}

__device__ void swa_simple_row(const bf16_t* __restrict__ P, bf16_t* __restrict__ Y, const LayerW& W, int row, float* wl) {
    const int lane = tid_opaque() & 63;
    const int bh = row & 31, b = bh >> 3, hq = bh & 7, q = row >> 5, kvh = hq >> 2;
    const size_t tok = (size_t)b * SEQ + q;
    const bf16_t* qp = P + tok * NPAD + C_SQ + hq * 128;
    const float q0 = bf2f(qp[2 * lane]), q1 = bf2f(qp[2 * lane + 1]);
    const float rq = rsqrtf(wsum(q0 * q0 + q1 * q1) * (1.f / 128.f) + EPS) * 0.08838834764831845f;
    __threadfence_block();
    wl[2 * lane] = q0 * rq * W.swa_qn[2 * lane] * W.swa_kn[2 * lane];
    wl[2 * lane + 1] = q1 * rq * W.swa_qn[2 * lane + 1] * W.swa_kn[2 * lane + 1];
    __threadfence_block();
    const float slope = exp2f(-(float)(hq + 1)), sink = W.swa_sinks[hq];
    float sc[2];
#pragma unroll
    for (int i = 0; i < 2; ++i) {
        const int j = q - 127 + lane + 64 * i;
        sc[i] = -INFINITY;
        if (j >= 0) { const uint4* kp = (const uint4*)(P + ((size_t)b * SEQ + j) * NPAD + C_SK + kvh * 128);
            float dot = 0.f, ssk = 0.f;
            for (int c = 0; c < 16; ++c) { float f[8]; unpack8(kp[c], f);
#pragma unroll
                for (int e = 0; e < 8; ++e) { dot += wl[c * 8 + e] * f[e]; ssk += f[e] * f[e]; } }
            sc[i] = dot * rsqrtf(ssk * (1.f / 128.f) + EPS) - slope * (float)(q - j); }
    }
    const float m = fmaxf(wmax(fmaxf(sc[0], sc[1])), sink);
    const float p0 = (sc[0] == -INFINITY) ? 0.f : __expf(sc[0] - m), p1 = (sc[1] == -INFINITY) ? 0.f : __expf(sc[1] - m);
    const float inv = 1.f / (wsum(p0 + p1) + __expf(sink - m));
    wl[128 + lane] = p0 * inv; wl[192 + lane] = p1 * inv;
    __threadfence_block();
    float o0 = 0.f, o1 = 0.f;
    for (int jj = 0; jj < 128; ++jj) { const int j = q - 127 + jj; if (j < 0) continue;
        const unsigned vv = *(const unsigned*)(P + ((size_t)b * SEQ + j) * NPAD + C_SV + kvh * 128 + 2 * lane);
        const float pj = wl[128 + jj]; o0 += pj * __uint_as_float(vv << 16); o1 += pj * __uint_as_float(vv & 0xffff0000u); }
    const unsigned gg = *(const unsigned*)(P + tok * NPAD + C_GATE + 1024 + hq * 128 + 2 * lane);
    *(unsigned*)(Y + tok * DM + 1024 + hq * 128 + 2 * lane) = pk2(o0 * __uint_as_float(gg << 16), o1 * __uint_as_float(gg & 0xffff0000u));
    __threadfence_block();
}

__device__ void diff_simple_row(const bf16_t* __restrict__ P, bf16_t* __restrict__ Y, const LayerW& W, float lam, int row, float* wl) {
    const int lane = tid_opaque() & 63;
    const int bh = row & 31, b = bh >> 3, h = bh & 7, q = row >> 5;
    const size_t tok = (size_t)b * SEQ + q;
    const bf16_t* qp = P + tok * NPAD + C_DQ + h * 128;
    const float x0 = bf2f(qp[lane]), x1 = bf2f(qp[64 + lane]);
    const float r0 = rsqrtf(wsum(x0 * x0) * (1.f / 64.f) + EPS) * 0.125f, r1 = rsqrtf(wsum(x1 * x1) * (1.f / 64.f) + EPS) * 0.125f;
    __threadfence_block();
    wl[lane] = x0 * r0 * W.dq_n[lane] * W.dk_n[lane]; wl[64 + lane] = x1 * r1 * W.dq_n[lane] * W.dk_n[lane];
    __threadfence_block();
    float* S0 = wl + 128; float* S1 = S0 + 2048;
    const float slope = exp2f(-(float)(h + 1));
    const int nk = q + 1;
    float m0 = -INFINITY, m1 = -INFINITY;
    for (int j = lane; j < nk; j += 64) {
        const uint4* kp = (const uint4*)(P + ((size_t)b * SEQ + j) * NPAD + C_DK + h * 128);
        float d0 = 0.f, k0 = 0.f, d1 = 0.f, k1 = 0.f;
        for (int c = 0; c < 8; ++c) { float f[8]; unpack8(kp[c], f);
#pragma unroll
            for (int e = 0; e < 8; ++e) { d0 += wl[c * 8 + e] * f[e]; k0 += f[e] * f[e]; } }
        for (int c = 0; c < 8; ++c) { float f[8]; unpack8(kp[8 + c], f);
#pragma unroll
            for (int e = 0; e < 8; ++e) { d1 += wl[64 + c * 8 + e] * f[e]; k1 += f[e] * f[e]; } }
        const float al = slope * (float)(q - j);
        const float s0 = d0 * rsqrtf(k0 * (1.f / 64.f) + EPS) - al, s1 = d1 * rsqrtf(k1 * (1.f / 64.f) + EPS) - al;
        S0[j] = s0; S1[j] = s1; m0 = fmaxf(m0, s0); m1 = fmaxf(m1, s1);
    }
    m0 = wmax(m0); m1 = wmax(m1);
    float l0 = 0.f, l1 = 0.f;
    for (int j = lane; j < nk; j += 64) { l0 += __expf(S0[j] - m0); l1 += __expf(S1[j] - m1); }
    l0 = 1.f / wsum(l0); l1 = lam / wsum(l1);
    for (int j = lane; j < nk; j += 64) S0[j] = __expf(S0[j] - m0) * l0 - __expf(S1[j] - m1) * l1;
    __threadfence_block();
    float o0 = 0.f, o1 = 0.f;
    const bf16_t* vp = P + (size_t)b * SEQ * NPAD + C_DV + h * 128 + 2 * lane;
    for (int j = 0; j < nk; ++j) { const unsigned vv = *(const unsigned*)(vp + (size_t)j * NPAD); const float wj = S0[j];
        o0 += wj * __uint_as_float(vv << 16); o1 += wj * __uint_as_float(vv & 0xffff0000u); }
    const float rstd = rsqrtf(wsum(o0 * o0 + o1 * o1) * (1.f / 128.f) + EPS) * (1.f - W.lambda_init);
    const unsigned gg = *(const unsigned*)(P + tok * NPAD + C_GATE + 2048 + h * 128 + 2 * lane);
    *(unsigned*)(Y + tok * DM + 2048 + h * 128 + 2 * lane) = pk2(o0 * rstd * W.d_on[2 * lane] * __uint_as_float(gg << 16), o1 * rstd * W.d_on[2 * lane + 1] * __uint_as_float(gg & 0xffff0000u));
    __threadfence_block();
}

__device__ void lru_gates_simple(const bf16_t* __restrict__ P, float* __restrict__ LA, float* __restrict__ LU, const LayerW& W, int unit, float* sXc) {
    const int tid = tid_opaque(), tg = unit >> 3, n = unit & 7, tok0 = tg * 16, t0 = tok0 & (SEQ - 1);
    __syncthreads();
#pragma unroll
    for (int e = 0; e < 4; ++e) { const int i = tid + 512 * e, tt = i >> 7, c = i & 127, ch = n * 128 + c;
        float xc = W.conv_b[ch];
#pragma unroll
        for (int w = 0; w < 4; ++w) { const int tp = t0 + tt - 3 + w; if (tp >= 0) xc += W.conv_w[w * 1024 + ch] * bf2f(P[(size_t)(tok0 + tt - 3 + w) * NPAD + C_RX + ch]); }
        sXc[i] = xc; }
    __syncthreads();
    const int tt = tid >> 5, jg = tid & 31, ch0 = n * 128 + jg * 4;
    float4 r = *(const float4*)(W.b_r + ch0), g = *(const float4*)(W.b_i + ch0);
    const float* wr = W.w_r + (size_t)n * 16384 + jg * 4; const float* wi = W.w_i + (size_t)n * 16384 + jg * 4;
    for (int i = 0; i < 128; ++i) { const float x = sXc[tt * 128 + i]; const float4 a = *(const float4*)(wr + i * 128), c = *(const float4*)(wi + i * 128);
        r.x += x * a.x; r.y += x * a.y; r.z += x * a.z; r.w += x * a.w; g.x += x * c.x; g.y += x * c.y; g.z += x * c.z; g.w += x * c.w; }
    float rr[4] = {r.x, r.y, r.z, r.w}, gg[4] = {g.x, g.y, g.z, g.w}, av[4], uv[4];
#pragma unroll
    for (int e = 0; e < 4; ++e) { const float x = -W.lam[ch0 + e]; const float sp = (x > 20.f) ? x : log1pf(expf(x));
        const float la = -8.f * sigmf(rr[e]) * sp; av[e] = expf(la); uv[e] = sqrtf(-expm1f(2.f * la)) * sigmf(gg[e]) * sXc[tt * 128 + jg * 4 + e]; }
    *(float4*)(LA + (size_t)(tok0 + tt) * 1024 + ch0) = make_float4(av[0], av[1], av[2], av[3]);
    *(float4*)(LU + (size_t)(tok0 + tt) * 1024 + ch0) = make_float4(uv[0], uv[1], uv[2], uv[3]);
}

__device__ void lru_scan_simple(const bf16_t* __restrict__ P, bf16_t* __restrict__ Y, const float* __restrict__ LA, const float* __restrict__ LU) {
    const int tid = tid_opaque();
    if (blockIdx.x >= 64 || tid >= 64) return;
    const int gid = blockIdx.x * 64 + tid, b = gid >> 10, ch = gid & 1023;
    float h = 0.f;
    for (int t = 0; t < SEQ; t += 8) {
        float a[8], u[8], g[8];
#pragma unroll
        for (int e = 0; e < 8; ++e) { const size_t tok = (size_t)b * SEQ + t + e; a[e] = LA[tok * 1024 + ch]; u[e] = LU[tok * 1024 + ch]; g[e] = bf2f(P[tok * NPAD + C_GATE + 3072 + ch]); }
#pragma unroll
        for (int e = 0; e < 8; ++e) { h = a[e] * h + u[e]; Y[((size_t)b * SEQ + t + e) * DM + 3072 + ch] = f2bf(h * g[e]); }
    }
}

__device__ __forceinline__ float diff_lambda(const LayerW& W) {
    float a = 0.f, b = 0.f;
    for (int i = 0; i < 64; ++i) { a += W.lq1[i] * W.lk1[i]; b += W.lq2[i] * W.lk2[i]; }
    return expf(a) - expf(b) + W.lambda_init;
}


typedef short bf16x8 __attribute__((ext_vector_type(8)));
typedef short s16x4 __attribute__((ext_vector_type(4)));
typedef float f32x16 __attribute__((ext_vector_type(16)));
#define MFMA32(a, b, c) __builtin_amdgcn_mfma_f32_32x32x16_bf16((a), (b), (c), 0, 0, 0)
constexpr float LOG2E = 1.4426950408889634f;
__device__ __forceinline__ int crow(int r, int h) { return (r & 3) + 8 * (r >> 2) + 4 * h; }
__device__ __forceinline__ bf16x8 pack8(const float* f) { u32x4 u; u.x = cvt2(f[0], f[1]); u.y = cvt2(f[2], f[3]); u.z = cvt2(f[4], f[5]); u.w = cvt2(f[6], f[7]); return __builtin_bit_cast(bf16x8, u); }

template <bool SWA> struct AttnCfg {
    static constexpr int DQK = SWA ? 128 : 64, NKS = DQK / 16;
    static constexpr int KP = DQK + 8;
    static constexpr int KMAPS = SWA ? 1 : 2;
    static constexpr int KBYTES = KMAPS * 64 * KP * 2;
    static constexpr int VP = 72;
    static constexpr int VBYTES = 128 * VP * 2;
    static constexpr int ABUF = KBYTES + VBYTES;
};

template <bool SWA>
__device__ __forceinline__ void attn_item(const bf16_t* __restrict__ P, bf16_t* __restrict__ Y, const LayerW& W, float lam, int item, unsigned char* lds) {
    typedef AttnCfg<SWA> C;
    const int tid = tid_opaque(), lane = tid & 63, wave = tid >> 6, c = wave & 1, g = wave >> 1, l31 = lane & 31, hh = lane >> 5;
    int b, qb, hk  , hq  ;
    if (SWA) { qb = 15 - (item >> 4); const int r = item & 15; b = r >> 2; const int kvh = (r >> 1) & 1, gp = r & 1; hk = kvh; hq = kvh * 4 + gp * 2 + c; }
    else { qb = 15 - (item >> 5); const int r = item & 31; b = r >> 3; hk = r & 7; hq = hk; }
    const size_t tokb = (size_t)b * SEQ;
    const int q0 = qb * 128 + g * 32;
    const int qcol = SWA ? (C_SQ + hq * 128) : (C_DQ + hq * 128 + c * 64);
    const int kcol = SWA ? (C_SK + hk * 128) : (C_DK + hk * 128);
    const int vcol = SWA ? (C_SV + hk * 128) : (C_DV + hk * 128);
    const float* qnw = SWA ? W.swa_qn : W.dq_n; const float* knw = SWA ? W.swa_kn : W.dk_n;
    const float slope2 = exp2f(-(float)(hq + 1)) * LOG2E;
    bf16x8 qf[C::NKS];
    {
        const bf16_t* qp = P + (tokb + q0 + l31) * NPAD + qcol;
        float f[C::NKS][8]; float ss = 0.f;
#pragma unroll
        for (int ks = 0; ks < C::NKS; ++ks) { unpack8(*(const uint4*)(qp + 16 * ks + 8 * hh), f[ks]);
#pragma unroll
            for (int e = 0; e < 8; ++e) ss += f[ks][e] * f[ks][e]; }
        ss += __shfl_xor(ss, 32);
        const float sc = rsqrtf(ss * (1.f / C::DQK) + EPS) * (SWA ? 0.08838834764831845f : 0.125f) * LOG2E;
#pragma unroll
        for (int ks = 0; ks < C::NKS; ++ks) {
#pragma unroll
            for (int e = 0; e < 8; ++e) f[ks][e] *= sc * qnw[16 * ks + 8 * hh + e];
            qf[ks] = pack8(f[ks]); }
    }
    int t_lo = 0, t_hi = 2 * qb + 2;
    if (SWA) t_lo = (qb == 0) ? 0 : 2 * qb - 2;
    const int kkey = SWA ? (tid >> 3) : (tid >> 3), kch = tid & 7;
    const int vkey = tid & 63, vch = tid >> 6;
    uint4 rk0, rk1, rv0, rv1;
#define ATT_LOAD(t) do { const bf16_t* kp_ = P + (tokb + (t) * 64 + kkey) * NPAD + kcol + kch * 16; rk0 = ((const uint4*)kp_)[0]; rk1 = ((const uint4*)kp_)[1]; \
        const bf16_t* vp_ = P + (tokb + (t) * 64 + vkey) * NPAD + vcol + vch * 16; rv0 = ((const uint4*)vp_)[0]; rv1 = ((const uint4*)vp_)[1]; } while (0)
#define ATT_STORE(bufp) do { float f_[16]; unpack8(rk0, f_); unpack8(rk1, f_ + 8); float ss_ = 0.f; \
        _Pragma("unroll") for (int e = 0; e < 16; ++e) ss_ += f_[e] * f_[e]; \
        ss_ += __shfl_xor(ss_, 1); ss_ += __shfl_xor(ss_, 2); if (SWA) ss_ += __shfl_xor(ss_, 4); \
        const float rs_ = rsqrtf(ss_ * (1.f / C::DQK) + EPS); const int d0_ = SWA ? kch * 16 : (kch & 3) * 16; \
        _Pragma("unroll") for (int e = 0; e < 16; ++e) f_[e] *= rs_ * knw[d0_ + e]; \
        bf16_t* kd_ = (bf16_t*)(bufp) + ((SWA ? 0 : (kch >> 2) * 64) + kkey) * C::KP + d0_; \
        *(bf16x8*)kd_ = pack8(f_); *(bf16x8*)(kd_ + 8) = pack8(f_ + 8); \
        bf16_t* vd_ = (bf16_t*)((bufp) + C::KBYTES) + (vch * 16) * C::VP + vkey; \
        const unsigned vw_[8] = {rv0.x, rv0.y, rv0.z, rv0.w, rv1.x, rv1.y, rv1.z, rv1.w}; \
        _Pragma("unroll") for (int e = 0; e < 8; ++e) { vd_[(2 * e) * C::VP] = (bf16_t)(vw_[e] & 0xffffu); vd_[(2 * e + 1) * C::VP] = (bf16_t)(vw_[e] >> 16); } } while (0)

    f32x16 O[4];
#pragma unroll
    for (int vt = 0; vt < 4; ++vt)
#pragma unroll
        for (int r = 0; r < 16; ++r) O[vt][r] = 0.f;
    float m = SWA ? W.swa_sinks[hq] * LOG2E + slope2 * (float)(q0 + l31) : -INFINITY, l = SWA ? 0.5f : 0.f;
    __syncthreads();
    ATT_LOAD(t_lo);
    ATT_STORE(lds);
    __syncthreads();
    for (int t = t_lo; t < t_hi; ++t) {
        unsigned char* buf = lds + ((t - t_lo) & 1) * C::ABUF;
        unsigned char* nbuf = lds + (((t - t_lo) & 1) ^ 1) * C::ABUF;
        const bool more = (t + 1 < t_hi);
        if (more) ATT_LOAD(t + 1);
        const int k0 = t * 64;
        bool act = (k0 <= q0 + 31);
        if (SWA) act = act && (k0 + 63 >= q0 - 127);
        if (act) {
            const bf16_t* Kb = (const bf16_t*)buf + (SWA ? 0 : c * 64 * C::KP);
            f32x16 s0, s1;
            { const float kb0 = slope2 * (float)(k0 + 4 * hh), kb1 = kb0 + 32.f * slope2;
#pragma unroll
              for (int r = 0; r < 16; ++r) { const float cr = (float)((r & 3) + 8 * (r >> 2)); s0[r] = fmaf(slope2, cr, kb0); s1[r] = fmaf(slope2, cr, kb1); } }
#pragma unroll
            for (int ks = 0; ks < C::NKS; ++ks) {
                const bf16x8 a0 = *(const bf16x8*)(Kb + l31 * C::KP + 16 * ks + 8 * hh);
                const bf16x8 a1 = *(const bf16x8*)(Kb + (32 + l31) * C::KP + 16 * ks + 8 * hh);
                s0 = MFMA32(a0, qf[ks], s0); s1 = MFMA32(a1, qf[ks], s1); }
            const int dq = q0 + l31 - k0;
            const bool edge = SWA ? (k0 + 63 > q0 || k0 < q0 + 31 - 127) : (k0 + 63 > q0);
            float mx = -INFINITY;
            if (edge) {
#pragma unroll
                for (int r = 0; r < 16; ++r) { const int d0 = dq - crow(r, hh), d1 = d0 - 32;
                    if (d0 < 0 || (SWA && d0 > 127)) s0[r] = -INFINITY;
                    if (d1 < 0 || (SWA && d1 > 127)) s1[r] = -INFINITY; } }
#pragma unroll
            for (int r = 0; r < 16; ++r) { mx = __builtin_amdgcn_fmed3f(mx, s0[r], INFINITY); mx = __builtin_amdgcn_fmed3f(mx, s1[r], INFINITY); }
            mx = __builtin_amdgcn_fmed3f(mx, __shfl_xor(mx, 32), INFINITY);
            const float mn = __builtin_amdgcn_fmed3f(m, mx, INFINITY), alpha = __builtin_amdgcn_exp2f(m - mn);
            m = mn;
            s0 = s0 - mn; s1 = s1 - mn;
            f32v2_t ls2 = {0.f, 0.f};
#pragma unroll
            for (int r = 0; r < 16; r += 2) { s0[r] = __builtin_amdgcn_exp2f(s0[r]); s0[r + 1] = __builtin_amdgcn_exp2f(s0[r + 1]); s1[r] = __builtin_amdgcn_exp2f(s1[r]); s1[r + 1] = __builtin_amdgcn_exp2f(s1[r + 1]);
                ls2 += (f32v2_t){s0[r], s0[r + 1]}; ls2 += (f32v2_t){s1[r], s1[r + 1]}; }
            l = l * alpha + (ls2[0] + ls2[1]);
#pragma unroll
            for (int vt = 0; vt < 4; ++vt)
#pragma unroll
                for (int r = 0; r < 16; ++r) O[vt][r] *= alpha;
            const bf16_t* Vb = (const bf16_t*)(buf + C::KBYTES);
#pragma unroll
            for (int kt2 = 0; kt2 < 2; ++kt2)
#pragma unroll
                for (int s2 = 0; s2 < 2; ++s2) {
                    float pf[8];
#pragma unroll
                    for (int e = 0; e < 8; ++e) pf[e] = kt2 ? s1[8 * s2 + e] : s0[8 * s2 + e];
                    const bf16x8 pb = pack8(pf);
#pragma unroll
                    for (int vt = 0; vt < 4; ++vt) {
                        const bf16_t* vp = Vb + (32 * vt + l31) * C::VP + 32 * kt2 + 16 * s2 + 4 * hh;
                        const s16x4 lo = *(const s16x4*)vp, hi = *(const s16x4*)(vp + 8);
                        const bf16x8 a = __builtin_shufflevector(lo, hi, 0, 1, 2, 3, 4, 5, 6, 7);
                        O[vt] = MFMA32(a, pb, O[vt]); }
                }
        }
        if (more) ATT_STORE(nbuf);
        __syncthreads();
    }
#undef ATT_LOAD
#undef ATT_STORE
    l += __shfl_xor(l, 32);
    float* OB = (float*)lds;
    const int orow = (g * 32 + l31) * 129;
    if (SWA) {
        const float sc = 1.f / l;
#pragma unroll 1
        for (int pass = 0; pass < 2; ++pass) {
            if (c == pass) {
#pragma unroll
                for (int vt = 0; vt < 4; ++vt)
#pragma unroll
                    for (int r = 0; r < 16; ++r) OB[orow + 32 * vt + crow(r, hh)] = O[vt][r] * sc; }
            __syncthreads();
            { const int q = tid >> 2, part = tid & 3; const size_t tq = tokb + qb * 128 + q; const int hq2 = hq - c + pass;
              const bf16_t* gp = P + tq * NPAD + C_GATE + 1024 + hq2 * 128 + part * 32; bf16_t* yp = Y + tq * DM + 1024 + hq2 * 128 + part * 32;
#pragma unroll
              for (int ch = 0; ch < 4; ++ch) { float gf[8]; unpack8(*(const uint4*)(gp + ch * 8), gf); float of[8];
#pragma unroll
                  for (int e = 0; e < 8; ++e) of[e] = OB[q * 129 + part * 32 + ch * 8 + e] * gf[e];
                  *(bf16x8*)(yp + ch * 8) = pack8(of); } }
            __syncthreads();
        }
    } else {
        const float sc = (c == 0) ? 1.f / l : lam / l;
        if (c == 1) {
#pragma unroll
            for (int vt = 0; vt < 4; ++vt)
#pragma unroll
                for (int r = 0; r < 16; ++r) OB[orow + 32 * vt + crow(r, hh)] = O[vt][r] * sc; }
        __syncthreads();
        if (c == 0) {
            float ss = 0.f;
#pragma unroll
            for (int vt = 0; vt < 4; ++vt)
#pragma unroll
                for (int r = 0; r < 16; ++r) { const float o = O[vt][r] * sc - OB[orow + 32 * vt + crow(r, hh)]; O[vt][r] = o; ss += o * o; }
            ss += __shfl_xor(ss, 32);
            const float rstd = rsqrtf(ss * (1.f / 128.f) + EPS) * (1.f - W.lambda_init);
#pragma unroll
            for (int vt = 0; vt < 4; ++vt)
#pragma unroll
                for (int r = 0; r < 16; ++r) OB[orow + 32 * vt + crow(r, hh)] = O[vt][r] * rstd; }
        __syncthreads();
        { const int q = tid >> 2, part = tid & 3; const size_t tq = tokb + qb * 128 + q;
          const bf16_t* gp = P + tq * NPAD + C_GATE + 2048 + hq * 128 + part * 32; bf16_t* yp = Y + tq * DM + 2048 + hq * 128 + part * 32;
#pragma unroll
          for (int ch = 0; ch < 4; ++ch) { float gf[8]; unpack8(*(const uint4*)(gp + ch * 8), gf); float of[8];
#pragma unroll
              for (int e = 0; e < 8; ++e) of[e] = OB[q * 129 + part * 32 + ch * 8 + e] * gf[e] * W.d_on[part * 32 + ch * 8 + e];
              *(bf16x8*)(yp + ch * 8) = pack8(of); } }
        __syncthreads();
    }
}


__device__ __forceinline__ void diff_item3(const Params& p, int lay, const bf16_t* __restrict__ P, bf16_t* __restrict__ Y, const LayerW& W, float lam, int item, unsigned char* lds) {
    constexpr int KP = 72, VP = 72, KBYTES = 2 * 64 * KP * 2, ABUF = KBYTES + 128 * VP * 2;
    const int tid = tid_opaque(), lane = tid & 63, wave = tid >> 6, c = wave & 1, g = wave >> 1, l31 = lane & 31, hh = lane >> 5;
    const int qb = 15 - (item >> 5), r_ = item & 31, b = r_ >> 3, h = r_ & 7;
    const size_t tokb = (size_t)b * SEQ;
    const int q0 = qb * 128 + g * 32;
    const int kcol = C_DK + h * 128, vcol = C_DV + h * 128;
    const float slope2 = exp2f(-(float)(h + 1)) * LOG2E;
    const int kkey = tid >> 3, kch = tid & 7, vkey = tid & 63, vch = tid >> 6;
    uint4 rk0, rk1, rv0, rv1;
#define D3_KLOAD(t) do { const bf16_t* kp_ = P + (tokb + (t) * 64 + kkey) * NPAD + kcol + kch * 16; rk0 = ((const uint4*)kp_)[0]; rk1 = ((const uint4*)kp_)[1]; } while (0)
#define D3_VLOAD(t) do { const bf16_t* vp_ = P + (tokb + (t) * 64 + vkey) * NPAD + vcol + vch * 16; rv0 = ((const uint4*)vp_)[0]; rv1 = ((const uint4*)vp_)[1]; } while (0)
#define D3_KSTORE(t) do { float f_[16]; unpack8(rk0, f_); unpack8(rk1, f_ + 8); float ss_ = 0.f; \
        _Pragma("unroll") for (int e = 0; e < 16; ++e) ss_ += f_[e] * f_[e]; \
        ss_ += __shfl_xor(ss_, 1); ss_ += __shfl_xor(ss_, 2); \
        const float rs_ = rsqrtf(ss_ * (1.f / 64.f) + EPS); const int d0_ = (kch & 3) * 16; \
        _Pragma("unroll") for (int e = 0; e < 16; ++e) f_[e] *= rs_ * W.dk_n[d0_ + e]; \
        bf16_t* kd_ = (bf16_t*)(lds + ((t) & 1) * ABUF) + ((kch >> 2) * 64 + kkey) * KP + d0_; \
        *(bf16x8*)kd_ = pack8(f_); *(bf16x8*)(kd_ + 8) = pack8(f_ + 8); } while (0)
#define D3_VSTORE(t) do { bf16_t* vd_ = (bf16_t*)(lds + ((t) & 1) * ABUF + KBYTES) + (vch * 16) * VP + vkey; \
        const unsigned vw_[8] = {rv0.x, rv0.y, rv0.z, rv0.w, rv1.x, rv1.y, rv1.z, rv1.w}; \
        _Pragma("unroll") for (int e = 0; e < 8; ++e) { vd_[(2 * e) * VP] = (bf16_t)(vw_[e] & 0xffffu); vd_[(2 * e + 1) * VP] = (bf16_t)(vw_[e] >> 16); } } while (0)
#define D3_QK(t) do { const int k0_ = (t) * 64; const bf16_t* Kb_ = (const bf16_t*)(lds + ((t) & 1) * ABUF) + c * 64 * KP; \
        { const float kb0 = slope2 * (float)(k0_ + 4 * hh), kb1 = kb0 + 32.f * slope2; \
          _Pragma("unroll") for (int r = 0; r < 16; ++r) { const float cr = (float)((r & 3) + 8 * (r >> 2)); s0[r] = fmaf(slope2, cr, kb0); s1[r] = fmaf(slope2, cr, kb1); } } \
        _Pragma("unroll") for (int ks = 0; ks < 4; ++ks) { \
            const bf16x8 a0 = *(const bf16x8*)(Kb_ + l31 * KP + 16 * ks + 8 * hh), a1 = *(const bf16x8*)(Kb_ + (32 + l31) * KP + 16 * ks + 8 * hh); \
            s0 = MFMA32(a0, qf[ks], s0); s1 = MFMA32(a1, qf[ks], s1); } \
        if ((t) == tw) { const int dq = q0 + l31 - k0_; \
            _Pragma("unroll") for (int r = 0; r < 16; ++r) { const int d0 = dq - crow(r, hh), d1 = d0 - 32; if (d0 < 0) s0[r] = -INFINITY; if (d1 < 0) s1[r] = -INFINITY; } } } while (0)
#define D3_PV(tv) do { const bf16_t* Vb_ = (const bf16_t*)(lds + ((tv) & 1) * ABUF + KBYTES); \
        _Pragma("unroll") for (int i4 = 0; i4 < 4; ++i4) \
            _Pragma("unroll") for (int vt = 0; vt < 4; ++vt) { \
                const bf16_t* vp = Vb_ + (32 * vt + l31) * VP + 16 * i4 + 4 * hh; \
                const s16x4 lo = *(const s16x4*)vp, hi = *(const s16x4*)(vp + 8); \
                O[vt] = MFMA32(__builtin_shufflevector(lo, hi, 0, 1, 2, 3, 4, 5, 6, 7), pp[i4], O[vt]); } } while (0)
#define D3_SOFTMAX() do { float mx = -INFINITY; \
        _Pragma("unroll") for (int r = 0; r < 16; ++r) { mx = __builtin_amdgcn_fmed3f(mx, s0[r], INFINITY); mx = __builtin_amdgcn_fmed3f(mx, s1[r], INFINITY); } \
        mx = __builtin_amdgcn_fmed3f(mx, __shfl_xor(mx, 32), INFINITY); \
        const float mn = __builtin_amdgcn_fmed3f(m, mx, INFINITY); alpha = __builtin_amdgcn_exp2f(m - mn); m = mn; \
        float ls = 0.f; \
        _Pragma("unroll") for (int r = 0; r < 16; ++r) { s0[r] = __builtin_amdgcn_exp2f(s0[r] - mn); s1[r] = __builtin_amdgcn_exp2f(s1[r] - mn); ls += s0[r] + s1[r]; } \
        l = l * alpha + ls; } while (0)
#define D3_PACK() do { _Pragma("unroll") for (int i4 = 0; i4 < 4; ++i4) { float pf[8]; \
        _Pragma("unroll") for (int e = 0; e < 8; ++e) pf[e] = (i4 >> 1) ? s1[8 * (i4 & 1) + e] : s0[8 * (i4 & 1) + e]; \
        pp[i4] = pack8(pf); } } while (0)
    const int nt = 2 * qb + 2, tw = (q0 + 31) >> 6;
    D3_KLOAD(0);
    bf16x8 qf[4];
    {
        const bf16_t* qp = P + (tokb + q0 + l31) * NPAD + C_DQ + h * 128 + c * 64;
        float f[4][8]; float ss = 0.f;
#pragma unroll
        for (int ks = 0; ks < 4; ++ks) { unpack8(*(const uint4*)(qp + 16 * ks + 8 * hh), f[ks]);
#pragma unroll
            for (int e = 0; e < 8; ++e) ss += f[ks][e] * f[ks][e]; }
        ss += __shfl_xor(ss, 32);
        const float sc = rsqrtf(ss * (1.f / 64.f) + EPS) * 0.125f * LOG2E;
#pragma unroll
        for (int ks = 0; ks < 4; ++ks) {
#pragma unroll
            for (int e = 0; e < 8; ++e) f[ks][e] *= sc * W.dq_n[16 * ks + 8 * hh + e];
            qf[ks] = pack8(f[ks]); }
    }
    f32x16 O[4];
#pragma unroll
    for (int vt = 0; vt < 4; ++vt)
#pragma unroll
        for (int r = 0; r < 16; ++r) O[vt][r] = 0.f;
    float m = -INFINITY, l = 0.f, alpha = 0.f;
    bf16x8 pp[4];
    f32x16 s0, s1;
    __syncthreads();
    D3_KSTORE(0);
    __syncthreads();
    unsigned* HC = (unsigned*)(lds + 81920);
    const int hbase = 32 * (256 - (qb + 1) * (qb + 1)) + (item & 31) * (2 * qb + 1) - 1;
    f32x4 hc[4]; TrTile Th, Tf; bool hok, fok = false;
    hok = diff_host_tile(p, lay, hbase + 1, Th);
    if (hok) tr_load(Th, tid, hc);
    {
        D3_KLOAD(1); D3_VLOAD(0);
        D3_QK(0);
        D3_SOFTMAX();
        D3_PACK();
        D3_KSTORE(1); D3_VSTORE(0);
        __syncthreads();
    }
#pragma unroll 1
    for (int t = 1; t < nt; ++t) {
        const bool more = (t + 1 < nt);
        if (fok) tr_flush(Tf, tid, HC + ((t - 1) & 1) * 4160);
        if (more) D3_KLOAD(t + 1);
        D3_VLOAD(t);
        if (t <= tw) {
            D3_QK(t);
            {
                float mx = -INFINITY;
#pragma unroll
                for (int r = 0; r < 16; ++r) { mx = __builtin_amdgcn_fmed3f(mx, s0[r], INFINITY); mx = __builtin_amdgcn_fmed3f(mx, s1[r], INFINITY); }
                mx = __builtin_amdgcn_fmed3f(mx, __shfl_xor(mx, 32), INFINITY);
                const float mn = __builtin_amdgcn_fmed3f(m, mx, INFINITY); alpha = __builtin_amdgcn_exp2f(m - mn); m = mn;
                float ls = 0.f;
                const bf16_t* Vb_ = (const bf16_t*)(lds + ((t - 1) & 1) * ABUF + KBYTES);
#pragma unroll
                for (int r = 0; r < 16; ++r) {
                    { const int i4 = r >> 2, vt = r & 3;
                      const bf16_t* vp = Vb_ + (32 * vt + l31) * VP + 16 * i4 + 4 * hh;
                      const s16x4 lo = *(const s16x4*)vp, hi = *(const s16x4*)(vp + 8);
                      O[vt] = MFMA32(__builtin_shufflevector(lo, hi, 0, 1, 2, 3, 4, 5, 6, 7), pp[i4], O[vt]); }
                    s0[r] = __builtin_amdgcn_exp2f(s0[r] - mn); s1[r] = __builtin_amdgcn_exp2f(s1[r] - mn); ls += s0[r] + s1[r];
                    __builtin_amdgcn_sched_barrier(0);
                }
                l = l * alpha + ls;
            }
#pragma unroll
            for (int vt = 0; vt < 4; ++vt)
#pragma unroll
                for (int r = 0; r < 16; ++r) O[vt][r] *= alpha;
            D3_PACK();
        } else if (t == tw + 1) {
            D3_PV(t - 1);
        }
        if (more) D3_KSTORE(t + 1);
        D3_VSTORE(t);
        if (hok) tr_stage(tid, hc, HC + (t & 1) * 4160);
        Tf = Th; fok = hok;
        hok = more && diff_host_tile(p, lay, hbase + t + 1, Th);
        if (hok) tr_load(Th, tid, hc);
        __syncthreads();
    }
    if (fok) tr_flush(Tf, tid, HC + ((nt - 1) & 1) * 4160);
    if (tw == nt - 1) D3_PV(nt - 1);
    __syncthreads();
#undef D3_KLOAD
#undef D3_VLOAD
#undef D3_KSTORE
#undef D3_VSTORE
#undef D3_QK
#undef D3_PV
#undef D3_SOFTMAX
#undef D3_PACK
    l += __shfl_xor(l, 32);
    float* OB = (float*)lds;
    const int orow = (g * 32 + l31) * 129;
    const float sc = (c == 0) ? 1.f / l : lam / l;
    if (c == 1) {
#pragma unroll
        for (int vt = 0; vt < 4; ++vt)
#pragma unroll
            for (int r = 0; r < 16; ++r) OB[orow + 32 * vt + crow(r, hh)] = O[vt][r] * sc; }
    __syncthreads();
    if (c == 0) {
        float ss = 0.f;
#pragma unroll
        for (int vt = 0; vt < 4; ++vt)
#pragma unroll
            for (int r = 0; r < 16; ++r) { const float o = O[vt][r] * sc - OB[orow + 32 * vt + crow(r, hh)]; O[vt][r] = o; ss += o * o; }
        ss += __shfl_xor(ss, 32);
        const float rstd = rsqrtf(ss * (1.f / 128.f) + EPS) * (1.f - W.lambda_init);
#pragma unroll
        for (int vt = 0; vt < 4; ++vt)
#pragma unroll
            for (int r = 0; r < 16; ++r) OB[orow + 32 * vt + crow(r, hh)] = O[vt][r] * rstd; }
    __syncthreads();
    { const int q = tid >> 2, part = tid & 3; const size_t tq = tokb + qb * 128 + q;
      const bf16_t* gp = P + tq * NPAD + C_GATE + 2048 + h * 128 + part * 32; bf16_t* yp = Y + tq * DM + 2048 + h * 128 + part * 32;
#pragma unroll
      for (int ch = 0; ch < 4; ++ch) { float gf[8]; unpack8(*(const uint4*)(gp + ch * 8), gf); float of[8];
#pragma unroll
          for (int e = 0; e < 8; ++e) of[e] = OB[q * 129 + part * 32 + ch * 8 + e] * gf[e] * W.d_on[part * 32 + ch * 8 + e];
          *(bf16x8*)(yp + ch * 8) = pack8(of); } }
    __syncthreads();
}

__device__ __forceinline__ float fast_sigm(float x) { return __builtin_amdgcn_rcpf(1.f + __builtin_amdgcn_exp2f(-x * LOG2E)); }
__device__ __forceinline__ void lru_pre_item(const bf16_t* __restrict__ P, bf16_t* __restrict__ HL, bf16_t* __restrict__ CP, const LayerW& W, int item, unsigned char* lds) {
    const int tid = tid_opaque(), lane = tid & 63, wave = tid >> 6, l31 = lane & 31, hh = lane >> 5;
    const int b = item >> 6, n = (item >> 3) & 7, seg = item & 7;
    const size_t tokb = (size_t)b * SEQ;
    bf16_t* WrT = (bf16_t*)lds; bf16_t* WiT = WrT + 128 * 136; bf16_t* XC = WiT + 128 * 136; float* A = (float*)(lds + 69632 + 17408); float* U = A + 8192;
    __syncthreads();
#pragma unroll 2
    for (int e = 0; e < 8; ++e) { const int idx = tid + 512 * e, i = idx >> 5, j4 = (idx & 31) * 4;
        const float4 a = *(const float4*)(W.w_r + (size_t)n * 16384 + i * 128 + j4), c = *(const float4*)(W.w_i + (size_t)n * 16384 + i * 128 + j4);
        WrT[(j4 + 0) * 136 + i] = f2bf(a.x); WrT[(j4 + 1) * 136 + i] = f2bf(a.y); WrT[(j4 + 2) * 136 + i] = f2bf(a.z); WrT[(j4 + 3) * 136 + i] = f2bf(a.w);
        WiT[(j4 + 0) * 136 + i] = f2bf(c.x); WiT[(j4 + 1) * 136 + i] = f2bf(c.y); WiT[(j4 + 2) * 136 + i] = f2bf(c.z); WiT[(j4 + 3) * 136 + i] = f2bf(c.w); }
    const int tt = wave >> 2, jt = wave & 3, chl = 32 * jt + l31, ch = n * 128 + chl;
    const float br = W.b_r[ch], bi = W.b_i[ch];
    float sp; { const float x = -W.lam[ch]; sp = (x > 20.f) ? x : log1pf(expf(x)); }
    const float sp8 = -8.f * sp;
    const int cc = 2 * (tid & 63), tg = tid >> 6, cch = n * 128 + cc;
    float cw[4][2], cb[2];
#pragma unroll
    for (int w = 0; w < 4; ++w) { cw[w][0] = W.conv_w[w * 1024 + cch]; cw[w][1] = W.conv_w[w * 1024 + cch + 1]; }
    cb[0] = W.conv_b[cch]; cb[1] = W.conv_b[cch + 1];
    unsigned rx[11];
#define LRU_LOAD(k) do { _Pragma("unroll") for (int i = 0; i < 11; ++i) { const int tp = seg * 256 + (k) * 64 + 8 * tg - 3 + i; rx[i] = (tp >= 0) ? *(const unsigned*)(P + (tokb + tp) * NPAD + C_RX + cch) : 0u; } } while (0)
    LRU_LOAD(0);
    float* XH = (float*)XC; float* XP = XH + 512;
    const int sch = tid & 127, ssub = tid >> 7;
    float hcar = 0.f, ccar = 1.f;
#pragma unroll 1
    for (int k = 0; k < 4; ++k) {
#pragma unroll
        for (int i = 0; i < 8; ++i) { float x0 = cb[0], x1 = cb[1];
#pragma unroll
            for (int w = 0; w < 4; ++w) { const unsigned v = rx[i + w]; x0 += cw[w][0] * __uint_as_float(v << 16); x1 += cw[w][1] * __uint_as_float(v & 0xffff0000u); }
            *(unsigned*)(XC + (8 * tg + i) * 136 + cc) = cvt2(x0, x1); }
        if (k + 1 < 4) LRU_LOAD(k + 1);
        __syncthreads();
        {
            f32x16 ar, ai;
#pragma unroll
            for (int r = 0; r < 16; ++r) { ar[r] = 0.f; ai[r] = 0.f; }
#pragma unroll
            for (int ks = 0; ks < 8; ++ks) {
                const bf16x8 a = *(const bf16x8*)(XC + (32 * tt + l31) * 136 + 16 * ks + 8 * hh);
                const bf16x8 wr = *(const bf16x8*)(WrT + (32 * jt + l31) * 136 + 16 * ks + 8 * hh);
                const bf16x8 wi = *(const bf16x8*)(WiT + (32 * jt + l31) * 136 + 16 * ks + 8 * hh);
                ar = MFMA32(a, wr, ar); ai = MFMA32(a, wi, ai); }
#pragma unroll
            for (int r = 0; r < 16; ++r) { const int t = 32 * tt + crow(r, hh);
                const float rr = fast_sigm(ar[r] + br), ii = fast_sigm(ai[r] + bi), la = sp8 * rr;
                const float av = __builtin_amdgcn_exp2f(la * LOG2E), x2 = 2.f * la;
                const float om = (x2 > -0.1f) ? -x2 * (1.f + x2 * (0.5f + x2 * (0.16666667f + x2 * 0.041666668f))) : 1.f - av * av;
                const float xv = bf2f(XC[t * 136 + chl]);
                A[t * 128 + chl] = av; U[t * 128 + chl] = __builtin_amdgcn_sqrtf(om) * ii * xv; }
        }
        __syncthreads();
        {
            float hl[16], cl[16]; float hh_ = 0.f, cc_ = 1.f;
#pragma unroll
            for (int t = 0; t < 16; ++t) { const float a = A[(16 * ssub + t) * 128 + sch]; hh_ = a * hh_ + U[(16 * ssub + t) * 128 + sch]; cc_ *= a; hl[t] = hh_; cl[t] = cc_; }
            XH[ssub * 128 + sch] = hh_; XP[ssub * 128 + sch] = cc_;
            __syncthreads();
            float hin = hcar, cin = ccar;
            for (int s = 0; s < ssub; ++s) { hin = XH[s * 128 + sch] + XP[s * 128 + sch] * hin; cin *= XP[s * 128 + sch]; }
            float hend = hin, cend = cin;
            for (int s = ssub; s < 4; ++s) { hend = XH[s * 128 + sch] + XP[s * 128 + sch] * hend; cend *= XP[s * 128 + sch]; }
            hcar = hend; ccar = cend;
            const size_t o = (tokb + seg * 256 + k * 64 + 16 * ssub) * 1024 + n * 128 + sch;
#pragma unroll
            for (int t = 0; t < 16; ++t) { HL[o + (size_t)t * 1024] = f2bf(hl[t] + cl[t] * hin); CP[o + (size_t)t * 1024] = f2bf(cl[t] * cin); }
            __syncthreads();
        }
    }
#undef LRU_LOAD
    __syncthreads();
}
__device__ __forceinline__ void lru_fix_item(const bf16_t* __restrict__ P, bf16_t* __restrict__ Y, const bf16_t* __restrict__ HL, const bf16_t* __restrict__ CP, int item) {
    const int tid = tid_opaque();
    const int b = item >> 6, n = (item >> 3) & 7, seg = item & 7;
    const size_t tokb = (size_t)b * SEQ;
    const int c0 = (tid & 15) * 8, tr = tid >> 4;
    float carry[8];
#pragma unroll
    for (int e = 0; e < 8; ++e) carry[e] = 0.f;
    for (int s = 0; s < seg; ++s) { const size_t o = (tokb + s * 256 + 255) * 1024 + n * 128 + c0;
        float h[8], c[8]; unpack8(*(const uint4*)(HL + o), h); unpack8(*(const uint4*)(CP + o), c);
#pragma unroll
        for (int e = 0; e < 8; ++e) carry[e] = h[e] + c[e] * carry[e]; }
#pragma unroll 2
    for (int it = 0; it < 8; ++it) { const size_t tok = tokb + seg * 256 + it * 32 + tr; const size_t o = tok * 1024 + n * 128 + c0;
        float h[8], c[8], gf[8]; unpack8(*(const uint4*)(HL + o), h); unpack8(*(const uint4*)(CP + o), c);
        unpack8(*(const uint4*)(P + tok * NPAD + C_GATE + 3072 + n * 128 + c0), gf);
        float of[8];
#pragma unroll
        for (int e = 0; e < 8; ++e) of[e] = (h[e] + c[e] * carry[e]) * gf[e];
        *(bf16x8*)(Y + tok * DM + 3072 + n * 128 + c0) = pack8(of); }
}

constexpr size_t GP_UNIT = 41216;
struct GlaPreRaw { uint4 ra0, ra1, rq, rk, rv0, rv1; };
__device__ __forceinline__ GlaPreRaw gla_pre_load(const bf16_t* __restrict__ P, int unit, int lane, int wave) {
    const int bh = unit >> 5, k = unit & 31, b = bh >> 3, h = bh & 7;
    const bf16_t* row_ = P + ((size_t)b * SEQ + k * 64 + lane) * NPAD;
    GlaPreRaw r;
    r.ra0 = *(const uint4*)(row_ + C_GA); r.ra1 = *(const uint4*)(row_ + C_GA + 8);
    r.rq = *(const uint4*)(row_ + C_GQ + h * 64 + 8 * wave); r.rk = *(const uint4*)(row_ + C_GK + h * 64 + 8 * wave);
    r.rv0 = *(const uint4*)(row_ + C_GV + h * 128 + 16 * wave); r.rv1 = *(const uint4*)(row_ + C_GV + h * 128 + 16 * wave + 8);
    return r;
}
__device__ __forceinline__ void gla_pre_unit(const GlaPreRaw& R, unsigned char* __restrict__ GP, const LayerW& W, int unit, unsigned char* lds, int tid) {
    const int lane = tid & 63, wave = tid >> 6;
    const int bh = unit >> 5, h = bh & 7;
    float* WUP = (float*)lds;
    __syncthreads();
    for (int i = tid; i < 1024; i += 512) WUP[i] = W.gla_w_up[(i >> 6) * 512 + h * 64 + (i & 63)];
    if (tid < 64) WUP[1024 + tid] = W.gla_b_up[h * 64 + tid];
    __syncthreads();
    unsigned char* g = GP + (size_t)unit * GP_UNIT;
    float al[16]; unpack8(R.ra0, al); unpack8(R.ra1, al + 8);
    float bc[8];
    { const float4 b0 = *(const float4*)(WUP + 1024 + 8 * wave), b1 = *(const float4*)(WUP + 1024 + 8 * wave + 4);
      bc[0] = b0.x; bc[1] = b0.y; bc[2] = b0.z; bc[3] = b0.w; bc[4] = b1.x; bc[5] = b1.y; bc[6] = b1.z; bc[7] = b1.w; }
#pragma unroll
    for (int r = 0; r < 16; ++r) { const float4 w0 = *(const float4*)(WUP + r * 64 + 8 * wave), w1 = *(const float4*)(WUP + r * 64 + 8 * wave + 4);
        bc[0] += al[r] * w0.x; bc[1] += al[r] * w0.y; bc[2] += al[r] * w0.z; bc[3] += al[r] * w0.w; bc[4] += al[r] * w1.x; bc[5] += al[r] * w1.y; bc[6] += al[r] * w1.z; bc[7] += al[r] * w1.w; }
#pragma unroll
    for (int e = 0; e < 8; ++e) { const float lg = bc[e]; bc[e] = (fminf(lg, 0.f) - __logf(1.f + __expf(-fabsf(lg)))) * (1.f / 16.f); }
#define DPP_ADD(x, ctrl, rmask) (x) += __int_as_float(__builtin_amdgcn_update_dpp(0, __float_as_int(x), (ctrl), (rmask), 0xf, true))
#pragma unroll
    for (int e = 0; e < 8; ++e) { DPP_ADD(bc[e], 0x111, 0xf); DPP_ADD(bc[e], 0x112, 0xf); DPP_ADD(bc[e], 0x114, 0xf); DPP_ADD(bc[e], 0x118, 0xf); DPP_ADD(bc[e], 0x142, 0xa); DPP_ADD(bc[e], 0x143, 0xc); }
#undef DPP_ADD
    float qv[8], kv[8], qd[8], kd[8]; unpack8(R.rq, qv); unpack8(R.rk, kv);
#pragma unroll
    for (int e = 0; e < 8; ++e) { const float bl = __shfl(bc[e], 63);
        qd[e] = qv[e] * 0.125f * __expf(bc[e]); kd[e] = kv[e] * __expf(-bc[e]);
        ((bf16_t*)(g + 16384))[(8 * wave + e) * 64 + lane] = f2bf(kv[e] * __expf(bl - bc[e]));
        if (lane == 63) ((float*)(g + 40960))[8 * wave + e] = __expf(bl); }
    *(bf16x8*)(g + (lane * 64 + 8 * wave) * 2) = pack8(qd); *(bf16x8*)(g + 8192 + (lane * 64 + 8 * wave) * 2) = pack8(kd);
    const unsigned vw[8] = {R.rv0.x, R.rv0.y, R.rv0.z, R.rv0.w, R.rv1.x, R.rv1.y, R.rv1.z, R.rv1.w};
    bf16_t* vt = (bf16_t*)(g + 24576);
#pragma unroll
    for (int e = 0; e < 8; ++e) { vt[(16 * wave + 2 * e) * 64 + lane] = (bf16_t)(vw[e] & 0xffffu); vt[(16 * wave + 2 * e + 1) * 64 + lane] = (bf16_t)(vw[e] >> 16); }
}
__device__ __forceinline__ void gla_pre_all(const bf16_t* __restrict__ P, unsigned char* __restrict__ GP, const LayerW& W, unsigned char* lds) {
    const int tid = tid_opaque(), lane = tid & 63, wave = tid >> 6;
    int u = blockIdx.x;
    if (u >= 1024) return;
    GlaPreRaw cur = gla_pre_load(P, u, lane, wave);
#pragma unroll 1
    while (u < 1024) {
        const int un = u + gridDim.x;
        GlaPreRaw nxt = cur;
        if (un < 1024) nxt = gla_pre_load(P, un, lane, wave);
        gla_pre_unit(cur, GP, W, u, lds, tid);
        cur = nxt; u = un;
    }
}

__device__ __forceinline__ void gla_item(const Params& p, int l, const bf16_t* __restrict__ P, bf16_t* __restrict__ Y, const unsigned char* __restrict__ GP, const LayerW& W, int item, unsigned char* lds) {
    const int tid = tid_opaque(), lane = tid & 63, wave = tid >> 6, l31 = lane & 31, hh = lane >> 5;
    const int b = item >> 3, h = item & 7;
    const size_t tokb = (size_t)b * SEQ;
    bf16_t* QD = (bf16_t*)lds; bf16_t* KD = QD + 64 * 72; bf16_t* KST = KD + 64 * 72; bf16_t* VT = KST + 64 * 72; bf16_t* ST = VT + 128 * 72;
    float* OB = (float*)(lds + 64768);
    const int vt = wave >> 1, it = wave & 1;
    const int srow = tid >> 3, sseg = tid & 7, ctok = tid >> 3, cvch = tid & 7;
    f32x16 S;
#pragma unroll
    for (int r = 0; r < 16; ++r) S[r] = 0.f;
    uint4 rQ, rK, rS, rV0, rV1, rg0, rg1; float rdec;
#define GLA_LOAD(k) do { const unsigned char* g_ = GP + (size_t)(item * 32 + (k)) * GP_UNIT + srow * 128 + sseg * 16; \
        rQ = *(const uint4*)g_; rK = *(const uint4*)(g_ + 8192); rS = *(const uint4*)(g_ + 16384); rV0 = *(const uint4*)(g_ + 24576); rV1 = *(const uint4*)(g_ + 24576 + 8192); \
        rdec = ((const float*)(GP + (size_t)(item * 32 + (k)) * GP_UNIT + 40960))[32 * it + l31]; \
        const bf16_t* gp_ = P + (tokb + (k) * 64 + ctok) * NPAD + C_GATE + h * 128 + cvch * 16; rg0 = *(const uint4*)gp_; rg1 = *(const uint4*)(gp_ + 8); } while (0)
    GLA_LOAD(0);
    unsigned* CS0 = (unsigned*)(lds + 98304); unsigned* CS1 = (unsigned*)(lds + 98304 + 16640);
    f32x4 ca[4], cb[4]; TrTile Ta, Tb;
    bool oka = host_tile(p, l, item * 32, Ta), okb = false;
    if (oka) tr_load(Ta, tid, ca);
    if (okb) tr_load(Tb, tid, cb);
    float nw[16];
#pragma unroll
    for (int e = 0; e < 16; ++e) nw[e] = W.gla_nw[cvch * 16 + e];
    __syncthreads();
#pragma unroll 1
    for (int k = 0; k < 32; ++k) {
        *(uint4*)(QD + srow * 72 + sseg * 8) = rQ; *(uint4*)(KD + srow * 72 + sseg * 8) = rK; *(uint4*)(KST + srow * 72 + sseg * 8) = rS;
        *(uint4*)(VT + srow * 72 + sseg * 8) = rV0; *(uint4*)(VT + (64 + srow) * 72 + sseg * 8) = rV1;
#pragma unroll
        for (int r = 0; r < 16; ++r) ST[(32 * vt + crow(r, hh)) * 72 + 32 * it + l31] = f2bf(S[r]);
        const float dec = rdec; const uint4 g0 = rg0, g1 = rg1;
        __syncthreads();
        if (k + 1 < 32) GLA_LOAD(k + 1);
        {
            f32x16 at0, at1, o, u;
#pragma unroll
            for (int r = 0; r < 16; ++r) { at0[r] = 0.f; at1[r] = 0.f; o[r] = 0.f; u[r] = 0.f; }
#pragma unroll
            for (int ks = 0; ks < 4; ++ks) {
                const bf16x8 bq = *(const bf16x8*)(QD + (32 * it + l31) * 72 + 16 * ks + 8 * hh);
                const bf16x8 a0 = *(const bf16x8*)(KD + l31 * 72 + 16 * ks + 8 * hh), a1 = *(const bf16x8*)(KD + (32 + l31) * 72 + 16 * ks + 8 * hh);
                at0 = MFMA32(a0, bq, at0); at1 = MFMA32(a1, bq, at1); }
            const int iq = 32 * it + l31;
#pragma unroll
            for (int r = 0; r < 16; ++r) { const int j0 = crow(r, hh); if (j0 > iq) at0[r] = 0.f; if (j0 + 32 > iq) at1[r] = 0.f; }
#pragma unroll
            for (int jt2 = 0; jt2 < 2; ++jt2)
#pragma unroll
                for (int s2 = 0; s2 < 2; ++s2) { float pf[8];
#pragma unroll
                    for (int e = 0; e < 8; ++e) pf[e] = jt2 ? at1[8 * s2 + e] : at0[8 * s2 + e];
                    const bf16x8 pb = pack8(pf);
                    const bf16_t* vp = VT + (32 * vt + l31) * 72 + 32 * jt2 + 16 * s2 + 4 * hh;
                    const s16x4 lo = *(const s16x4*)vp, hi = *(const s16x4*)(vp + 8);
                    o = MFMA32(__builtin_shufflevector(lo, hi, 0, 1, 2, 3, 4, 5, 6, 7), pb, o); }
#pragma unroll
            for (int ks = 0; ks < 4; ++ks) {
                const bf16x8 a = *(const bf16x8*)(ST + (32 * vt + l31) * 72 + 16 * ks + 8 * hh);
                const bf16x8 bq = *(const bf16x8*)(QD + (32 * it + l31) * 72 + 16 * ks + 8 * hh);
                o = MFMA32(a, bq, o); }
#pragma unroll
            for (int ks = 0; ks < 4; ++ks) {
                const bf16x8 a = *(const bf16x8*)(VT + (32 * vt + l31) * 72 + 16 * ks + 8 * hh);
                const bf16x8 bk = *(const bf16x8*)(KST + (32 * it + l31) * 72 + 16 * ks + 8 * hh);
                u = MFMA32(a, bk, u); }
#pragma unroll
            for (int r = 0; r < 16; ++r) { S[r] = dec * S[r] + u[r]; OB[(32 * it + l31) * 129 + 32 * vt + crow(r, hh)] = o[r]; }
        }
        const TrTile Fa = Ta, Fb = Tb; const bool fa = oka, fb = okb;
        if (fa) tr_stage(tid, ca, CS0);
        if (fb) tr_stage(tid, cb, CS1);
        oka = (k + 1 < 32) && host_tile(p, l, item * 32 + k + 1, Ta); okb = false;
        if (oka) tr_load(Ta, tid, ca);
        if (okb) tr_load(Tb, tid, cb);
        __syncthreads();
        if (fa) tr_flush(Fa, tid, CS0);
        if (fb) tr_flush(Fb, tid, CS1);
        {
            float ov[16]; float ss = 0.f;
#pragma unroll
            for (int e = 0; e < 16; ++e) { ov[e] = OB[ctok * 129 + cvch * 16 + e]; ss += ov[e] * ov[e]; }
            ss += __shfl_xor(ss, 1); ss += __shfl_xor(ss, 2); ss += __shfl_xor(ss, 4);
            const float rstd = rsqrtf(ss * (1.f / 128.f) + EPS);
            float gf[16]; unpack8(g0, gf); unpack8(g1, gf + 8);
#pragma unroll
            for (int e = 0; e < 16; ++e) ov[e] *= rstd * nw[e] * gf[e];
            bf16_t* yp = Y + (tokb + k * 64 + ctok) * DM + h * 128 + cvch * 16;
            *(bf16x8*)yp = pack8(ov); *(bf16x8*)(yp + 8) = pack8(ov + 8);
        }
    }
#undef GLA_LOAD
    __syncthreads();
}

constexpr int QSLOT_OFF = LDS_BYTES - 16;
constexpr size_t WS_CTR = WS_END;
constexpr size_t WS_BAR = WS_END + 512;
constexpr size_t WS_CTL_BYTES = 512 + XCD_BAR_WORDS_C * 4;
__device__ __forceinline__ void phase_mix_fast(const Params& p, int l, unsigned char* lds, int rep) {
    const LayerW W = layer_w(p, l);
    const bf16_t* P = (const bf16_t*)(p.ws + WS_PROJ); bf16_t* Y = (bf16_t*)(p.ws + WS_Y);
    unsigned* ctr = (unsigned*)(p.ws + WS_CTR) + l * 64 + rep * 16;
    const float lam = diff_lambda(W);
    volatile int* slot = (volatile int*)(lds + QSLOT_OFF);
    for (;;) {
        __syncthreads();
        if (tid_opaque() == 0) *slot = (int)atomicAdd(ctr, 1u);
        __syncthreads();
        const int it = __builtin_amdgcn_readfirstlane(*slot);
        if (it >= 1056) break;
        if (it < 32) { gla_item(p, l, P, Y, p.ws + WS_GP, W, it, lds);
#ifdef PROBE_GLA2
            gla_item(p, l, P, Y, p.ws + WS_GP, W, it, lds);
#endif
        }
        else if (it < 544) diff_item3(p, l, P, Y, W, lam, it - 32, lds);
        else if (it < 800) attn_item<true>(P, Y, W, lam, it - 544, lds);
        else lru_fix_item(P, Y, (const bf16_t*)(p.ws + WS_LA), (const bf16_t*)(p.ws + WS_LU), it - 800);
    }
}

#define XB_TMO      128
#define XB_XCNT(j)  (256  + 64 * (j))
#define XB_XSUB(j)  (1280 + 64 * (j))
#define XB_XGEN(j)  (2304 + 64 * (j))
#define XB_TOP      3328
#define XB_TOPGEN   3392
#define XCD_BAR_WORDS 3456
#define XB_SPIN_CAP (1u << 18)

__device__ __forceinline__ unsigned xb_ld(unsigned* p)              { return __hip_atomic_load(p, __ATOMIC_RELAXED, __HIP_MEMORY_SCOPE_AGENT); }
__device__ __forceinline__ unsigned xb_add(unsigned* p, unsigned v) { return __hip_atomic_fetch_add(p, v, __ATOMIC_RELAXED, __HIP_MEMORY_SCOPE_AGENT); }
__device__ __forceinline__ unsigned xb_xcc_id() { return (unsigned)__builtin_amdgcn_s_getreg((3 << 11) | 20) & 0xFu; }
#define XB_SPIN(cond, bar) do { unsigned _sp = 0; while (cond) { __builtin_amdgcn_s_sleep(1); \
    if ((++_sp & 255u) == 0u) { if (xb_ld(&(bar)[XB_TMO])) break; if (_sp > XB_SPIN_CAP) { atomicAdd(&(bar)[XB_TMO], 1u); break; } } } } while (0)

struct XcdBarrier {
    unsigned* bar; unsigned x;
    volatile LAS unsigned* st;
};

__device__ __forceinline__ XcdBarrier xcd_barrier_post(unsigned* bar, volatile LAS unsigned* st) {
    XcdBarrier b; b.bar = bar; b.x = xb_xcc_id(); b.st = st;
    if (threadIdx.x == 0) (void)xb_add(&bar[XB_XCNT(b.x)], 1u);
    return b;
}
__device__ __forceinline__ void xcd_barrier_complete(unsigned* bar, unsigned x, unsigned& nloc, unsigned& nx) {
    const unsigned G = gridDim.x * gridDim.y * gridDim.z;
    unsigned sum, cnt, mine, sp = 0u;
    for (;;) {
        sum = 0u; cnt = 0u; mine = 0u;
#pragma unroll
        for (unsigned j = 0; j < 16; ++j) { const unsigned c = xb_ld(&bar[XB_XCNT(j)]); sum += c; cnt += (c > 0u) ? 1u : 0u; mine = (j == x) ? c : mine; }
        if (sum == G) break;
        __builtin_amdgcn_s_sleep(1);
        if ((++sp & 255u) == 0u) { if (xb_ld(&bar[XB_TMO])) break; if (sp > XB_SPIN_CAP) { atomicAdd(&bar[XB_TMO], 1u); break; } }
    }
    nloc = mine > 0u ? mine : 1u; nx = cnt > 0u ? cnt : 1u;
}

__device__ __forceinline__ void xcd_barrier(const XcdBarrier& b) {
    asm volatile("s_waitcnt vmcnt(0)" ::: "memory");
    __syncthreads();
    if (threadIdx.x == 0) {
        unsigned* bar = b.bar;
        __builtin_amdgcn_s_waitcnt(0);
        unsigned nloc = b.st[0], nx = b.st[1];
        if (nloc == 0u) { xcd_barrier_complete(bar, b.x, nloc, nx); b.st[0] = nloc; b.st[1] = nx; }
        const unsigned old = xb_add(&bar[XB_XSUB(b.x)], 1u);
        const unsigned gen = old / nloc;
        if (old + 1u == (gen + 1u) * nloc) {
            __builtin_amdgcn_fence(__ATOMIC_RELEASE, "agent");
            asm volatile("s_waitcnt vmcnt(0)" ::: "memory");
            const unsigned og = xb_add(&bar[XB_TOP], 1u);
            const unsigned tg = og / nx;
            if (og + 1u == (tg + 1u) * nx) xb_add(&bar[XB_TOPGEN], 1u);
            else XB_SPIN(xb_ld(&bar[XB_TOPGEN]) == tg, bar);
            __builtin_amdgcn_fence(__ATOMIC_ACQUIRE, "agent");
            xb_add(&bar[XB_XGEN(b.x)], 1u);
            asm volatile("s_waitcnt vmcnt(0)" ::: "memory");
        } else {
            XB_SPIN(xb_ld(&bar[XB_XGEN(b.x)]) == gen, bar);
            __builtin_amdgcn_fence(__ATOMIC_ACQUIRE, "agent");
            asm volatile("s_waitcnt vmcnt(0)" ::: "memory");
        }
    }
    __syncthreads();
}


#ifndef GEMM_SP2
#define GEMM_SP2 true
#endif
#ifndef GEMM_ALIGN
#define GEMM_ALIGN true
#endif
#ifndef REP_M1
#define REP_M1 1
#endif
#ifndef REP_PREP
#define REP_PREP 1
#endif
#ifndef REP_G1
#define REP_G1 1
#endif
#ifndef REP_MIX
#define REP_MIX 1
#endif
__global__ void __launch_bounds__(512, 2) mega(Params p) {
    extern __shared__ __attribute__((aligned(16))) unsigned char lds[];
    cg::grid_group grid = cg::this_grid();
    const int lo = p.ph_lo, hi = p.ph_hi;
#define IN(k) (lo <= (k) && (k) < hi)
#define SYNC(k) do { if (IN(k) && IN((k) + 1)) xcd_barrier(xbar); } while (0)
    if (lo < 0) grid.sync();
    volatile LAS unsigned* xst = (volatile LAS unsigned*)((LAS unsigned char*)lds + (LDS_BYTES - 32));
    if (threadIdx.x < 2) xst[threadIdx.x] = 0u;
    __syncthreads();
    XcdBarrier xbar; xbar.bar = (unsigned*)(p.ws + WS_BAR); xbar.x = xb_xcc_id(); xbar.st = xst;
    if (threadIdx.x == 0) xst[2] = xb_add(&xbar.bar[XB_XCNT(xbar.x)], 1u);
    __syncthreads();
    const int xrank = (int)xst[2];
    int cu_c = (int)blockIdx.x;
#ifdef EXTRA_SYNC
    if (hi - lo > 1) {
#pragma unroll 1
        for (int r = 0; r < EXTRA_SYNC; ++r) grid.sync(); }
#endif
    if (IN(0)) {
#pragma unroll 1
        for (int r = 0; r < REP_PREP; ++r) phase_prep(p, lds); }
    SYNC(0);
    if (hi - lo > 1) {
        bool even = (gridDim.x % 8 == 0);
        for (unsigned j = 0; j < 16; ++j) { const unsigned cnt = xb_ld(&xbar.bar[XB_XCNT(j)]); even = even && (cnt == (j < 8 ? gridDim.x / 8 : 0u)); }
        if (even) cu_c = (int)xbar.x + 8 * xrank;
    }
#pragma unroll 1
    for (int l = 0; l < 2; ++l) {
        const int pb = 1 + 5 * l;
        if (IN(pb)) {
            pg8::Gemm g{(const bf16_t*)(p.ws + WS_H), (const bf16_t*)(p.ws + WS_WIN + l * SZ_WIN), TOK, NPAD, DM};
            pg8::StaticOrder S; S.init(TOK, NPAD, (int)gridDim.x, cu_c);
            EpiProj E{(bf16_t*)(p.ws + WS_PROJ)};
#pragma unroll 1
            for (int r = 0; r < REP_G1; ++r)
            pg8::gemm_phase<EpiProj, pg8::StaticOrder, GEMM_ALIGN, GEMM_SP2>((LAS unsigned char*)lds, g, S, E);
            { const int nwg = (TOK / 256) * (NPAD / 256), G = (int)gridDim.x, rem = nwg % G;
              if (rem == 0) convert_deferred(p, l, cu_c, G, lds);
              else if (cu_c >= rem) convert_deferred(p, l, cu_c - rem, G - rem, lds); }
        }
        SYNC(pb);
        if (IN(pb + 1)) { const LayerW W = layer_w(p, l);
#pragma unroll 1
          for (int r1 = 0; r1 < REP_M1; ++r1) {
            gla_pre_all((const bf16_t*)(p.ws + WS_PROJ), p.ws + WS_GP, W, lds);
            for (int it = blockIdx.x; it < 256; it += gridDim.x) lru_pre_item((const bf16_t*)(p.ws + WS_PROJ), (bf16_t*)(p.ws + WS_LA), (bf16_t*)(p.ws + WS_LU), W, it, lds); } }
        SYNC(pb + 1);
        if (IN(pb + 2)) {
#pragma unroll 1
            for (int r = 0; r < REP_MIX; ++r) phase_mix_fast(p, l, lds, r); }
        SYNC(pb + 2);
        if (IN(pb + 3)) {
            pg8::Gemm g{(const bf16_t*)(p.ws + WS_Y), (const bf16_t*)(p.ws + WS_WOUT + l * SZ_WOUT), TOK, DM, DM};
            pg8::StaticOrder S; S.init(TOK, DM, (int)gridDim.x, cu_c);
            EpiRes E{l == 0 ? p.in[0] : (const float*)(p.ws + WS_X1), l == 0 ? (float*)(p.ws + WS_X1) : p.out};
            pg8::gemm_phase<EpiRes, pg8::StaticOrder, GEMM_ALIGN, GEMM_SP2>((LAS unsigned char*)lds, g, S, E);
        }
        SYNC(pb + 3);
        if (l == 0) {
            if (IN(pb + 4)) rmsnorm_rows((const float*)(p.ws + WS_X1), p.in[1] + DM, (bf16_t*)(p.ws + WS_H));
            SYNC(pb + 4);
        }
    }
}

#ifndef COOP
#define COOP 1
#endif
extern "C" void kernel_launch(void* const* d_in, const int* in_sizes, int n_in, void* d_out, int out_size, void* d_ws, size_t ws_size, hipStream_t stream) {
    static int grid = 0;
    if (grid == 0) {
        if (n_in != 24 || ws_size < WS_END + 65536) { fprintf(stderr, "kernel_launch: unexpected n_in %d / ws %zu (need %zu)\n", n_in, ws_size, (size_t)WS_END); grid = -1; return; }
        if (hipFuncSetAttribute((const void*)mega, hipFuncAttributeMaxDynamicSharedMemorySize, LDS_BYTES) != hipSuccess) { fprintf(stderr, "kernel_launch: hipFuncSetAttribute failed\n"); grid = -1; return; }
        int dev = 0, cus = 0, per_cu = 0;
        hipGetDevice(&dev); hipDeviceGetAttribute(&cus, hipDeviceAttributeMultiprocessorCount, dev);
        hipOccupancyMaxActiveBlocksPerMultiprocessor(&per_cu, (const void*)mega, 512, LDS_BYTES);
        if (per_cu < 1) { fprintf(stderr, "kernel_launch: occupancy query says %d blocks/CU\n", per_cu); per_cu = 1; }
        grid = cus * 1;
        (void)hipGetLastError();
    }
    if (grid < 0) return;
    Params p{};
    for (int i = 0; i < 24; ++i) p.in[i] = (const float*)d_in[i];
    p.out = (float*)d_out; p.ws = (unsigned char*)d_ws;
    if (hipMemsetAsync((unsigned char*)d_ws + WS_CTR, 0, WS_CTL_BYTES, stream) != hipSuccess) { fprintf(stderr, "kernel_launch: memset failed\n"); return; }
#if COOP
    p.ph_lo = 0; p.ph_hi = NPH - 1 + 0;
    p.ph_hi = NPH;
    void* args[] = {&p};
    hipError_t e = hipLaunchCooperativeKernel((const void*)mega, dim3(grid), dim3(512), args, LDS_BYTES, stream);
    if (e != hipSuccess) fprintf(stderr, "cooperative launch failed: %s (grid %d)\n", hipGetErrorString(e), grid);
#else
    for (int ph = 0; ph < NPH; ++ph) { p.ph_lo = ph; p.ph_hi = ph + 1; hipLaunchKernelGGL(mega, dim3(grid), dim3(512), LDS_BYTES, stream, p); }
#endif
}
```

```cpp
#include <hip/hip_runtime.h>
#include <hip/hip_cooperative_groups.h>
#include <cstdio>
namespace cg = cooperative_groups;
namespace pg8 {
#define PG8_LAS __attribute__((address_space(3)))
typedef unsigned short bf16_t;
typedef short bf16x8 __attribute__((ext_vector_type(8)));
typedef float f32x4 __attribute__((ext_vector_type(4)));
typedef unsigned u32x4 __attribute__((ext_vector_type(4)));
constexpr int BM = 256, BK = 64, HALF = 128, HTB = HALF * BK * 2  , STAGE_BYTES = 8 * HTB, NXCD = 8, WGM = 4;

__host__ __device__ __forceinline__ int lds_byte(int r, int c) { const int st = (r >> 4) * 2 + (c >> 5), rr = r & 15, cc = c & 31, ob = rr * 64 + cc * 2; return st * 1024 + (ob ^ (((ob >> 9) & 1) << 5)); }
__host__ __device__ __forceinline__ void stage_rc(int b, int& R, int& C) { const int st = b / 1024, sb = b % 1024, swz = sb ^ (((sb >> 9) & 1) << 5); R = (st >> 1) * 16 + swz / 64; C = (st & 1) * 32 + (swz % 64) / 2; }
__host__ __device__ __forceinline__ int perm32(int rho) { const int n = rho >> 4, i = rho & 15; return 8 * (i >> 2) + 4 * n + (i & 3); }

struct Unit { int pm, pn; };
struct Gemm { const bf16_t* A; const bf16_t* Bt; int M, N, K; };

struct StaticOrder {
    int nM, nN, nwg, G, c;
    __host__ __device__ void init(int M, int N, int G_, int c_) { nM = M / BM; nN = N / BM; nwg = nM * nN; G = G_; c = c_; }
    __host__ __device__ bool next(int i, Unit& u) const {
        const long L = (long)i * G + c; if (L >= nwg) return false;
        int wgid = (int)L; { const int q = nwg / NXCD, r = nwg % NXCD, xcd = wgid % NXCD, off = wgid / NXCD; wgid = (xcd < r ? xcd * (q + 1) : r * (q + 1) + (xcd - r) * q) + off; }
        const int nig = WGM * nN, gid = wgid / nig, fm = gid * WGM, gsz = (nM - fm) < WGM ? (nM - fm) : WGM;
        u.pm = fm + ((wgid % nig) % gsz); u.pn = (wgid % nig) / gsz; return true;
    }
    __device__ __forceinline__ void a_ready(const Unit&) const {}
    __device__ __forceinline__ void done(const Unit&) const {}
};
__device__ __forceinline__ unsigned cvt_pk_bf16(float lo, float hi) { unsigned r; asm volatile("v_cvt_pk_bf16_f32 %0, %1, %2" : "=v"(r) : "v"(lo), "v"(hi)); return r; }
typedef float f32x2 __attribute__((ext_vector_type(2)));
template <class Epi, class Sched, bool ALIGN_EPI = false, bool SP2 = false>
__device__ __forceinline__ void gemm_phase(PG8_LAS unsigned char* lds, const Gemm g, const Sched& S, const Epi& E) {
    int tid_ = threadIdx.x; asm volatile("" : "+v"(tid_)); const int tid = tid_, wid = __builtin_amdgcn_readfirstlane(tid >> 6), lane = tid & 63, wr = wid >> 2, wc = wid & 3, fr = lane & 15, fq = lane >> 4;
    const int K = g.K, nt = K / BK;
    unsigned voffA[2], voffB[2];
#pragma unroll
    for (int i = 0; i < 2; ++i) { int R, C; stage_rc(tid * 16 + i * 8192, R, C); const int Rb = Epi::PERM ? ((R & ~31) + perm32(R & 31)) : R;
        voffA[i] = (unsigned)(R * K + C) * 2u; voffB[i] = (unsigned)(Rb * K + C) * 2u; }
    const size_t kstep = (size_t)(BK * 2);
    const size_t hstep = (size_t)HALF * K * 2;
    const size_t tstep = 2 * hstep;
    const unsigned ldsw = (unsigned)wid * 1024u;
    const int aoff = lds_byte(wr * 64 + fr, fq * 8), boff = lds_byte(wc * 32 + fr, fq * 8);
#define PG8_SA(b, h) (((b) * 2 + (h)) * HTB)
#define PG8_SB(b, h) ((4 + (b) * 2 + (h)) * HTB)
#define PG8_STAGE(bufoff, gbase, voff) do { _Pragma("unroll") for (int _i = 0; _i < 2; ++_i) \
        __builtin_amdgcn_global_load_lds((const unsigned*)((const char*)(gbase) + (voff)[_i]), (PG8_LAS unsigned*)(lds + (bufoff) + ldsw + _i * 8192), 16, 0, 0); } while (0)
#define PG8_LDA(dst, b, h) do { _Pragma("unroll") for (int m = 0; m < 4; ++m) _Pragma("unroll") for (int k = 0; k < 2; ++k) dst[m][k] = *(const PG8_LAS bf16x8*)(lds + PG8_SA(b, h) + aoff + m * 2048 + k * 1024); } while (0)
#define PG8_LDB(dst, b, h) do { _Pragma("unroll") for (int n = 0; n < 2; ++n) _Pragma("unroll") for (int k = 0; k < 2; ++k) dst[n][k] = *(const PG8_LAS bf16x8*)(lds + PG8_SB(b, h) + boff + n * 2048 + k * 1024); } while (0)
#define PG8_MMA(ai, bj, At, Bt) do { __builtin_amdgcn_s_setprio(1); _Pragma("unroll") for (int m = 0; m < 4; ++m) _Pragma("unroll") for (int n = 0; n < 2; ++n) _Pragma("unroll") for (int k = 0; k < 2; ++k) \
        acc[ai][bj][m][n] = __builtin_amdgcn_mfma_f32_16x16x32_bf16(Bt[n][k], At[m][k], acc[ai][bj][m][n], 0, 0, 0); __builtin_amdgcn_s_setprio(0); } while (0)
#define PG8_WAIT_V(n) asm volatile("s_waitcnt vmcnt(" #n ")" ::: "memory")
#define PG8_WAIT_L(n) asm volatile("s_waitcnt lgkmcnt(" #n ")" ::: "memory")
#define PG8_BAR __builtin_amdgcn_s_barrier()
#define PG8_SCHED __builtin_amdgcn_sched_barrier(0)
    Unit cur, nxt; int ui = 0;
    if (!S.next(0, cur)) return;
    f32x4 acc[2][2][4][2];
    E.init(acc, cur, wr, wc, fr, fq);
    bf16x8 At[4][2], B0[2][2], B1[2][2];
    const char* cA = (const char*)g.A + (size_t)cur.pm * tstep; const char* cB = (const char*)g.Bt + (size_t)cur.pn * tstep;
    S.a_ready(cur);
    if constexpr (SP2) {
        PG8_STAGE(PG8_SB(0, 0), cB, voffB); PG8_STAGE(PG8_SB(0, 1), cB + hstep, voffB); PG8_STAGE(PG8_SA(0, 0), cA, voffA); PG8_STAGE(PG8_SA(0, 1), cA + hstep, voffA);
        if (wr == 1) PG8_BAR;
        PG8_WAIT_V(2); PG8_BAR;
        PG8_STAGE(PG8_SB(1, 0), cB + kstep, voffB); PG8_STAGE(PG8_SA(1, 0), cA + kstep, voffA); PG8_STAGE(PG8_SB(1, 1), cB + hstep + kstep, voffB);
        PG8_WAIT_V(6); PG8_BAR;
    } else {
        PG8_STAGE(PG8_SB(0, 0), cB, voffB); PG8_STAGE(PG8_SA(0, 0), cA, voffA); PG8_STAGE(PG8_SB(0, 1), cB + hstep, voffB); PG8_STAGE(PG8_SA(0, 1), cA + hstep, voffA);
        if (wr == 1) PG8_BAR;
        PG8_WAIT_V(4); PG8_BAR;
        PG8_STAGE(PG8_SB(1, 0), cB + kstep, voffB); PG8_STAGE(PG8_SA(1, 0), cA + kstep, voffA); PG8_STAGE(PG8_SB(1, 1), cB + hstep + kstep, voffB);
        PG8_WAIT_V(6); PG8_BAR;
    }
    for (;;) {
        const bool has_next = S.next(ui + 1, nxt);
        const char* nA = has_next ? (const char*)g.A + (size_t)nxt.pm * tstep : cA; const char* nB = has_next ? (const char*)g.Bt + (size_t)nxt.pn * tstep : cB;
        for (int t = 0; t < nt; t += 2) {
            const bool last = (t == nt - 2);
            const char* a1 = cA + (size_t)(t + 1) * kstep;
            const char* a2 = last ? nA : cA + (size_t)(t + 2) * kstep; const char* b2 = last ? nB : cB + (size_t)(t + 2) * kstep;
            const char* a3 = a2 + kstep; const char* b3 = b2 + kstep;
            if (last && has_next) S.a_ready(nxt);
            if constexpr (SP2) {
            PG8_LDB(B0, 0, 0); PG8_LDB(B1, 0, 1); PG8_SCHED; PG8_LDA(At, 0, 0); PG8_STAGE(PG8_SA(1, 1), a1 + hstep, voffA);
            PG8_WAIT_V(8); PG8_WAIT_L(0); PG8_BAR; PG8_MMA(0, 0, At, B0); PG8_MMA(0, 1, At, B1); PG8_BAR; PG8_SCHED;
            PG8_LDA(At, 0, 1); PG8_STAGE(PG8_SB(0, 0), b2, voffB); PG8_STAGE(PG8_SB(0, 1), b2 + hstep, voffB); PG8_STAGE(PG8_SA(0, 0), a2, voffA);
            PG8_WAIT_V(8); PG8_WAIT_L(0); PG8_BAR; PG8_MMA(1, 0, At, B0); PG8_MMA(1, 1, At, B1); PG8_BAR; PG8_SCHED;
            PG8_LDB(B0, 1, 0); PG8_LDB(B1, 1, 1); PG8_SCHED; PG8_LDA(At, 1, 0); PG8_STAGE(PG8_SA(0, 1), a2 + hstep, voffA);
            PG8_WAIT_V(8); PG8_WAIT_L(0); PG8_BAR; PG8_MMA(0, 0, At, B0); PG8_MMA(0, 1, At, B1); PG8_BAR; PG8_SCHED;
            PG8_LDA(At, 1, 1); PG8_STAGE(PG8_SB(1, 0), b3, voffB); PG8_STAGE(PG8_SB(1, 1), b3 + hstep, voffB); PG8_STAGE(PG8_SA(1, 0), a3, voffA);
            PG8_WAIT_V(8); PG8_WAIT_L(0); PG8_BAR; PG8_MMA(1, 0, At, B0); PG8_MMA(1, 1, At, B1); PG8_BAR; PG8_SCHED;
            } else {
            PG8_LDB(B0, 0, 0); PG8_SCHED; PG8_LDA(At, 0, 0); PG8_STAGE(PG8_SA(1, 1), a1 + hstep, voffA);
            PG8_WAIT_L(8); PG8_BAR; PG8_WAIT_L(0); PG8_MMA(0, 0, At, B0); PG8_BAR; PG8_SCHED;
            PG8_LDB(B1, 0, 1); PG8_STAGE(PG8_SB(0, 0), b2, voffB);
            PG8_BAR; PG8_WAIT_L(0); PG8_MMA(0, 1, At, B1); PG8_BAR;
            PG8_LDA(At, 0, 1); PG8_STAGE(PG8_SA(0, 0), a2, voffA);
            PG8_BAR; PG8_WAIT_L(0); PG8_MMA(1, 0, At, B0); PG8_BAR; PG8_SCHED;
            PG8_STAGE(PG8_SB(0, 1), b2 + hstep, voffB);
            PG8_WAIT_V(6); PG8_BAR; PG8_MMA(1, 1, At, B1); PG8_BAR;
            PG8_LDB(B0, 1, 0); PG8_SCHED; PG8_LDA(At, 1, 0); PG8_STAGE(PG8_SA(0, 1), a2 + hstep, voffA);
            PG8_WAIT_L(8); PG8_BAR; PG8_WAIT_L(0); PG8_MMA(0, 0, At, B0); PG8_BAR; PG8_SCHED;
            PG8_LDB(B1, 1, 1); PG8_STAGE(PG8_SB(1, 0), b3, voffB);
            PG8_BAR; PG8_WAIT_L(0); PG8_MMA(0, 1, At, B1); PG8_BAR;
            PG8_LDA(At, 1, 1); PG8_STAGE(PG8_SA(1, 0), a3, voffA);
            PG8_BAR; PG8_WAIT_L(0); PG8_MMA(1, 0, At, B0); PG8_BAR; PG8_SCHED;
            PG8_STAGE(PG8_SB(1, 1), b3 + hstep, voffB);
            PG8_WAIT_V(6); PG8_BAR; PG8_MMA(1, 1, At, B1); PG8_BAR;
            }
        }
        if constexpr (ALIGN_EPI) { if (wr == 0) PG8_BAR; }
        if constexpr (!Epi::AFTER_DRAIN) { E(acc, cur, wr, wc, fr, fq); S.done(cur); }
        if (!has_next) break;
        E.init(acc, nxt, wr, wc, fr, fq);
        cur = nxt; cA = nA; cB = nB; ++ui;
        if constexpr (ALIGN_EPI) { if (wr == 1) PG8_BAR; }
    }
    PG8_WAIT_V(0);
    if constexpr (!ALIGN_EPI) { if (wr == 0) PG8_BAR; }
    PG8_BAR;
    if constexpr (Epi::AFTER_DRAIN) { E.fused(acc, cur, wr, wc, fr, fq, lds, wid, lane); S.done(cur); }
#undef PG8_SA
#undef PG8_SB
#undef PG8_STAGE
#undef PG8_LDA
#undef PG8_LDB
#undef PG8_MMA
#undef PG8_WAIT_V
#undef PG8_WAIT_L
#undef PG8_BAR
#undef PG8_SCHED
}
}

#define LAS __attribute__((address_space(3)))
typedef unsigned short bf16_t;
typedef float f32x4 __attribute__((ext_vector_type(4)));
typedef unsigned u32x4 __attribute__((ext_vector_type(4)));
constexpr int TOK = 8192, SEQ = 2048, DM = 4096, NIN = 11792, NPAD = 12032;
constexpr int C_GQ = 0, C_GK = 512, C_GV = 1024, C_SQ = 2048, C_SK = 3072, C_SV = 3328, C_DQ = 3584, C_DK = 4608, C_DV = 5632, C_RX = 6656, C_GATE = 7680, C_GA = 11776;
constexpr float EPS = 1e-6f;
constexpr int LDS_BYTES = 152 * 1024;
constexpr int NPH = 10;
constexpr int XCD_BAR_WORDS_C = 3456;
constexpr size_t WS_WIN = 0;
constexpr size_t SZ_WIN = (size_t)NPAD * DM * 2;
constexpr size_t WS_WOUT = WS_WIN + 2 * SZ_WIN;
constexpr size_t SZ_WOUT = (size_t)DM * DM * 2;
constexpr size_t WS_H = WS_WOUT + 2 * SZ_WOUT;
constexpr size_t WS_PROJ = WS_H + (size_t)TOK * DM * 2;
constexpr size_t WS_Y = WS_PROJ + (size_t)TOK * NPAD * 2;
constexpr size_t WS_X1 = WS_Y + (size_t)TOK * DM * 2;
constexpr size_t WS_LA = WS_X1 + (size_t)TOK * DM * 4;
constexpr size_t WS_LU = WS_LA + (size_t)TOK * 1024 * 4;
constexpr size_t WS_GP = WS_LU + (size_t)TOK * 1024 * 4;
constexpr size_t WS_END = WS_GP + (size_t)1024 * 41216;

struct Params { const float* in[24]; float* out; unsigned char* ws; int ph_lo, ph_hi; };

__device__ __forceinline__ int tid_opaque() { int t = threadIdx.x; asm volatile("" : "+v"(t)); return t; }
__device__ __forceinline__ float bf2f(bf16_t b) { return __uint_as_float(((unsigned)b) << 16); }
typedef __bf16 bf16v2_t __attribute__((ext_vector_type(2)));
typedef float f32v2_t __attribute__((ext_vector_type(2)));
__device__ __forceinline__ unsigned cvt2(float lo, float hi) { f32v2_t f = {lo, hi}; bf16v2_t b = __builtin_convertvector(f, bf16v2_t); return __builtin_bit_cast(unsigned, b); }
__device__ __forceinline__ bf16_t f2bf(float f) { return (bf16_t)(cvt2(f, f) & 0xffffu); }
__device__ __forceinline__ unsigned pk2(float lo, float hi) { return cvt2(lo, hi); }
__device__ __forceinline__ float wsum(float v) { for (int o = 32; o; o >>= 1) v += __shfl_xor(v, o); return v; }
__device__ __forceinline__ float wmax(float v) { for (int o = 32; o; o >>= 1) v = fmaxf(v, __shfl_xor(v, o)); return v; }
__device__ __forceinline__ float siluf(float x) { return x / (1.f + __expf(-x)); }
__device__ __forceinline__ float sigmf(float x) { return 1.f / (1.f + __expf(-x)); }
__device__ __forceinline__ void unpack8(const uint4 u, float* f) {
    f[0] = __uint_as_float(u.x << 16); f[1] = __uint_as_float(u.x & 0xffff0000u); f[2] = __uint_as_float(u.y << 16); f[3] = __uint_as_float(u.y & 0xffff0000u);
    f[4] = __uint_as_float(u.z << 16); f[5] = __uint_as_float(u.z & 0xffff0000u); f[6] = __uint_as_float(u.w << 16); f[7] = __uint_as_float(u.w & 0xffff0000u);
}

struct EpiProj {
    static constexpr bool PERM = true, AFTER_DRAIN = false;
    bf16_t* O;
    __device__ __forceinline__ void init(f32x4 (&acc)[2][2][4][2], const pg8::Unit&, int, int, int, int) const {
#pragma unroll
        for (int a = 0; a < 2; ++a)
#pragma unroll
            for (int b = 0; b < 2; ++b)
#pragma unroll
                for (int m = 0; m < 4; ++m)
#pragma unroll
                    for (int n = 0; n < 2; ++n) acc[a][b][m][n] = (f32x4){0.f, 0.f, 0.f, 0.f};
    }
    __device__ __forceinline__ void operator()(const f32x4 (&acc)[2][2][4][2], const pg8::Unit& u, int wr, int wc, int fr, int fq) const {
        const int row0 = u.pm * 256 + wr * 64 + fr, col0 = u.pn * 256 + wc * 32 + 8 * fq;
        const bool act = (u.pn >= 30 && u.pn < 46);
#pragma unroll
        for (int ai = 0; ai < 2; ++ai)
#pragma unroll
            for (int m = 0; m < 4; ++m) { bf16_t* rowp = O + (size_t)(row0 + ai * 128 + m * 16) * NPAD + col0;
#pragma unroll
                for (int bj = 0; bj < 2; ++bj) { f32x4 v0 = acc[ai][bj][m][0], v1 = acc[ai][bj][m][1];
                    if (act) {
#pragma unroll
                        for (int j = 0; j < 4; ++j) { v0[j] = v0[j] * __builtin_amdgcn_rcpf(1.f + __builtin_amdgcn_exp2f(-1.4426950408889634f * v0[j])); v1[j] = v1[j] * __builtin_amdgcn_rcpf(1.f + __builtin_amdgcn_exp2f(-1.4426950408889634f * v1[j])); } }
                    u32x4 w; w.x = pg8::cvt_pk_bf16(v0[0], v0[1]); w.y = pg8::cvt_pk_bf16(v0[2], v0[3]); w.z = pg8::cvt_pk_bf16(v1[0], v1[1]); w.w = pg8::cvt_pk_bf16(v1[2], v1[3]);
                    *(u32x4*)(rowp + bj * 128) = w; } }
    }
};
struct EpiRes {
    static constexpr bool PERM = false, AFTER_DRAIN = false;
    const float* R; float* C;
    __device__ __forceinline__ void init(f32x4 (&acc)[2][2][4][2], const pg8::Unit& u, int wr, int wc, int fr, int fq) const {
        const int row0 = u.pm * 256 + wr * 64 + fr, col0 = u.pn * 256 + wc * 32 + 4 * fq;
#pragma unroll
        for (int ai = 0; ai < 2; ++ai)
#pragma unroll
            for (int m = 0; m < 4; ++m) { const size_t off = (size_t)(row0 + ai * 128 + m * 16) * DM + col0;
#pragma unroll
                for (int bj = 0; bj < 2; ++bj)
#pragma unroll
                    for (int n = 0; n < 2; ++n) acc[ai][bj][m][n] = *(const f32x4*)(R + off + bj * 128 + n * 16); }
    }
    __device__ __forceinline__ void operator()(const f32x4 (&acc)[2][2][4][2], const pg8::Unit& u, int wr, int wc, int fr, int fq) const {
        const int row0 = u.pm * 256 + wr * 64 + fr, col0 = u.pn * 256 + wc * 32 + 4 * fq;
#pragma unroll
        for (int ai = 0; ai < 2; ++ai)
#pragma unroll
            for (int m = 0; m < 4; ++m) { const size_t off = (size_t)(row0 + ai * 128 + m * 16) * DM + col0;
#pragma unroll
                for (int bj = 0; bj < 2; ++bj)
#pragma unroll
                    for (int n = 0; n < 2; ++n) *(f32x4*)(C + off + bj * 128 + n * 16) = acc[ai][bj][m][n]; }
    }
};

constexpr int NDEF = 1536;
constexpr int HOST0 = 1024;
constexpr int PREP_TILES = 6016;
constexpr int DHOST_WIN = 6016 - HOST0, DHOST = DHOST_WIN + 2048 - NDEF;
struct TrTile { const float* W; bf16_t* WT; int ld, nt, kt; bool permute; };
__device__ __forceinline__ TrTile tr_tile(const Params& p, int t) {
    TrTile r; int q = t; const int l = 0;
    r.W = p.in[2] + (size_t)l * DM * NIN; r.WT = (bf16_t*)(p.ws + WS_WIN + l * SZ_WIN); r.ld = NIN; r.permute = true;
    r.nt = q >> 5; r.kt = q & 31; return r;
}
__device__ __forceinline__ void tr_load(const TrTile& T, int tid, f32x4 (&v)[4]) {
#pragma unroll
    for (int i = 0; i < 2; ++i) {
        const int idx = tid + 512 * i, kp = idx >> 4, c4 = idx & 15;
        const int nd = T.nt * 64 + c4 * 4;
        int ns = nd;
        if (T.permute) { ns = (nd < 2048) ? nd : ((nd < 11776) ? nd + 16 : ((nd < 11792) ? nd - 11776 + 2048 : -1)); }
        v[2 * i] = (f32x4){0.f, 0.f, 0.f, 0.f}; v[2 * i + 1] = v[2 * i];
        if (ns >= 0) { const float* q = T.W + (size_t)(T.kt * 128 + 2 * kp) * T.ld + ns; v[2 * i] = __builtin_nontemporal_load((const f32x4*)q); v[2 * i + 1] = __builtin_nontemporal_load((const f32x4*)(q + T.ld)); }
    }
}
__device__ __forceinline__ void tr_stage(int tid, const f32x4 (&v)[4], unsigned* lds) {
#pragma unroll
    for (int i = 0; i < 2; ++i) {
        const int idx = tid + 512 * i, kp = idx >> 4, c4 = idx & 15;
        const f32x4 a = v[2 * i], b = v[2 * i + 1];
        unsigned* d = lds + kp * 65 + c4 * 4;
        d[0] = pk2(a[0], b[0]); d[1] = pk2(a[1], b[1]); d[2] = pk2(a[2], b[2]); d[3] = pk2(a[3], b[3]);
    }
}
__device__ __forceinline__ void tr_flush(const TrTile& T, int tid, const unsigned* lds) {
#pragma unroll
    for (int i = 0; i < 2; ++i) {
        const int idx = tid + 512 * i, kc = idx & 15, n = idx >> 4;
        uint4 o; o.x = lds[(kc * 4 + 0) * 65 + n]; o.y = lds[(kc * 4 + 1) * 65 + n]; o.z = lds[(kc * 4 + 2) * 65 + n]; o.w = lds[(kc * 4 + 3) * 65 + n];
        *(uint4*)(T.WT + (size_t)(T.nt * 64 + n) * DM + T.kt * 128 + kc * 8) = o;
    }
}
__device__ __forceinline__ void tr_store(const TrTile& T, int tid, const f32x4 (&v)[4], unsigned* lds) {
#pragma unroll
    for (int i = 0; i < 2; ++i) {
        const int idx = tid + 512 * i, kp = idx >> 4, c4 = idx & 15;
        const f32x4 a = v[2 * i], b = v[2 * i + 1];
        unsigned* d = lds + kp * 65 + c4 * 4;
        d[0] = pk2(a[0], b[0]); d[1] = pk2(a[1], b[1]); d[2] = pk2(a[2], b[2]); d[3] = pk2(a[3], b[3]);
    }
    __syncthreads();
#pragma unroll
    for (int i = 0; i < 2; ++i) {
        const int idx = tid + 512 * i, kc = idx & 15, n = idx >> 4;
        uint4 o; o.x = lds[(kc * 4 + 0) * 65 + n]; o.y = lds[(kc * 4 + 1) * 65 + n]; o.z = lds[(kc * 4 + 2) * 65 + n]; o.w = lds[(kc * 4 + 3) * 65 + n];
        *(uint4*)(T.WT + (size_t)(T.nt * 64 + n) * DM + T.kt * 128 + kc * 8) = o;
    }
    __syncthreads();
}

__device__ __forceinline__ void rmsnorm_rows(const float* __restrict__ X, const float* __restrict__ w, bf16_t* __restrict__ H) {
    const int tid = tid_opaque(), lane = tid & 63, wave = tid >> 6;
    for (int row = blockIdx.x * 8 + wave; row < TOK; row += gridDim.x * 8) {
        const float4* xp = (const float4*)(X + (size_t)row * DM);
        float4 v[16]; float ss = 0.f;
#pragma unroll
        for (int i = 0; i < 16; ++i) { v[i] = xp[lane + 64 * i]; ss += v[i].x * v[i].x + v[i].y * v[i].y + v[i].z * v[i].z + v[i].w * v[i].w; }
        ss = wsum(ss);
        const float rstd = rsqrtf(ss * (1.f / DM) + EPS);
#pragma unroll
        for (int i = 0; i < 16; ++i) { const float4 g = ((const float4*)w)[lane + 64 * i];
            uint2 o; o.x = pk2(v[i].x * rstd * g.x, v[i].y * rstd * g.y); o.y = pk2(v[i].z * rstd * g.z, v[i].w * rstd * g.w);
            *(uint2*)(H + (size_t)row * DM + 4 * (lane + 64 * i)) = o; }
    }
}

__device__ __forceinline__ void phase_prep(const Params& p, unsigned char* lds) {
    const bool rows_first = (blockIdx.x & 1) != 0;
    if (rows_first) rmsnorm_rows(p.in[0], p.in[1], (bf16_t*)(p.ws + WS_H));
    { const int tid = tid_opaque();
      f32x4 va[4], vb[4];
      int t = blockIdx.x;
      TrTile T = tr_tile(p, t < PREP_TILES ? t : 0);
      if (t < PREP_TILES) tr_load(T, tid, va);
#pragma unroll 1
      while (t < PREP_TILES) {
          const int tn = t + gridDim.x;
          const TrTile Tn = tr_tile(p, tn < PREP_TILES ? tn : 0);
          if (tn < PREP_TILES) tr_load(Tn, tid, vb);
          tr_store(T, tid, va, (unsigned*)lds);
#pragma unroll
          for (int i = 0; i < 4; ++i) va[i] = vb[i];
          T = Tn; t = tn;
      } }
    if (!rows_first) rmsnorm_rows(p.in[0], p.in[1], (bf16_t*)(p.ws + WS_H));
}

__device__ __forceinline__ bool host_tile(const Params& p, int l, int hidx, TrTile& T) {
    if (l == 0) { if (hidx >= HOST0) return false;
        T.W = p.in[2] + (size_t)DM * NIN; T.WT = (bf16_t*)(p.ws + WS_WIN + SZ_WIN); T.ld = NIN; T.permute = true; T.nt = hidx >> 5; T.kt = hidx & 31; return true; }
    const int r = NDEF + hidx; if (r >= 2048) return false;
    T.W = p.in[3] + (size_t)DM * DM; T.WT = (bf16_t*)(p.ws + WS_WOUT + SZ_WOUT); T.ld = DM; T.permute = false; T.nt = r >> 5; T.kt = r & 31; return true;
}
__device__ __forceinline__ bool diff_host_tile(const Params& p, int l, int s, TrTile& T) {
    if (l != 0 || s >= DHOST) return false;
    if (s < DHOST_WIN) { const int q = HOST0 + s; T.W = p.in[2] + (size_t)DM * NIN; T.WT = (bf16_t*)(p.ws + WS_WIN + SZ_WIN); T.ld = NIN; T.permute = true; T.nt = q >> 5; T.kt = q & 31; return true; }
    const int r = NDEF + (s - DHOST_WIN); T.W = p.in[3]; T.WT = (bf16_t*)(p.ws + WS_WOUT); T.ld = DM; T.permute = false; T.nt = r >> 5; T.kt = r & 31; return true;
}
__device__ __forceinline__ TrTile tr_tile_wout(const Params& p, int l, int r) {
    TrTile T; T.W = p.in[3] + (size_t)l * DM * DM; T.WT = (bf16_t*)(p.ws + WS_WOUT + l * SZ_WOUT); T.ld = DM; T.permute = false; T.nt = r >> 5; T.kt = r & 31; return T;
}
__device__ __forceinline__ void convert_deferred(const Params& p, int l, int rank, int nidle, unsigned char* lds) {
    const int tid = tid_opaque();
    f32x4 va[4], vb[4];
    int r = rank;
    TrTile T = tr_tile_wout(p, l, r < NDEF ? r : 0);
    if (r < NDEF) tr_load(T, tid, va);
#pragma unroll 1
    while (r < NDEF) {
        const int rn = r + nidle;
        const TrTile Tn = tr_tile_wout(p, l, rn < NDEF ? rn : 0);
        if (rn < NDEF) tr_load(Tn, tid, vb);
        tr_store(T, tid, va, (unsigned*)lds);
#pragma unroll
        for (int i = 0; i < 4; ++i) va[i] = vb[i];
        T = Tn; r = rn;
    }
}

struct LayerW {
    const float *gla_w_up, *gla_b_up, *gla_nw, *swa_qn, *swa_kn, *swa_sinks, *dq_n, *dk_n, *lq1, *lk1, *lq2, *lk2, *d_on, *conv_w, *conv_b, *w_r, *b_r, *w_i, *b_i, *lam;
    float lambda_init;
};
__device__ __forceinline__ LayerW layer_w(const Params& p, int l) {
    LayerW w;
    w.gla_w_up = p.in[4] + l * 16 * 512; w.gla_b_up = p.in[5] + l * 512; w.gla_nw = p.in[6] + l * 128;
    w.swa_qn = p.in[7] + l * 128; w.swa_kn = p.in[8] + l * 128; w.swa_sinks = p.in[9] + l * 8;
    w.dq_n = p.in[10] + l * 64; w.dk_n = p.in[11] + l * 64; w.lq1 = p.in[12] + l * 64; w.lk1 = p.in[13] + l * 64; w.lq2 = p.in[14] + l * 64; w.lk2 = p.in[15] + l * 64;
    w.d_on = p.in[16] + l * 128; w.conv_w = p.in[17] + l * 4096; w.conv_b = p.in[18] + l * 1024;
    w.w_r = p.in[19] + l * 8 * 128 * 128; w.b_r = p.in[20] + l * 1024; w.w_i = p.in[21] + l * 8 * 128 * 128; w.b_i = p.in[22] + l * 1024; w.lam = p.in[23] + l * 1024;
    w.lambda_init = 0.8f - 0.6f * expf(-0.3f * (float)l);
    return w;
}

__device__ void gla_simple(const bf16_t* __restrict__ P, bf16_t* __restrict__ Y, const LayerW& W, int bh, float* lds) {
    const int b = bh >> 3, h = bh & 7, tid = tid_opaque();
    float* sAl = lds; float* sQ = sAl + 2048; float* sK = sQ + 2048; float* sV = sK + 2048; float* sPo = sV + 4096; float* sW = sPo + 16384;
    __syncthreads();
    for (int i = tid; i < 1024; i += 512) sW[i] = W.gla_w_up[(i >> 6) * 512 + h * 64 + (i & 63)];
    if (tid < 64) sW[1024 + tid] = W.gla_b_up[h * 64 + tid];
    const int v = tid & 127, dg = tid >> 7;
    float s[16];
#pragma unroll
    for (int i = 0; i < 16; ++i) s[i] = 0.f;
    for (int c = 0; c < 64; ++c) {
        __syncthreads();
        const int tok0 = b * SEQ + c * 32;
        for (int i = tid; i < 2048; i += 512) { const int tt = i >> 6, d = i & 63; const bf16_t* row = P + (size_t)(tok0 + tt) * NPAD;
            float lg = sW[1024 + d];
#pragma unroll
            for (int r = 0; r < 16; ++r) lg += bf2f(row[C_GA + r]) * sW[r * 64 + d];
            const float ls = fminf(lg, 0.f) - log1pf(expf(-fabsf(lg)));
            sAl[i] = expf(ls * (1.f / 16.f));
            sQ[i] = bf2f(row[C_GQ + h * 64 + d]) * 0.125f;
            sK[i] = bf2f(row[C_GK + h * 64 + d]); }
        for (int i = tid; i < 4096; i += 512) { const int tt = i >> 7, vv = i & 127; sV[i] = bf2f(P[(size_t)(tok0 + tt) * NPAD + C_GV + h * 128 + vv]); }
        __syncthreads();
        for (int tt = 0; tt < 32; ++tt) {
            const float vt = sV[tt * 128 + v]; float po = 0.f;
#pragma unroll
            for (int i = 0; i < 16; ++i) { const int d = dg * 16 + i; s[i] = sAl[tt * 64 + d] * s[i] + sK[tt * 64 + d] * vt; po += sQ[tt * 64 + d] * s[i]; }
            sPo[(dg * 32 + tt) * 128 + v] = po;
        }
        __syncthreads();
        { const int tt = tid >> 4, v0 = (tid & 15) * 8; float o[8]; float ss = 0.f;
#pragma unroll
            for (int j = 0; j < 8; ++j) { o[j] = sPo[(0 * 32 + tt) * 128 + v0 + j] + sPo[(1 * 32 + tt) * 128 + v0 + j] + sPo[(2 * 32 + tt) * 128 + v0 + j] + sPo[(3 * 32 + tt) * 128 + v0 + j]; ss += o[j] * o[j]; }
            ss += __shfl_xor(ss, 1); ss += __shfl_xor(ss, 2); ss += __shfl_xor(ss, 4); ss += __shfl_xor(ss, 8);
            const float rstd = rsqrtf(ss * (1.f / 128.f) + EPS);
            const bf16_t* gp = P + (size_t)(tok0 + tt) * NPAD + C_GATE + h * 128 + v0;
            bf16_t* yp = Y + (size_t)(tok0 + tt) * DM + h * 128 + v0;
#pragma unroll
            for (int j = 0; j < 8; ++j) yp[j] = f2bf(o[j] * rstd * W.gla_nw[v0 + j] * bf2f(gp[j])); }
    }
    __syncthreads();
}

__device__ void swa_simple_row(const bf16_t* __restrict__ P, bf16_t* __restrict__ Y, const LayerW& W, int row, float* wl) {
    const int lane = tid_opaque() & 63;
    const int bh = row & 31, b = bh >> 3, hq = bh & 7, q = row >> 5, kvh = hq >> 2;
    const size_t tok = (size_t)b * SEQ + q;
    const bf16_t* qp = P + tok * NPAD + C_SQ + hq * 128;
    const float q0 = bf2f(qp[2 * lane]), q1 = bf2f(qp[2 * lane + 1]);
    const float rq = rsqrtf(wsum(q0 * q0 + q1 * q1) * (1.f / 128.f) + EPS) * 0.08838834764831845f;
    __threadfence_block();
    wl[2 * lane] = q0 * rq * W.swa_qn[2 * lane] * W.swa_kn[2 * lane];
    wl[2 * lane + 1] = q1 * rq * W.swa_qn[2 * lane + 1] * W.swa_kn[2 * lane + 1];
    __threadfence_block();
    const float slope = exp2f(-(float)(hq + 1)), sink = W.swa_sinks[hq];
    float sc[2];
#pragma unroll
    for (int i = 0; i < 2; ++i) {
        const int j = q - 127 + lane + 64 * i;
        sc[i] = -INFINITY;
        if (j >= 0) { const uint4* kp = (const uint4*)(P + ((size_t)b * SEQ + j) * NPAD + C_SK + kvh * 128);
            float dot = 0.f, ssk = 0.f;
            for (int c = 0; c < 16; ++c) { float f[8]; unpack8(kp[c], f);
#pragma unroll
                for (int e = 0; e < 8; ++e) { dot += wl[c * 8 + e] * f[e]; ssk += f[e] * f[e]; } }
            sc[i] = dot * rsqrtf(ssk * (1.f / 128.f) + EPS) - slope * (float)(q - j); }
    }
    const float m = fmaxf(wmax(fmaxf(sc[0], sc[1])), sink);
    const float p0 = (sc[0] == -INFINITY) ? 0.f : __expf(sc[0] - m), p1 = (sc[1] == -INFINITY) ? 0.f : __expf(sc[1] - m);
    const float inv = 1.f / (wsum(p0 + p1) + __expf(sink - m));
    wl[128 + lane] = p0 * inv; wl[192 + lane] = p1 * inv;
    __threadfence_block();
    float o0 = 0.f, o1 = 0.f;
    for (int jj = 0; jj < 128; ++jj) { const int j = q - 127 + jj; if (j < 0) continue;
        const unsigned vv = *(const unsigned*)(P + ((size_t)b * SEQ + j) * NPAD + C_SV + kvh * 128 + 2 * lane);
        const float pj = wl[128 + jj]; o0 += pj * __uint_as_float(vv << 16); o1 += pj * __uint_as_float(vv & 0xffff0000u); }
    const unsigned gg = *(const unsigned*)(P + tok * NPAD + C_GATE + 1024 + hq * 128 + 2 * lane);
    *(unsigned*)(Y + tok * DM + 1024 + hq * 128 + 2 * lane) = pk2(o0 * __uint_as_float(gg << 16), o1 * __uint_as_float(gg & 0xffff0000u));
    __threadfence_block();
}

__device__ void diff_simple_row(const bf16_t* __restrict__ P, bf16_t* __restrict__ Y, const LayerW& W, float lam, int row, float* wl) {
    const int lane = tid_opaque() & 63;
    const int bh = row & 31, b = bh >> 3, h = bh & 7, q = row >> 5;
    const size_t tok = (size_t)b * SEQ + q;
    const bf16_t* qp = P + tok * NPAD + C_DQ + h * 128;
    const float x0 = bf2f(qp[lane]), x1 = bf2f(qp[64 + lane]);
    const float r0 = rsqrtf(wsum(x0 * x0) * (1.f / 64.f) + EPS) * 0.125f, r1 = rsqrtf(wsum(x1 * x1) * (1.f / 64.f) + EPS) * 0.125f;
    __threadfence_block();
    wl[lane] = x0 * r0 * W.dq_n[lane] * W.dk_n[lane]; wl[64 + lane] = x1 * r1 * W.dq_n[lane] * W.dk_n[lane];
    __threadfence_block();
    float* S0 = wl + 128; float* S1 = S0 + 2048;
    const float slope = exp2f(-(float)(h + 1));
    const int nk = q + 1;
    float m0 = -INFINITY, m1 = -INFINITY;
    for (int j = lane; j < nk; j += 64) {
        const uint4* kp = (const uint4*)(P + ((size_t)b * SEQ + j) * NPAD + C_DK + h * 128);
        float d0 = 0.f, k0 = 0.f, d1 = 0.f, k1 = 0.f;
        for (int c = 0; c < 8; ++c) { float f[8]; unpack8(kp[c], f);
#pragma unroll
            for (int e = 0; e < 8; ++e) { d0 += wl[c * 8 + e] * f[e]; k0 += f[e] * f[e]; } }
        for (int c = 0; c < 8; ++c) { float f[8]; unpack8(kp[8 + c], f);
#pragma unroll
            for (int e = 0; e < 8; ++e) { d1 += wl[64 + c * 8 + e] * f[e]; k1 += f[e] * f[e]; } }
        const float al = slope * (float)(q - j);
        const float s0 = d0 * rsqrtf(k0 * (1.f / 64.f) + EPS) - al, s1 = d1 * rsqrtf(k1 * (1.f / 64.f) + EPS) - al;
        S0[j] = s0; S1[j] = s1; m0 = fmaxf(m0, s0); m1 = fmaxf(m1, s1);
    }
    m0 = wmax(m0); m1 = wmax(m1);
    float l0 = 0.f, l1 = 0.f;
    for (int j = lane; j < nk; j += 64) { l0 += __expf(S0[j] - m0); l1 += __expf(S1[j] - m1); }
    l0 = 1.f / wsum(l0); l1 = lam / wsum(l1);
    for (int j = lane; j < nk; j += 64) S0[j] = __expf(S0[j] - m0) * l0 - __expf(S1[j] - m1) * l1;
    __threadfence_block();
    float o0 = 0.f, o1 = 0.f;
    const bf16_t* vp = P + (size_t)b * SEQ * NPAD + C_DV + h * 128 + 2 * lane;
    for (int j = 0; j < nk; ++j) { const unsigned vv = *(const unsigned*)(vp + (size_t)j * NPAD); const float wj = S0[j];
        o0 += wj * __uint_as_float(vv << 16); o1 += wj * __uint_as_float(vv & 0xffff0000u); }
    const float rstd = rsqrtf(wsum(o0 * o0 + o1 * o1) * (1.f / 128.f) + EPS) * (1.f - W.lambda_init);
    const unsigned gg = *(const unsigned*)(P + tok * NPAD + C_GATE + 2048 + h * 128 + 2 * lane);
    *(unsigned*)(Y + tok * DM + 2048 + h * 128 + 2 * lane) = pk2(o0 * rstd * W.d_on[2 * lane] * __uint_as_float(gg << 16), o1 * rstd * W.d_on[2 * lane + 1] * __uint_as_float(gg & 0xffff0000u));
    __threadfence_block();
}

__device__ void lru_gates_simple(const bf16_t* __restrict__ P, float* __restrict__ LA, float* __restrict__ LU, const LayerW& W, int unit, float* sXc) {
    const int tid = tid_opaque(), tg = unit >> 3, n = unit & 7, tok0 = tg * 16, t0 = tok0 & (SEQ - 1);
    __syncthreads();
#pragma unroll
    for (int e = 0; e < 4; ++e) { const int i = tid + 512 * e, tt = i >> 7, c = i & 127, ch = n * 128 + c;
        float xc = W.conv_b[ch];
#pragma unroll
        for (int w = 0; w < 4; ++w) { const int tp = t0 + tt - 3 + w; if (tp >= 0) xc += W.conv_w[w * 1024 + ch] * bf2f(P[(size_t)(tok0 + tt - 3 + w) * NPAD + C_RX + ch]); }
        sXc[i] = xc; }
    __syncthreads();
    const int tt = tid >> 5, jg = tid & 31, ch0 = n * 128 + jg * 4;
    float4 r = *(const float4*)(W.b_r + ch0), g = *(const float4*)(W.b_i + ch0);
    const float* wr = W.w_r + (size_t)n * 16384 + jg * 4; const float* wi = W.w_i + (size_t)n * 16384 + jg * 4;
    for (int i = 0; i < 128; ++i) { const float x = sXc[tt * 128 + i]; const float4 a = *(const float4*)(wr + i * 128), c = *(const float4*)(wi + i * 128);
        r.x += x * a.x; r.y += x * a.y; r.z += x * a.z; r.w += x * a.w; g.x += x * c.x; g.y += x * c.y; g.z += x * c.z; g.w += x * c.w; }
    float rr[4] = {r.x, r.y, r.z, r.w}, gg[4] = {g.x, g.y, g.z, g.w}, av[4], uv[4];
#pragma unroll
    for (int e = 0; e < 4; ++e) { const float x = -W.lam[ch0 + e]; const float sp = (x > 20.f) ? x : log1pf(expf(x));
        const float la = -8.f * sigmf(rr[e]) * sp; av[e] = expf(la); uv[e] = sqrtf(-expm1f(2.f * la)) * sigmf(gg[e]) * sXc[tt * 128 + jg * 4 + e]; }
    *(float4*)(LA + (size_t)(tok0 + tt) * 1024 + ch0) = make_float4(av[0], av[1], av[2], av[3]);
    *(float4*)(LU + (size_t)(tok0 + tt) * 1024 + ch0) = make_float4(uv[0], uv[1], uv[2], uv[3]);
}

__device__ void lru_scan_simple(const bf16_t* __restrict__ P, bf16_t* __restrict__ Y, const float* __restrict__ LA, const float* __restrict__ LU) {
    const int tid = tid_opaque();
    if (blockIdx.x >= 64 || tid >= 64) return;
    const int gid = blockIdx.x * 64 + tid, b = gid >> 10, ch = gid & 1023;
    float h = 0.f;
    for (int t = 0; t < SEQ; t += 8) {
        float a[8], u[8], g[8];
#pragma unroll
        for (int e = 0; e < 8; ++e) { const size_t tok = (size_t)b * SEQ + t + e; a[e] = LA[tok * 1024 + ch]; u[e] = LU[tok * 1024 + ch]; g[e] = bf2f(P[tok * NPAD + C_GATE + 3072 + ch]); }
#pragma unroll
        for (int e = 0; e < 8; ++e) { h = a[e] * h + u[e]; Y[((size_t)b * SEQ + t + e) * DM + 3072 + ch] = f2bf(h * g[e]); }
    }
}

__device__ __forceinline__ float diff_lambda(const LayerW& W) {
    float a = 0.f, b = 0.f;
    for (int i = 0; i < 64; ++i) { a += W.lq1[i] * W.lk1[i]; b += W.lq2[i] * W.lk2[i]; }
    return expf(a) - expf(b) + W.lambda_init;
}


typedef short bf16x8 __attribute__((ext_vector_type(8)));
typedef short s16x4 __attribute__((ext_vector_type(4)));
typedef float f32x16 __attribute__((ext_vector_type(16)));
#define MFMA32(a, b, c) __builtin_amdgcn_mfma_f32_32x32x16_bf16((a), (b), (c), 0, 0, 0)
constexpr float LOG2E = 1.4426950408889634f;
__device__ __forceinline__ int crow(int r, int h) { return (r & 3) + 8 * (r >> 2) + 4 * h; }
__device__ __forceinline__ bf16x8 pack8(const float* f) { u32x4 u; u.x = cvt2(f[0], f[1]); u.y = cvt2(f[2], f[3]); u.z = cvt2(f[4], f[5]); u.w = cvt2(f[6], f[7]); return __builtin_bit_cast(bf16x8, u); }

template <bool SWA> struct AttnCfg {
    static constexpr int DQK = SWA ? 128 : 64, NKS = DQK / 16;
    static constexpr int KP = DQK + 8;
    static constexpr int KMAPS = SWA ? 1 : 2;
    static constexpr int KBYTES = KMAPS * 64 * KP * 2;
    static constexpr int VP = 72;
    static constexpr int VBYTES = 128 * VP * 2;
    static constexpr int ABUF = KBYTES + VBYTES;
};

template <bool SWA>
__device__ __forceinline__ void attn_item(const bf16_t* __restrict__ P, bf16_t* __restrict__ Y, const LayerW& W, float lam, int item, unsigned char* lds) {
    typedef AttnCfg<SWA> C;
    const int tid = tid_opaque(), lane = tid & 63, wave = tid >> 6, c = wave & 1, g = wave >> 1, l31 = lane & 31, hh = lane >> 5;
    int b, qb, hk  , hq  ;
    if (SWA) { qb = 15 - (item >> 4); const int r = item & 15; b = r >> 2; const int kvh = (r >> 1) & 1, gp = r & 1; hk = kvh; hq = kvh * 4 + gp * 2 + c; }
    else { qb = 15 - (item >> 5); const int r = item & 31; b = r >> 3; hk = r & 7; hq = hk; }
    const size_t tokb = (size_t)b * SEQ;
    const int q0 = qb * 128 + g * 32;
    const int qcol = SWA ? (C_SQ + hq * 128) : (C_DQ + hq * 128 + c * 64);
    const int kcol = SWA ? (C_SK + hk * 128) : (C_DK + hk * 128);
    const int vcol = SWA ? (C_SV + hk * 128) : (C_DV + hk * 128);
    const float* qnw = SWA ? W.swa_qn : W.dq_n; const float* knw = SWA ? W.swa_kn : W.dk_n;
    const float slope2 = exp2f(-(float)(hq + 1)) * LOG2E;
    bf16x8 qf[C::NKS];
    {
        const bf16_t* qp = P + (tokb + q0 + l31) * NPAD + qcol;
        float f[C::NKS][8]; float ss = 0.f;
#pragma unroll
        for (int ks = 0; ks < C::NKS; ++ks) { unpack8(*(const uint4*)(qp + 16 * ks + 8 * hh), f[ks]);
#pragma unroll
            for (int e = 0; e < 8; ++e) ss += f[ks][e] * f[ks][e]; }
        ss += __shfl_xor(ss, 32);
        const float sc = rsqrtf(ss * (1.f / C::DQK) + EPS) * (SWA ? 0.08838834764831845f : 0.125f) * LOG2E;
#pragma unroll
        for (int ks = 0; ks < C::NKS; ++ks) {
#pragma unroll
            for (int e = 0; e < 8; ++e) f[ks][e] *= sc * qnw[16 * ks + 8 * hh + e];
            qf[ks] = pack8(f[ks]); }
    }
    int t_lo = 0, t_hi = 2 * qb + 2;
    if (SWA) t_lo = (qb == 0) ? 0 : 2 * qb - 2;
    const int kkey = SWA ? (tid >> 3) : (tid >> 3), kch = tid & 7;
    const int vkey = tid & 63, vch = tid >> 6;
    uint4 rk0, rk1, rv0, rv1;
#define ATT_LOAD(t) do { const bf16_t* kp_ = P + (tokb + (t) * 64 + kkey) * NPAD + kcol + kch * 16; rk0 = ((const uint4*)kp_)[0]; rk1 = ((const uint4*)kp_)[1]; \
        const bf16_t* vp_ = P + (tokb + (t) * 64 + vkey) * NPAD + vcol + vch * 16; rv0 = ((const uint4*)vp_)[0]; rv1 = ((const uint4*)vp_)[1]; } while (0)
#define ATT_STORE(bufp) do { float f_[16]; unpack8(rk0, f_); unpack8(rk1, f_ + 8); float ss_ = 0.f; \
        _Pragma("unroll") for (int e = 0; e < 16; ++e) ss_ += f_[e] * f_[e]; \
        ss_ += __shfl_xor(ss_, 1); ss_ += __shfl_xor(ss_, 2); if (SWA) ss_ += __shfl_xor(ss_, 4); \
        const float rs_ = rsqrtf(ss_ * (1.f / C::DQK) + EPS); const int d0_ = SWA ? kch * 16 : (kch & 3) * 16; \
        _Pragma("unroll") for (int e = 0; e < 16; ++e) f_[e] *= rs_ * knw[d0_ + e]; \
        bf16_t* kd_ = (bf16_t*)(bufp) + ((SWA ? 0 : (kch >> 2) * 64) + kkey) * C::KP + d0_; \
        *(bf16x8*)kd_ = pack8(f_); *(bf16x8*)(kd_ + 8) = pack8(f_ + 8); \
        bf16_t* vd_ = (bf16_t*)((bufp) + C::KBYTES) + (vch * 16) * C::VP + vkey; \
        const unsigned vw_[8] = {rv0.x, rv0.y, rv0.z, rv0.w, rv1.x, rv1.y, rv1.z, rv1.w}; \
        _Pragma("unroll") for (int e = 0; e < 8; ++e) { vd_[(2 * e) * C::VP] = (bf16_t)(vw_[e] & 0xffffu); vd_[(2 * e + 1) * C::VP] = (bf16_t)(vw_[e] >> 16); } } while (0)

    f32x16 O[4];
#pragma unroll
    for (int vt = 0; vt < 4; ++vt)
#pragma unroll
        for (int r = 0; r < 16; ++r) O[vt][r] = 0.f;
    float m = SWA ? W.swa_sinks[hq] * LOG2E + slope2 * (float)(q0 + l31) : -INFINITY, l = SWA ? 0.5f : 0.f;
    __syncthreads();
    ATT_LOAD(t_lo);
    ATT_STORE(lds);
    __syncthreads();
    for (int t = t_lo; t < t_hi; ++t) {
        unsigned char* buf = lds + ((t - t_lo) & 1) * C::ABUF;
        unsigned char* nbuf = lds + (((t - t_lo) & 1) ^ 1) * C::ABUF;
        const bool more = (t + 1 < t_hi);
        if (more) ATT_LOAD(t + 1);
        const int k0 = t * 64;
        bool act = (k0 <= q0 + 31);
        if (SWA) act = act && (k0 + 63 >= q0 - 127);
        if (act) {
            const bf16_t* Kb = (const bf16_t*)buf + (SWA ? 0 : c * 64 * C::KP);
            f32x16 s0, s1;
            { const float kb0 = slope2 * (float)(k0 + 4 * hh), kb1 = kb0 + 32.f * slope2;
#pragma unroll
              for (int r = 0; r < 16; ++r) { const float cr = (float)((r & 3) + 8 * (r >> 2)); s0[r] = fmaf(slope2, cr, kb0); s1[r] = fmaf(slope2, cr, kb1); } }
#pragma unroll
            for (int ks = 0; ks < C::NKS; ++ks) {
                const bf16x8 a0 = *(const bf16x8*)(Kb + l31 * C::KP + 16 * ks + 8 * hh);
                const bf16x8 a1 = *(const bf16x8*)(Kb + (32 + l31) * C::KP + 16 * ks + 8 * hh);
                s0 = MFMA32(a0, qf[ks], s0); s1 = MFMA32(a1, qf[ks], s1); }
            const int dq = q0 + l31 - k0;
            const bool edge = SWA ? (k0 + 63 > q0 || k0 < q0 + 31 - 127) : (k0 + 63 > q0);
            float mx = -INFINITY;
            if (edge) {
#pragma unroll
                for (int r = 0; r < 16; ++r) { const int d0 = dq - crow(r, hh), d1 = d0 - 32;
                    if (d0 < 0 || (SWA && d0 > 127)) s0[r] = -INFINITY;
                    if (d1 < 0 || (SWA && d1 > 127)) s1[r] = -INFINITY; } }
#pragma unroll
            for (int r = 0; r < 16; ++r) { mx = __builtin_amdgcn_fmed3f(mx, s0[r], INFINITY); mx = __builtin_amdgcn_fmed3f(mx, s1[r], INFINITY); }
            mx = __builtin_amdgcn_fmed3f(mx, __shfl_xor(mx, 32), INFINITY);
            const float mn = __builtin_amdgcn_fmed3f(m, mx, INFINITY), alpha = __builtin_amdgcn_exp2f(m - mn);
            m = mn;
            s0 = s0 - mn; s1 = s1 - mn;
            f32v2_t ls2 = {0.f, 0.f};
#pragma unroll
            for (int r = 0; r < 16; r += 2) { s0[r] = __builtin_amdgcn_exp2f(s0[r]); s0[r + 1] = __builtin_amdgcn_exp2f(s0[r + 1]); s1[r] = __builtin_amdgcn_exp2f(s1[r]); s1[r + 1] = __builtin_amdgcn_exp2f(s1[r + 1]);
                ls2 += (f32v2_t){s0[r], s0[r + 1]}; ls2 += (f32v2_t){s1[r], s1[r + 1]}; }
            l = l * alpha + (ls2[0] + ls2[1]);
#pragma unroll
            for (int vt = 0; vt < 4; ++vt)
#pragma unroll
                for (int r = 0; r < 16; ++r) O[vt][r] *= alpha;
            const bf16_t* Vb = (const bf16_t*)(buf + C::KBYTES);
#pragma unroll
            for (int kt2 = 0; kt2 < 2; ++kt2)
#pragma unroll
                for (int s2 = 0; s2 < 2; ++s2) {
                    float pf[8];
#pragma unroll
                    for (int e = 0; e < 8; ++e) pf[e] = kt2 ? s1[8 * s2 + e] : s0[8 * s2 + e];
                    const bf16x8 pb = pack8(pf);
#pragma unroll
                    for (int vt = 0; vt < 4; ++vt) {
                        const bf16_t* vp = Vb + (32 * vt + l31) * C::VP + 32 * kt2 + 16 * s2 + 4 * hh;
                        const s16x4 lo = *(const s16x4*)vp, hi = *(const s16x4*)(vp + 8);
                        const bf16x8 a = __builtin_shufflevector(lo, hi, 0, 1, 2, 3, 4, 5, 6, 7);
                        O[vt] = MFMA32(a, pb, O[vt]); }
                }
        }
        if (more) ATT_STORE(nbuf);
        __syncthreads();
    }
#undef ATT_LOAD
#undef ATT_STORE
    l += __shfl_xor(l, 32);
    float* OB = (float*)lds;
    const int orow = (g * 32 + l31) * 129;
    if (SWA) {
        const float sc = 1.f / l;
#pragma unroll 1
        for (int pass = 0; pass < 2; ++pass) {
            if (c == pass) {
#pragma unroll
                for (int vt = 0; vt < 4; ++vt)
#pragma unroll
                    for (int r = 0; r < 16; ++r) OB[orow + 32 * vt + crow(r, hh)] = O[vt][r] * sc; }
            __syncthreads();
            { const int q = tid >> 2, part = tid & 3; const size_t tq = tokb + qb * 128 + q; const int hq2 = hq - c + pass;
              const bf16_t* gp = P + tq * NPAD + C_GATE + 1024 + hq2 * 128 + part * 32; bf16_t* yp = Y + tq * DM + 1024 + hq2 * 128 + part * 32;
#pragma unroll
              for (int ch = 0; ch < 4; ++ch) { float gf[8]; unpack8(*(const uint4*)(gp + ch * 8), gf); float of[8];
#pragma unroll
                  for (int e = 0; e < 8; ++e) of[e] = OB[q * 129 + part * 32 + ch * 8 + e] * gf[e];
                  *(bf16x8*)(yp + ch * 8) = pack8(of); } }
            __syncthreads();
        }
    } else {
        const float sc = (c == 0) ? 1.f / l : lam / l;
        if (c == 1) {
#pragma unroll
            for (int vt = 0; vt < 4; ++vt)
#pragma unroll
                for (int r = 0; r < 16; ++r) OB[orow + 32 * vt + crow(r, hh)] = O[vt][r] * sc; }
        __syncthreads();
        if (c == 0) {
            float ss = 0.f;
#pragma unroll
            for (int vt = 0; vt < 4; ++vt)
#pragma unroll
                for (int r = 0; r < 16; ++r) { const float o = O[vt][r] * sc - OB[orow + 32 * vt + crow(r, hh)]; O[vt][r] = o; ss += o * o; }
            ss += __shfl_xor(ss, 32);
            const float rstd = rsqrtf(ss * (1.f / 128.f) + EPS) * (1.f - W.lambda_init);
#pragma unroll
            for (int vt = 0; vt < 4; ++vt)
#pragma unroll
                for (int r = 0; r < 16; ++r) OB[orow + 32 * vt + crow(r, hh)] = O[vt][r] * rstd; }
        __syncthreads();
        { const int q = tid >> 2, part = tid & 3; const size_t tq = tokb + qb * 128 + q;
          const bf16_t* gp = P + tq * NPAD + C_GATE + 2048 + hq * 128 + part * 32; bf16_t* yp = Y + tq * DM + 2048 + hq * 128 + part * 32;
#pragma unroll
          for (int ch = 0; ch < 4; ++ch) { float gf[8]; unpack8(*(const uint4*)(gp + ch * 8), gf); float of[8];
#pragma unroll
              for (int e = 0; e < 8; ++e) of[e] = OB[q * 129 + part * 32 + ch * 8 + e] * gf[e] * W.d_on[part * 32 + ch * 8 + e];
              *(bf16x8*)(yp + ch * 8) = pack8(of); } }
        __syncthreads();
    }
}


__device__ __forceinline__ void diff_item3(const Params& p, int lay, const bf16_t* __restrict__ P, bf16_t* __restrict__ Y, const LayerW& W, float lam, int item, unsigned char* lds) {
    constexpr int KP = 72, VP = 72, KBYTES = 2 * 64 * KP * 2, ABUF = KBYTES + 128 * VP * 2;
    const int tid = tid_opaque(), lane = tid & 63, wave = tid >> 6, c = wave & 1, g = wave >> 1, l31 = lane & 31, hh = lane >> 5;
    const int qb = 15 - (item >> 5), r_ = item & 31, b = r_ >> 3, h = r_ & 7;
    const size_t tokb = (size_t)b * SEQ;
    const int q0 = qb * 128 + g * 32;
    const int kcol = C_DK + h * 128, vcol = C_DV + h * 128;
    const float slope2 = exp2f(-(float)(h + 1)) * LOG2E;
    const int kkey = tid >> 3, kch = tid & 7, vkey = tid & 63, vch = tid >> 6;
    uint4 rk0, rk1, rv0, rv1;
#define D3_KLOAD(t) do { const bf16_t* kp_ = P + (tokb + (t) * 64 + kkey) * NPAD + kcol + kch * 16; rk0 = ((const uint4*)kp_)[0]; rk1 = ((const uint4*)kp_)[1]; } while (0)
#define D3_VLOAD(t) do { const bf16_t* vp_ = P + (tokb + (t) * 64 + vkey) * NPAD + vcol + vch * 16; rv0 = ((const uint4*)vp_)[0]; rv1 = ((const uint4*)vp_)[1]; } while (0)
#define D3_KSTORE(t) do { float f_[16]; unpack8(rk0, f_); unpack8(rk1, f_ + 8); float ss_ = 0.f; \
        _Pragma("unroll") for (int e = 0; e < 16; ++e) ss_ += f_[e] * f_[e]; \
        ss_ += __shfl_xor(ss_, 1); ss_ += __shfl_xor(ss_, 2); \
        const float rs_ = rsqrtf(ss_ * (1.f / 64.f) + EPS); const int d0_ = (kch & 3) * 16; \
        _Pragma("unroll") for (int e = 0; e < 16; ++e) f_[e] *= rs_ * W.dk_n[d0_ + e]; \
        bf16_t* kd_ = (bf16_t*)(lds + ((t) & 1) * ABUF) + ((kch >> 2) * 64 + kkey) * KP + d0_; \
        *(bf16x8*)kd_ = pack8(f_); *(bf16x8*)(kd_ + 8) = pack8(f_ + 8); } while (0)
#define D3_VSTORE(t) do { bf16_t* vd_ = (bf16_t*)(lds + ((t) & 1) * ABUF + KBYTES) + (vch * 16) * VP + vkey; \
        const unsigned vw_[8] = {rv0.x, rv0.y, rv0.z, rv0.w, rv1.x, rv1.y, rv1.z, rv1.w}; \
        _Pragma("unroll") for (int e = 0; e < 8; ++e) { vd_[(2 * e) * VP] = (bf16_t)(vw_[e] & 0xffffu); vd_[(2 * e + 1) * VP] = (bf16_t)(vw_[e] >> 16); } } while (0)
#define D3_QK(t) do { const int k0_ = (t) * 64; const bf16_t* Kb_ = (const bf16_t*)(lds + ((t) & 1) * ABUF) + c * 64 * KP; \
        { const float kb0 = slope2 * (float)(k0_ + 4 * hh), kb1 = kb0 + 32.f * slope2; \
          _Pragma("unroll") for (int r = 0; r < 16; ++r) { const float cr = (float)((r & 3) + 8 * (r >> 2)); s0[r] = fmaf(slope2, cr, kb0); s1[r] = fmaf(slope2, cr, kb1); } } \
        _Pragma("unroll") for (int ks = 0; ks < 4; ++ks) { \
            const bf16x8 a0 = *(const bf16x8*)(Kb_ + l31 * KP + 16 * ks + 8 * hh), a1 = *(const bf16x8*)(Kb_ + (32 + l31) * KP + 16 * ks + 8 * hh); \
            s0 = MFMA32(a0, qf[ks], s0); s1 = MFMA32(a1, qf[ks], s1); } \
        if ((t) == tw) { const int dq = q0 + l31 - k0_; \
            _Pragma("unroll") for (int r = 0; r < 16; ++r) { const int d0 = dq - crow(r, hh), d1 = d0 - 32; if (d0 < 0) s0[r] = -INFINITY; if (d1 < 0) s1[r] = -INFINITY; } } } while (0)
#define D3_PV(tv) do { const bf16_t* Vb_ = (const bf16_t*)(lds + ((tv) & 1) * ABUF + KBYTES); \
        _Pragma("unroll") for (int i4 = 0; i4 < 4; ++i4) \
            _Pragma("unroll") for (int vt = 0; vt < 4; ++vt) { \
                const bf16_t* vp = Vb_ + (32 * vt + l31) * VP + 16 * i4 + 4 * hh; \
                const s16x4 lo = *(const s16x4*)vp, hi = *(const s16x4*)(vp + 8); \
                O[vt] = MFMA32(__builtin_shufflevector(lo, hi, 0, 1, 2, 3, 4, 5, 6, 7), pp[i4], O[vt]); } } while (0)
#define D3_SOFTMAX() do { float mx = -INFINITY; \
        _Pragma("unroll") for (int r = 0; r < 16; ++r) { mx = __builtin_amdgcn_fmed3f(mx, s0[r], INFINITY); mx = __builtin_amdgcn_fmed3f(mx, s1[r], INFINITY); } \
        mx = __builtin_amdgcn_fmed3f(mx, __shfl_xor(mx, 32), INFINITY); \
        const float mn = __builtin_amdgcn_fmed3f(m, mx, INFINITY); alpha = __builtin_amdgcn_exp2f(m - mn); m = mn; \
        float ls = 0.f; \
        _Pragma("unroll") for (int r = 0; r < 16; ++r) { s0[r] = __builtin_amdgcn_exp2f(s0[r] - mn); s1[r] = __builtin_amdgcn_exp2f(s1[r] - mn); ls += s0[r] + s1[r]; } \
        l = l * alpha + ls; } while (0)
#define D3_PACK() do { _Pragma("unroll") for (int i4 = 0; i4 < 4; ++i4) { float pf[8]; \
        _Pragma("unroll") for (int e = 0; e < 8; ++e) pf[e] = (i4 >> 1) ? s1[8 * (i4 & 1) + e] : s0[8 * (i4 & 1) + e]; \
        pp[i4] = pack8(pf); } } while (0)
    const int nt = 2 * qb + 2, tw = (q0 + 31) >> 6;
    D3_KLOAD(0);
    bf16x8 qf[4];
    {
        const bf16_t* qp = P + (tokb + q0 + l31) * NPAD + C_DQ + h * 128 + c * 64;
        float f[4][8]; float ss = 0.f;
#pragma unroll
        for (int ks = 0; ks < 4; ++ks) { unpack8(*(const uint4*)(qp + 16 * ks + 8 * hh), f[ks]);
#pragma unroll
            for (int e = 0; e < 8; ++e) ss += f[ks][e] * f[ks][e]; }
        ss += __shfl_xor(ss, 32);
        const float sc = rsqrtf(ss * (1.f / 64.f) + EPS) * 0.125f * LOG2E;
#pragma unroll
        for (int ks = 0; ks < 4; ++ks) {
#pragma unroll
            for (int e = 0; e < 8; ++e) f[ks][e] *= sc * W.dq_n[16 * ks + 8 * hh + e];
            qf[ks] = pack8(f[ks]); }
    }
    f32x16 O[4];
#pragma unroll
    for (int vt = 0; vt < 4; ++vt)
#pragma unroll
        for (int r = 0; r < 16; ++r) O[vt][r] = 0.f;
    float m = -INFINITY, l = 0.f, alpha = 0.f;
    bf16x8 pp[4];
    f32x16 s0, s1;
    __syncthreads();
    D3_KSTORE(0);
    __syncthreads();
    unsigned* HC = (unsigned*)(lds + 81920);
    const int hbase = 32 * (256 - (qb + 1) * (qb + 1)) + (item & 31) * (2 * qb + 1) - 1;
    f32x4 hc[4]; TrTile Th, Tf; bool hok, fok = false;
    hok = diff_host_tile(p, lay, hbase + 1, Th);
    if (hok) tr_load(Th, tid, hc);
    {
        D3_KLOAD(1); D3_VLOAD(0);
        D3_QK(0);
        D3_SOFTMAX();
        D3_PACK();
        D3_KSTORE(1); D3_VSTORE(0);
        __syncthreads();
    }
#pragma unroll 1
    for (int t = 1; t < nt; ++t) {
        const bool more = (t + 1 < nt);
        if (fok) tr_flush(Tf, tid, HC + ((t - 1) & 1) * 4160);
        if (more) D3_KLOAD(t + 1);
        D3_VLOAD(t);
        if (t <= tw) {
            D3_QK(t);
            {
                float mx = -INFINITY;
#pragma unroll
                for (int r = 0; r < 16; ++r) { mx = __builtin_amdgcn_fmed3f(mx, s0[r], INFINITY); mx = __builtin_amdgcn_fmed3f(mx, s1[r], INFINITY); }
                mx = __builtin_amdgcn_fmed3f(mx, __shfl_xor(mx, 32), INFINITY);
                const float mn = __builtin_amdgcn_fmed3f(m, mx, INFINITY); alpha = __builtin_amdgcn_exp2f(m - mn); m = mn;
                float ls = 0.f;
                const bf16_t* Vb_ = (const bf16_t*)(lds + ((t - 1) & 1) * ABUF + KBYTES);
#pragma unroll
                for (int r = 0; r < 16; ++r) {
                    { const int i4 = r >> 2, vt = r & 3;
                      const bf16_t* vp = Vb_ + (32 * vt + l31) * VP + 16 * i4 + 4 * hh;
                      const s16x4 lo = *(const s16x4*)vp, hi = *(const s16x4*)(vp + 8);
                      O[vt] = MFMA32(__builtin_shufflevector(lo, hi, 0, 1, 2, 3, 4, 5, 6, 7), pp[i4], O[vt]); }
                    s0[r] = __builtin_amdgcn_exp2f(s0[r] - mn); s1[r] = __builtin_amdgcn_exp2f(s1[r] - mn); ls += s0[r] + s1[r];
                    __builtin_amdgcn_sched_barrier(0);
                }
                l = l * alpha + ls;
            }
#pragma unroll
            for (int vt = 0; vt < 4; ++vt)
#pragma unroll
                for (int r = 0; r < 16; ++r) O[vt][r] *= alpha;
            D3_PACK();
        } else if (t == tw + 1) {
            D3_PV(t - 1);
        }
        if (more) D3_KSTORE(t + 1);
        D3_VSTORE(t);
        if (hok) tr_stage(tid, hc, HC + (t & 1) * 4160);
        Tf = Th; fok = hok;
        hok = more && diff_host_tile(p, lay, hbase + t + 1, Th);
        if (hok) tr_load(Th, tid, hc);
        __syncthreads();
    }
    if (fok) tr_flush(Tf, tid, HC + ((nt - 1) & 1) * 4160);
    if (tw == nt - 1) D3_PV(nt - 1);
    __syncthreads();
#undef D3_KLOAD
#undef D3_VLOAD
#undef D3_KSTORE
#undef D3_VSTORE
#undef D3_QK
#undef D3_PV
#undef D3_SOFTMAX
#undef D3_PACK
    l += __shfl_xor(l, 32);
    float* OB = (float*)lds;
    const int orow = (g * 32 + l31) * 129;
    const float sc = (c == 0) ? 1.f / l : lam / l;
    if (c == 1) {
#pragma unroll
        for (int vt = 0; vt < 4; ++vt)
#pragma unroll
            for (int r = 0; r < 16; ++r) OB[orow + 32 * vt + crow(r, hh)] = O[vt][r] * sc; }
    __syncthreads();
    if (c == 0) {
        float ss = 0.f;
#pragma unroll
        for (int vt = 0; vt < 4; ++vt)
#pragma unroll
            for (int r = 0; r < 16; ++r) { const float o = O[vt][r] * sc - OB[orow + 32 * vt + crow(r, hh)]; O[vt][r] = o; ss += o * o; }
        ss += __shfl_xor(ss, 32);
        const float rstd = rsqrtf(ss * (1.f / 128.f) + EPS) * (1.f - W.lambda_init);
#pragma unroll
        for (int vt = 0; vt < 4; ++vt)
#pragma unroll
            for (int r = 0; r < 16; ++r) OB[orow + 32 * vt + crow(r, hh)] = O[vt][r] * rstd; }
    __syncthreads();
    { const int q = tid >> 2, part = tid & 3; const size_t tq = tokb + qb * 128 + q;
      const bf16_t* gp = P + tq * NPAD + C_GATE + 2048 + h * 128 + part * 32; bf16_t* yp = Y + tq * DM + 2048 + h * 128 + part * 32;
#pragma unroll
      for (int ch = 0; ch < 4; ++ch) { float gf[8]; unpack8(*(const uint4*)(gp + ch * 8), gf); float of[8];
#pragma unroll
          for (int e = 0; e < 8; ++e) of[e] = OB[q * 129 + part * 32 + ch * 8 + e] * gf[e] * W.d_on[part * 32 + ch * 8 + e];
          *(bf16x8*)(yp + ch * 8) = pack8(of); } }
    __syncthreads();
}

__device__ __forceinline__ float fast_sigm(float x) { return __builtin_amdgcn_rcpf(1.f + __builtin_amdgcn_exp2f(-x * LOG2E)); }
__device__ __forceinline__ void lru_pre_item(const bf16_t* __restrict__ P, bf16_t* __restrict__ HL, bf16_t* __restrict__ CP, const LayerW& W, int item, unsigned char* lds) {
    const int tid = tid_opaque(), lane = tid & 63, wave = tid >> 6, l31 = lane & 31, hh = lane >> 5;
    const int b = item >> 6, n = (item >> 3) & 7, seg = item & 7;
    const size_t tokb = (size_t)b * SEQ;
    bf16_t* WrT = (bf16_t*)lds; bf16_t* WiT = WrT + 128 * 136; bf16_t* XC = WiT + 128 * 136; float* A = (float*)(lds + 69632 + 17408); float* U = A + 8192;
    __syncthreads();
#pragma unroll 2
    for (int e = 0; e < 8; ++e) { const int idx = tid + 512 * e, i = idx >> 5, j4 = (idx & 31) * 4;
        const float4 a = *(const float4*)(W.w_r + (size_t)n * 16384 + i * 128 + j4), c = *(const float4*)(W.w_i + (size_t)n * 16384 + i * 128 + j4);
        WrT[(j4 + 0) * 136 + i] = f2bf(a.x); WrT[(j4 + 1) * 136 + i] = f2bf(a.y); WrT[(j4 + 2) * 136 + i] = f2bf(a.z); WrT[(j4 + 3) * 136 + i] = f2bf(a.w);
        WiT[(j4 + 0) * 136 + i] = f2bf(c.x); WiT[(j4 + 1) * 136 + i] = f2bf(c.y); WiT[(j4 + 2) * 136 + i] = f2bf(c.z); WiT[(j4 + 3) * 136 + i] = f2bf(c.w); }
    const int tt = wave >> 2, jt = wave & 3, chl = 32 * jt + l31, ch = n * 128 + chl;
    const float br = W.b_r[ch], bi = W.b_i[ch];
    float sp; { const float x = -W.lam[ch]; sp = (x > 20.f) ? x : log1pf(expf(x)); }
    const float sp8 = -8.f * sp;
    const int cc = 2 * (tid & 63), tg = tid >> 6, cch = n * 128 + cc;
    float cw[4][2], cb[2];
#pragma unroll
    for (int w = 0; w < 4; ++w) { cw[w][0] = W.conv_w[w * 1024 + cch]; cw[w][1] = W.conv_w[w * 1024 + cch + 1]; }
    cb[0] = W.conv_b[cch]; cb[1] = W.conv_b[cch + 1];
    unsigned rx[11];
#define LRU_LOAD(k) do { _Pragma("unroll") for (int i = 0; i < 11; ++i) { const int tp = seg * 256 + (k) * 64 + 8 * tg - 3 + i; rx[i] = (tp >= 0) ? *(const unsigned*)(P + (tokb + tp) * NPAD + C_RX + cch) : 0u; } } while (0)
    LRU_LOAD(0);
    float* XH = (float*)XC; float* XP = XH + 512;
    const int sch = tid & 127, ssub = tid >> 7;
    float hcar = 0.f, ccar = 1.f;
#pragma unroll 1
    for (int k = 0; k < 4; ++k) {
#pragma unroll
        for (int i = 0; i < 8; ++i) { float x0 = cb[0], x1 = cb[1];
#pragma unroll
            for (int w = 0; w < 4; ++w) { const unsigned v = rx[i + w]; x0 += cw[w][0] * __uint_as_float(v << 16); x1 += cw[w][1] * __uint_as_float(v & 0xffff0000u); }
            *(unsigned*)(XC + (8 * tg + i) * 136 + cc) = cvt2(x0, x1); }
        if (k + 1 < 4) LRU_LOAD(k + 1);
        __syncthreads();
        {
            f32x16 ar, ai;
#pragma unroll
            for (int r = 0; r < 16; ++r) { ar[r] = 0.f; ai[r] = 0.f; }
#pragma unroll
            for (int ks = 0; ks < 8; ++ks) {
                const bf16x8 a = *(const bf16x8*)(XC + (32 * tt + l31) * 136 + 16 * ks + 8 * hh);
                const bf16x8 wr = *(const bf16x8*)(WrT + (32 * jt + l31) * 136 + 16 * ks + 8 * hh);
                const bf16x8 wi = *(const bf16x8*)(WiT + (32 * jt + l31) * 136 + 16 * ks + 8 * hh);
                ar = MFMA32(a, wr, ar); ai = MFMA32(a, wi, ai); }
#pragma unroll
            for (int r = 0; r < 16; ++r) { const int t = 32 * tt + crow(r, hh);
                const float rr = fast_sigm(ar[r] + br), ii = fast_sigm(ai[r] + bi), la = sp8 * rr;
                const float av = __builtin_amdgcn_exp2f(la * LOG2E), x2 = 2.f * la;
                const float om = (x2 > -0.1f) ? -x2 * (1.f + x2 * (0.5f + x2 * (0.16666667f + x2 * 0.041666668f))) : 1.f - av * av;
                const float xv = bf2f(XC[t * 136 + chl]);
                A[t * 128 + chl] = av; U[t * 128 + chl] = __builtin_amdgcn_sqrtf(om) * ii * xv; }
        }
        __syncthreads();
        {
            float hl[16], cl[16]; float hh_ = 0.f, cc_ = 1.f;
#pragma unroll
            for (int t = 0; t < 16; ++t) { const float a = A[(16 * ssub + t) * 128 + sch]; hh_ = a * hh_ + U[(16 * ssub + t) * 128 + sch]; cc_ *= a; hl[t] = hh_; cl[t] = cc_; }
            XH[ssub * 128 + sch] = hh_; XP[ssub * 128 + sch] = cc_;
            __syncthreads();
            float hin = hcar, cin = ccar;
            for (int s = 0; s < ssub; ++s) { hin = XH[s * 128 + sch] + XP[s * 128 + sch] * hin; cin *= XP[s * 128 + sch]; }
            float hend = hin, cend = cin;
            for (int s = ssub; s < 4; ++s) { hend = XH[s * 128 + sch] + XP[s * 128 + sch] * hend; cend *= XP[s * 128 + sch]; }
            hcar = hend; ccar = cend;
            const size_t o = (tokb + seg * 256 + k * 64 + 16 * ssub) * 1024 + n * 128 + sch;
#pragma unroll
            for (int t = 0; t < 16; ++t) { HL[o + (size_t)t * 1024] = f2bf(hl[t] + cl[t] * hin); CP[o + (size_t)t * 1024] = f2bf(cl[t] * cin); }
            __syncthreads();
        }
    }
#undef LRU_LOAD
    __syncthreads();
}
__device__ __forceinline__ void lru_fix_item(const bf16_t* __restrict__ P, bf16_t* __restrict__ Y, const bf16_t* __restrict__ HL, const bf16_t* __restrict__ CP, int item) {
    const int tid = tid_opaque();
    const int b = item >> 6, n = (item >> 3) & 7, seg = item & 7;
    const size_t tokb = (size_t)b * SEQ;
    const int c0 = (tid & 15) * 8, tr = tid >> 4;
    float carry[8];
#pragma unroll
    for (int e = 0; e < 8; ++e) carry[e] = 0.f;
    for (int s = 0; s < seg; ++s) { const size_t o = (tokb + s * 256 + 255) * 1024 + n * 128 + c0;
        float h[8], c[8]; unpack8(*(const uint4*)(HL + o), h); unpack8(*(const uint4*)(CP + o), c);
#pragma unroll
        for (int e = 0; e < 8; ++e) carry[e] = h[e] + c[e] * carry[e]; }
#pragma unroll 2
    for (int it = 0; it < 8; ++it) { const size_t tok = tokb + seg * 256 + it * 32 + tr; const size_t o = tok * 1024 + n * 128 + c0;
        float h[8], c[8], gf[8]; unpack8(*(const uint4*)(HL + o), h); unpack8(*(const uint4*)(CP + o), c);
        unpack8(*(const uint4*)(P + tok * NPAD + C_GATE + 3072 + n * 128 + c0), gf);
        float of[8];
#pragma unroll
        for (int e = 0; e < 8; ++e) of[e] = (h[e] + c[e] * carry[e]) * gf[e];
        *(bf16x8*)(Y + tok * DM + 3072 + n * 128 + c0) = pack8(of); }
}

constexpr size_t GP_UNIT = 41216;
struct GlaPreRaw { uint4 ra0, ra1, rq, rk, rv0, rv1; };
__device__ __forceinline__ GlaPreRaw gla_pre_load(const bf16_t* __restrict__ P, int unit, int lane, int wave) {
    const int bh = unit >> 5, k = unit & 31, b = bh >> 3, h = bh & 7;
    const bf16_t* row_ = P + ((size_t)b * SEQ + k * 64 + lane) * NPAD;
    GlaPreRaw r;
    r.ra0 = *(const uint4*)(row_ + C_GA); r.ra1 = *(const uint4*)(row_ + C_GA + 8);
    r.rq = *(const uint4*)(row_ + C_GQ + h * 64 + 8 * wave); r.rk = *(const uint4*)(row_ + C_GK + h * 64 + 8 * wave);
    r.rv0 = *(const uint4*)(row_ + C_GV + h * 128 + 16 * wave); r.rv1 = *(const uint4*)(row_ + C_GV + h * 128 + 16 * wave + 8);
    return r;
}
__device__ __forceinline__ void gla_pre_unit(const GlaPreRaw& R, unsigned char* __restrict__ GP, const LayerW& W, int unit, unsigned char* lds, int tid) {
    const int lane = tid & 63, wave = tid >> 6;
    const int bh = unit >> 5, h = bh & 7;
    float* WUP = (float*)lds;
    __syncthreads();
    for (int i = tid; i < 1024; i += 512) WUP[i] = W.gla_w_up[(i >> 6) * 512 + h * 64 + (i & 63)];
    if (tid < 64) WUP[1024 + tid] = W.gla_b_up[h * 64 + tid];
    __syncthreads();
    unsigned char* g = GP + (size_t)unit * GP_UNIT;
    float al[16]; unpack8(R.ra0, al); unpack8(R.ra1, al + 8);
    float bc[8];
    { const float4 b0 = *(const float4*)(WUP + 1024 + 8 * wave), b1 = *(const float4*)(WUP + 1024 + 8 * wave + 4);
      bc[0] = b0.x; bc[1] = b0.y; bc[2] = b0.z; bc[3] = b0.w; bc[4] = b1.x; bc[5] = b1.y; bc[6] = b1.z; bc[7] = b1.w; }
#pragma unroll
    for (int r = 0; r < 16; ++r) { const float4 w0 = *(const float4*)(WUP + r * 64 + 8 * wave), w1 = *(const float4*)(WUP + r * 64 + 8 * wave + 4);
        bc[0] += al[r] * w0.x; bc[1] += al[r] * w0.y; bc[2] += al[r] * w0.z; bc[3] += al[r] * w0.w; bc[4] += al[r] * w1.x; bc[5] += al[r] * w1.y; bc[6] += al[r] * w1.z; bc[7] += al[r] * w1.w; }
#pragma unroll
    for (int e = 0; e < 8; ++e) { const float lg = bc[e]; bc[e] = (fminf(lg, 0.f) - __logf(1.f + __expf(-fabsf(lg)))) * (1.f / 16.f); }
#define DPP_ADD(x, ctrl, rmask) (x) += __int_as_float(__builtin_amdgcn_update_dpp(0, __float_as_int(x), (ctrl), (rmask), 0xf, true))
#pragma unroll
    for (int e = 0; e < 8; ++e) { DPP_ADD(bc[e], 0x111, 0xf); DPP_ADD(bc[e], 0x112, 0xf); DPP_ADD(bc[e], 0x114, 0xf); DPP_ADD(bc[e], 0x118, 0xf); DPP_ADD(bc[e], 0x142, 0xa); DPP_ADD(bc[e], 0x143, 0xc); }
#undef DPP_ADD
    float qv[8], kv[8], qd[8], kd[8]; unpack8(R.rq, qv); unpack8(R.rk, kv);
#pragma unroll
    for (int e = 0; e < 8; ++e) { const float bl = __shfl(bc[e], 63);
        qd[e] = qv[e] * 0.125f * __expf(bc[e]); kd[e] = kv[e] * __expf(-bc[e]);
        ((bf16_t*)(g + 16384))[(8 * wave + e) * 64 + lane] = f2bf(kv[e] * __expf(bl - bc[e]));
        if (lane == 63) ((float*)(g + 40960))[8 * wave + e] = __expf(bl); }
    *(bf16x8*)(g + (lane * 64 + 8 * wave) * 2) = pack8(qd); *(bf16x8*)(g + 8192 + (lane * 64 + 8 * wave) * 2) = pack8(kd);
    const unsigned vw[8] = {R.rv0.x, R.rv0.y, R.rv0.z, R.rv0.w, R.rv1.x, R.rv1.y, R.rv1.z, R.rv1.w};
    bf16_t* vt = (bf16_t*)(g + 24576);
#pragma unroll
    for (int e = 0; e < 8; ++e) { vt[(16 * wave + 2 * e) * 64 + lane] = (bf16_t)(vw[e] & 0xffffu); vt[(16 * wave + 2 * e + 1) * 64 + lane] = (bf16_t)(vw[e] >> 16); }
}
__device__ __forceinline__ void gla_pre_all(const bf16_t* __restrict__ P, unsigned char* __restrict__ GP, const LayerW& W, unsigned char* lds) {
    const int tid = tid_opaque(), lane = tid & 63, wave = tid >> 6;
    int u = blockIdx.x;
    if (u >= 1024) return;
    GlaPreRaw cur = gla_pre_load(P, u, lane, wave);
#pragma unroll 1
    while (u < 1024) {
        const int un = u + gridDim.x;
        GlaPreRaw nxt = cur;
        if (un < 1024) nxt = gla_pre_load(P, un, lane, wave);
        gla_pre_unit(cur, GP, W, u, lds, tid);
        cur = nxt; u = un;
    }
}

__device__ __forceinline__ void gla_item(const Params& p, int l, const bf16_t* __restrict__ P, bf16_t* __restrict__ Y, const unsigned char* __restrict__ GP, const LayerW& W, int item, unsigned char* lds) {
    const int tid = tid_opaque(), lane = tid & 63, wave = tid >> 6, l31 = lane & 31, hh = lane >> 5;
    const int b = item >> 3, h = item & 7;
    const size_t tokb = (size_t)b * SEQ;
    bf16_t* QD = (bf16_t*)lds; bf16_t* KD = QD + 64 * 72; bf16_t* KST = KD + 64 * 72; bf16_t* VT = KST + 64 * 72; bf16_t* ST = VT + 128 * 72;
    float* OB = (float*)(lds + 64768);
    const int vt = wave >> 1, it = wave & 1;
    const int srow = tid >> 3, sseg = tid & 7, ctok = tid >> 3, cvch = tid & 7;
    f32x16 S;
#pragma unroll
    for (int r = 0; r < 16; ++r) S[r] = 0.f;
    uint4 rQ, rK, rS, rV0, rV1, rg0, rg1; float rdec;
#define GLA_LOAD(k) do { const unsigned char* g_ = GP + (size_t)(item * 32 + (k)) * GP_UNIT + srow * 128 + sseg * 16; \
        rQ = *(const uint4*)g_; rK = *(const uint4*)(g_ + 8192); rS = *(const uint4*)(g_ + 16384); rV0 = *(const uint4*)(g_ + 24576); rV1 = *(const uint4*)(g_ + 24576 + 8192); \
        rdec = ((const float*)(GP + (size_t)(item * 32 + (k)) * GP_UNIT + 40960))[32 * it + l31]; \
        const bf16_t* gp_ = P + (tokb + (k) * 64 + ctok) * NPAD + C_GATE + h * 128 + cvch * 16; rg0 = *(const uint4*)gp_; rg1 = *(const uint4*)(gp_ + 8); } while (0)
    GLA_LOAD(0);
    unsigned* CS0 = (unsigned*)(lds + 98304); unsigned* CS1 = (unsigned*)(lds + 98304 + 16640);
    f32x4 ca[4], cb[4]; TrTile Ta, Tb;
    bool oka = host_tile(p, l, item * 32, Ta), okb = false;
    if (oka) tr_load(Ta, tid, ca);
    if (okb) tr_load(Tb, tid, cb);
    float nw[16];
#pragma unroll
    for (int e = 0; e < 16; ++e) nw[e] = W.gla_nw[cvch * 16 + e];
    const bf16_t* LH = (const bf16_t*)(p.ws + WS_LA); const bf16_t* LC = (const bf16_t*)(p.ws + WS_LU);
    const int fc0 = (tid & 15) * 8, ftr = tid >> 4;
    float fcar[8];
#pragma unroll
    for (int e = 0; e < 8; ++e) fcar[e] = 0.f;
    __syncthreads();
#pragma unroll 1
    for (int k = 0; k < 32; ++k) {
        uint4 fh0, fh1, fp0, fp1, fg0, fg1, feh, fep;
        { const size_t t0 = tokb + k * 64 + ftr, t1 = t0 + 32;
          fh0 = *(const uint4*)(LH + t0 * 1024 + h * 128 + fc0); fp0 = *(const uint4*)(LC + t0 * 1024 + h * 128 + fc0); fg0 = *(const uint4*)(P + t0 * NPAD + C_GATE + 3072 + h * 128 + fc0);
          fh1 = *(const uint4*)(LH + t1 * 1024 + h * 128 + fc0); fp1 = *(const uint4*)(LC + t1 * 1024 + h * 128 + fc0); fg1 = *(const uint4*)(P + t1 * NPAD + C_GATE + 3072 + h * 128 + fc0);
          const size_t te = tokb + (k > 0 ? k * 64 - 1 : 0);
          feh = *(const uint4*)(LH + te * 1024 + h * 128 + fc0); fep = *(const uint4*)(LC + te * 1024 + h * 128 + fc0); }
        *(uint4*)(QD + srow * 72 + sseg * 8) = rQ; *(uint4*)(KD + srow * 72 + sseg * 8) = rK; *(uint4*)(KST + srow * 72 + sseg * 8) = rS;
        *(uint4*)(VT + srow * 72 + sseg * 8) = rV0; *(uint4*)(VT + (64 + srow) * 72 + sseg * 8) = rV1;
#pragma unroll
        for (int r = 0; r < 16; ++r) ST[(32 * vt + crow(r, hh)) * 72 + 32 * it + l31] = f2bf(S[r]);
        const float dec = rdec; const uint4 g0 = rg0, g1 = rg1;
        __syncthreads();
        if (k + 1 < 32) GLA_LOAD(k + 1);
        {
            f32x16 at0, at1, o, u;
#pragma unroll
            for (int r = 0; r < 16; ++r) { at0[r] = 0.f; at1[r] = 0.f; o[r] = 0.f; u[r] = 0.f; }
#pragma unroll
            for (int ks = 0; ks < 4; ++ks) {
                const bf16x8 bq = *(const bf16x8*)(QD + (32 * it + l31) * 72 + 16 * ks + 8 * hh);
                const bf16x8 a0 = *(const bf16x8*)(KD + l31 * 72 + 16 * ks + 8 * hh), a1 = *(const bf16x8*)(KD + (32 + l31) * 72 + 16 * ks + 8 * hh);
                at0 = MFMA32(a0, bq, at0); at1 = MFMA32(a1, bq, at1); }
            const int iq = 32 * it + l31;
#pragma unroll
            for (int r = 0; r < 16; ++r) { const int j0 = crow(r, hh); if (j0 > iq) at0[r] = 0.f; if (j0 + 32 > iq) at1[r] = 0.f; }
#pragma unroll
            for (int jt2 = 0; jt2 < 2; ++jt2)
#pragma unroll
                for (int s2 = 0; s2 < 2; ++s2) { float pf[8];
#pragma unroll
                    for (int e = 0; e < 8; ++e) pf[e] = jt2 ? at1[8 * s2 + e] : at0[8 * s2 + e];
                    const bf16x8 pb = pack8(pf);
                    const bf16_t* vp = VT + (32 * vt + l31) * 72 + 32 * jt2 + 16 * s2 + 4 * hh;
                    const s16x4 lo = *(const s16x4*)vp, hi = *(const s16x4*)(vp + 8);
                    o = MFMA32(__builtin_shufflevector(lo, hi, 0, 1, 2, 3, 4, 5, 6, 7), pb, o); }
#pragma unroll
            for (int ks = 0; ks < 4; ++ks) {
                const bf16x8 a = *(const bf16x8*)(ST + (32 * vt + l31) * 72 + 16 * ks + 8 * hh);
                const bf16x8 bq = *(const bf16x8*)(QD + (32 * it + l31) * 72 + 16 * ks + 8 * hh);
                o = MFMA32(a, bq, o); }
#pragma unroll
            for (int ks = 0; ks < 4; ++ks) {
                const bf16x8 a = *(const bf16x8*)(VT + (32 * vt + l31) * 72 + 16 * ks + 8 * hh);
                const bf16x8 bk = *(const bf16x8*)(KST + (32 * it + l31) * 72 + 16 * ks + 8 * hh);
                u = MFMA32(a, bk, u); }
#pragma unroll
            for (int r = 0; r < 16; ++r) { S[r] = dec * S[r] + u[r]; OB[(32 * it + l31) * 129 + 32 * vt + crow(r, hh)] = o[r]; }
        }
        const TrTile Fa = Ta, Fb = Tb; const bool fa = oka, fb = okb;
        if (fa) tr_stage(tid, ca, CS0);
        if (fb) tr_stage(tid, cb, CS1);
        oka = (k + 1 < 32) && host_tile(p, l, item * 32 + k + 1, Ta); okb = false;
        if (oka) tr_load(Ta, tid, ca);
        if (okb) tr_load(Tb, tid, cb);
        __syncthreads();
        if (fa) tr_flush(Fa, tid, CS0);
        if (fb) tr_flush(Fb, tid, CS1);
        {
            float ov[16]; float ss = 0.f;
#pragma unroll
            for (int e = 0; e < 16; ++e) { ov[e] = OB[ctok * 129 + cvch * 16 + e]; ss += ov[e] * ov[e]; }
            ss += __shfl_xor(ss, 1); ss += __shfl_xor(ss, 2); ss += __shfl_xor(ss, 4);
            const float rstd = rsqrtf(ss * (1.f / 128.f) + EPS);
            float gf[16]; unpack8(g0, gf); unpack8(g1, gf + 8);
#pragma unroll
            for (int e = 0; e < 16; ++e) ov[e] *= rstd * nw[e] * gf[e];
            bf16_t* yp = Y + (tokb + k * 64 + ctok) * DM + h * 128 + cvch * 16;
            *(bf16x8*)yp = pack8(ov); *(bf16x8*)(yp + 8) = pack8(ov + 8);
        }
        {
            if (k > 0 && (k & 3) == 0) { float eh[8], ep[8]; unpack8(feh, eh); unpack8(fep, ep);
#pragma unroll
                for (int e = 0; e < 8; ++e) fcar[e] = eh[e] + ep[e] * fcar[e]; }
            float hv[8], cv[8], gv[8], of[8];
            unpack8(fh0, hv); unpack8(fp0, cv); unpack8(fg0, gv);
#pragma unroll
            for (int e = 0; e < 8; ++e) of[e] = (hv[e] + cv[e] * fcar[e]) * gv[e];
            *(bf16x8*)(Y + (tokb + k * 64 + ftr) * DM + 3072 + h * 128 + fc0) = pack8(of);
            unpack8(fh1, hv); unpack8(fp1, cv); unpack8(fg1, gv);
#pragma unroll
            for (int e = 0; e < 8; ++e) of[e] = (hv[e] + cv[e] * fcar[e]) * gv[e];
            *(bf16x8*)(Y + (tokb + k * 64 + 32 + ftr) * DM + 3072 + h * 128 + fc0) = pack8(of);
        }
    }
#undef GLA_LOAD
    __syncthreads();
}

constexpr int QSLOT_OFF = LDS_BYTES - 16;
constexpr size_t WS_CTR = WS_END;
constexpr size_t WS_BAR = WS_END + 512;
constexpr size_t WS_CTL_BYTES = 512 + XCD_BAR_WORDS_C * 4;
__device__ __forceinline__ void phase_mix_fast(const Params& p, int l, unsigned char* lds, int rep) {
    const LayerW W = layer_w(p, l);
    const bf16_t* P = (const bf16_t*)(p.ws + WS_PROJ); bf16_t* Y = (bf16_t*)(p.ws + WS_Y);
    unsigned* ctr = (unsigned*)(p.ws + WS_CTR) + l * 64 + rep * 16;
    const float lam = diff_lambda(W);
    volatile int* slot = (volatile int*)(lds + QSLOT_OFF);
    for (;;) {
        __syncthreads();
        if (tid_opaque() == 0) *slot = (int)atomicAdd(ctr, 1u);
        __syncthreads();
        const int it = __builtin_amdgcn_readfirstlane(*slot);
        if (it >= 800) break;
        if (it < 32) { gla_item(p, l, P, Y, p.ws + WS_GP, W, it, lds);
#ifdef PROBE_GLA2
            gla_item(p, l, P, Y, p.ws + WS_GP, W, it, lds);
#endif
        }
        else if (it < 544) diff_item3(p, l, P, Y, W, lam, it - 32, lds);
        else attn_item<true>(P, Y, W, lam, it - 544, lds);
    }
}

#define XB_TMO      128
#define XB_XCNT(j)  (256  + 64 * (j))
#define XB_XSUB(j)  (1280 + 64 * (j))
#define XB_XGEN(j)  (2304 + 64 * (j))
#define XB_TOP      3328
#define XB_TOPGEN   3392
#define XCD_BAR_WORDS 3456
#define XB_SPIN_CAP (1u << 18)

__device__ __forceinline__ unsigned xb_ld(unsigned* p)              { return __hip_atomic_load(p, __ATOMIC_RELAXED, __HIP_MEMORY_SCOPE_AGENT); }
__device__ __forceinline__ unsigned xb_add(unsigned* p, unsigned v) { return __hip_atomic_fetch_add(p, v, __ATOMIC_RELAXED, __HIP_MEMORY_SCOPE_AGENT); }
__device__ __forceinline__ unsigned xb_xcc_id() { return (unsigned)__builtin_amdgcn_s_getreg((3 << 11) | 20) & 0xFu; }
#define XB_SPIN(cond, bar) do { unsigned _sp = 0; while (cond) { __builtin_amdgcn_s_sleep(1); \
    if ((++_sp & 255u) == 0u) { if (xb_ld(&(bar)[XB_TMO])) break; if (_sp > XB_SPIN_CAP) { atomicAdd(&(bar)[XB_TMO], 1u); break; } } } } while (0)

struct XcdBarrier {
    unsigned* bar; unsigned x;
    volatile LAS unsigned* st;
};

__device__ __forceinline__ XcdBarrier xcd_barrier_post(unsigned* bar, volatile LAS unsigned* st) {
    XcdBarrier b; b.bar = bar; b.x = xb_xcc_id(); b.st = st;
    if (threadIdx.x == 0) (void)xb_add(&bar[XB_XCNT(b.x)], 1u);
    return b;
}
__device__ __forceinline__ void xcd_barrier_complete(unsigned* bar, unsigned x, unsigned& nloc, unsigned& nx) {
    const unsigned G = gridDim.x * gridDim.y * gridDim.z;
    unsigned sum, cnt, mine, sp = 0u;
    for (;;) {
        sum = 0u; cnt = 0u; mine = 0u;
#pragma unroll
        for (unsigned j = 0; j < 16; ++j) { const unsigned c = xb_ld(&bar[XB_XCNT(j)]); sum += c; cnt += (c > 0u) ? 1u : 0u; mine = (j == x) ? c : mine; }
        if (sum == G) break;
        __builtin_amdgcn_s_sleep(1);
        if ((++sp & 255u) == 0u) { if (xb_ld(&bar[XB_TMO])) break; if (sp > XB_SPIN_CAP) { atomicAdd(&bar[XB_TMO], 1u); break; } }
    }
    nloc = mine > 0u ? mine : 1u; nx = cnt > 0u ? cnt : 1u;
}

__device__ __forceinline__ void xcd_barrier(const XcdBarrier& b) {
    asm volatile("s_waitcnt vmcnt(0)" ::: "memory");
    __syncthreads();
    if (threadIdx.x == 0) {
        unsigned* bar = b.bar;
        __builtin_amdgcn_s_waitcnt(0);
        unsigned nloc = b.st[0], nx = b.st[1];
        if (nloc == 0u) { xcd_barrier_complete(bar, b.x, nloc, nx); b.st[0] = nloc; b.st[1] = nx; }
        const unsigned old = xb_add(&bar[XB_XSUB(b.x)], 1u);
        const unsigned gen = old / nloc;
        if (old + 1u == (gen + 1u) * nloc) {
            __builtin_amdgcn_fence(__ATOMIC_RELEASE, "agent");
            asm volatile("s_waitcnt vmcnt(0)" ::: "memory");
            const unsigned og = xb_add(&bar[XB_TOP], 1u);
            const unsigned tg = og / nx;
            if (og + 1u == (tg + 1u) * nx) xb_add(&bar[XB_TOPGEN], 1u);
            else XB_SPIN(xb_ld(&bar[XB_TOPGEN]) == tg, bar);
            __builtin_amdgcn_fence(__ATOMIC_ACQUIRE, "agent");
            xb_add(&bar[XB_XGEN(b.x)], 1u);
            asm volatile("s_waitcnt vmcnt(0)" ::: "memory");
        } else {
            XB_SPIN(xb_ld(&bar[XB_XGEN(b.x)]) == gen, bar);
            __builtin_amdgcn_fence(__ATOMIC_ACQUIRE, "agent");
            asm volatile("s_waitcnt vmcnt(0)" ::: "memory");
        }
    }
    __syncthreads();
}


#ifndef GEMM_SP2
#define GEMM_SP2 true
#endif
#ifndef GEMM_ALIGN
#define GEMM_ALIGN true
#endif
#ifndef REP_M1
#define REP_M1 1
#endif
#ifndef REP_PREP
#define REP_PREP 1
#endif
#ifndef REP_G1
#define REP_G1 1
#endif
#ifndef REP_MIX
#define REP_MIX 1
#endif
__global__ void __launch_bounds__(512, 2) mega(Params p) {
    extern __shared__ __attribute__((aligned(16))) unsigned char lds[];
    cg::grid_group grid = cg::this_grid();
    const int lo = p.ph_lo, hi = p.ph_hi;
#define IN(k) (lo <= (k) && (k) < hi)
#define SYNC(k) do { if (IN(k) && IN((k) + 1)) xcd_barrier(xbar); } while (0)
    if (lo < 0) grid.sync();
    volatile LAS unsigned* xst = (volatile LAS unsigned*)((LAS unsigned char*)lds + (LDS_BYTES - 32));
    if (threadIdx.x < 2) xst[threadIdx.x] = 0u;
    __syncthreads();
    XcdBarrier xbar; xbar.bar = (unsigned*)(p.ws + WS_BAR); xbar.x = xb_xcc_id(); xbar.st = xst;
    if (threadIdx.x == 0) xst[2] = xb_add(&xbar.bar[XB_XCNT(xbar.x)], 1u);
    __syncthreads();
    const int xrank = (int)xst[2];
    int cu_c = (int)blockIdx.x;
#ifdef EXTRA_SYNC
    if (hi - lo > 1) {
#pragma unroll 1
        for (int r = 0; r < EXTRA_SYNC; ++r) grid.sync(); }
#endif
    if (IN(0)) {
#pragma unroll 1
        for (int r = 0; r < REP_PREP; ++r) phase_prep(p, lds); }
    SYNC(0);
    if (hi - lo > 1) {
        bool even = (gridDim.x % 8 == 0);
        for (unsigned j = 0; j < 16; ++j) { const unsigned cnt = xb_ld(&xbar.bar[XB_XCNT(j)]); even = even && (cnt == (j < 8 ? gridDim.x / 8 : 0u)); }
        if (even) cu_c = (int)xbar.x + 8 * xrank;
    }
#pragma unroll 1
    for (int l = 0; l < 2; ++l) {
        const int pb = 1 + 5 * l;
        if (IN(pb)) {
            pg8::Gemm g{(const bf16_t*)(p.ws + WS_H), (const bf16_t*)(p.ws + WS_WIN + l * SZ_WIN), TOK, NPAD, DM};
            pg8::StaticOrder S; S.init(TOK, NPAD, (int)gridDim.x, cu_c);
            EpiProj E{(bf16_t*)(p.ws + WS_PROJ)};
#pragma unroll 1
            for (int r = 0; r < REP_G1; ++r)
            pg8::gemm_phase<EpiProj, pg8::StaticOrder, GEMM_ALIGN, GEMM_SP2>((LAS unsigned char*)lds, g, S, E);
            { const int nwg = (TOK / 256) * (NPAD / 256), G = (int)gridDim.x, rem = nwg % G;
              if (rem == 0) convert_deferred(p, l, cu_c, G, lds);
              else if (cu_c >= rem) convert_deferred(p, l, cu_c - rem, G - rem, lds); }
        }
        SYNC(pb);
        if (IN(pb + 1)) { const LayerW W = layer_w(p, l);
#pragma unroll 1
          for (int r1 = 0; r1 < REP_M1; ++r1) {
            gla_pre_all((const bf16_t*)(p.ws + WS_PROJ), p.ws + WS_GP, W, lds);
            for (int it = blockIdx.x; it < 256; it += gridDim.x) lru_pre_item((const bf16_t*)(p.ws + WS_PROJ), (bf16_t*)(p.ws + WS_LA), (bf16_t*)(p.ws + WS_LU), W, it, lds); } }
        SYNC(pb + 1);
        if (IN(pb + 2)) {
#pragma unroll 1
            for (int r = 0; r < REP_MIX; ++r) phase_mix_fast(p, l, lds, r); }
        SYNC(pb + 2);
        if (IN(pb + 3)) {
            pg8::Gemm g{(const bf16_t*)(p.ws + WS_Y), (const bf16_t*)(p.ws + WS_WOUT + l * SZ_WOUT), TOK, DM, DM};
            pg8::StaticOrder S; S.init(TOK, DM, (int)gridDim.x, cu_c);
            EpiRes E{l == 0 ? p.in[0] : (const float*)(p.ws + WS_X1), l == 0 ? (float*)(p.ws + WS_X1) : p.out};
            pg8::gemm_phase<EpiRes, pg8::StaticOrder, GEMM_ALIGN, GEMM_SP2>((LAS unsigned char*)lds, g, S, E);
        }
        SYNC(pb + 3);
        if (l == 0) {
            if (IN(pb + 4)) rmsnorm_rows((const float*)(p.ws + WS_X1), p.in[1] + DM, (bf16_t*)(p.ws + WS_H));
            SYNC(pb + 4);
        }
    }
}

#ifndef COOP
#define COOP 1
#endif
extern "C" void kernel_launch(void* const* d_in, const int* in_sizes, int n_in, void* d_out, int out_size, void* d_ws, size_t ws_size, hipStream_t stream) {
    static int grid = 0;
    if (grid == 0) {
        if (n_in != 24 || ws_size < WS_END + 65536) { fprintf(stderr, "kernel_launch: unexpected n_in %d / ws %zu (need %zu)\n", n_in, ws_size, (size_t)WS_END); grid = -1; return; }
        if (hipFuncSetAttribute((const void*)mega, hipFuncAttributeMaxDynamicSharedMemorySize, LDS_BYTES) != hipSuccess) { fprintf(stderr, "kernel_launch: hipFuncSetAttribute failed\n"); grid = -1; return; }
        int dev = 0, cus = 0, per_cu = 0;
        hipGetDevice(&dev); hipDeviceGetAttribute(&cus, hipDeviceAttributeMultiprocessorCount, dev);
        hipOccupancyMaxActiveBlocksPerMultiprocessor(&per_cu, (const void*)mega, 512, LDS_BYTES);
        if (per_cu < 1) { fprintf(stderr, "kernel_launch: occupancy query says %d blocks/CU\n", per_cu); per_cu = 1; }
        grid = cus * 1;
        (void)hipGetLastError();
    }
    if (grid < 0) return;
    Params p{};
    for (int i = 0; i < 24; ++i) p.in[i] = (const float*)d_in[i];
    p.out = (float*)d_out; p.ws = (unsigned char*)d_ws;
    if (hipMemsetAsync((unsigned char*)d_ws + WS_CTR, 0, WS_CTL_BYTES, stream) != hipSuccess) { fprintf(stderr, "kernel_launch: memset failed\n"); return; }
#if COOP
    p.ph_lo = 0; p.ph_hi = NPH - 1 + 0;
    p.ph_hi = NPH;
    void* args[] = {&p};
    hipError_t e = hipLaunchCooperativeKernel((const void*)mega, dim3(grid), dim3(512), args, LDS_BYTES, stream);
    if (e != hipSuccess) fprintf(stderr, "cooperative launch failed: %s (grid %d)\n", hipGetErrorString(e), grid);
#else
    for (int ph = 0; ph < NPH; ++ph) { p.ph_lo = ph; p.ph_hi = ph + 1; hipLaunchKernelGGL(mega, dim3(grid), dim3(512), LDS_BYTES, stream, p); }
#endif
}
```

```cpp
#include <hip/hip_runtime.h>
#include <hip/hip_cooperative_groups.h>
#include <cstdio>
namespace cg = cooperative_groups;
namespace pg8 {
#define PG8_LAS __attribute__((address_space(3)))
typedef unsigned short bf16_t;
typedef short bf16x8 __attribute__((ext_vector_type(8)));
typedef float f32x4 __attribute__((ext_vector_type(4)));
typedef unsigned u32x4 __attribute__((ext_vector_type(4)));
constexpr int BM = 256, BK = 64, HALF = 128, HTB = HALF * BK * 2  , STAGE_BYTES = 8 * HTB, NXCD = 8, WGM = 4;

__host__ __device__ __forceinline__ int lds_byte(int r, int c) { const int st = (r >> 4) * 2 + (c >> 5), rr = r & 15, cc = c & 31, ob = rr * 64 + cc * 2; return st * 1024 + (ob ^ (((ob >> 9) & 1) << 5)); }
__host__ __device__ __forceinline__ void stage_rc(int b, int& R, int& C) { const int st = b / 1024, sb = b % 1024, swz = sb ^ (((sb >> 9) & 1) << 5); R = (st >> 1) * 16 + swz / 64; C = (st & 1) * 32 + (swz % 64) / 2; }
__host__ __device__ __forceinline__ int perm32(int rho) { const int n = rho >> 4, i = rho & 15; return 8 * (i >> 2) + 4 * n + (i & 3); }

struct Unit { int pm, pn; };
struct Gemm { const bf16_t* A; const bf16_t* Bt; int M, N, K; };

struct StaticOrder {
    int nM, nN, nwg, G, c;
    __host__ __device__ void init(int M, int N, int G_, int c_) { nM = M / BM; nN = N / BM; nwg = nM * nN; G = G_; c = c_; }
    __host__ __device__ bool next(int i, Unit& u) const {
        const long L = (long)i * G + c; if (L >= nwg) return false;
        int wgid = (int)L; { const int q = nwg / NXCD, r = nwg % NXCD, xcd = wgid % NXCD, off = wgid / NXCD; wgid = (xcd < r ? xcd * (q + 1) : r * (q + 1) + (xcd - r) * q) + off; }
        const int nig = WGM * nN, gid = wgid / nig, fm = gid * WGM, gsz = (nM - fm) < WGM ? (nM - fm) : WGM;
        u.pm = fm + ((wgid % nig) % gsz); u.pn = (wgid % nig) / gsz; return true;
    }
    __device__ __forceinline__ void a_ready(const Unit&) const {}
    __device__ __forceinline__ void done(const Unit&) const {}
};
__device__ __forceinline__ unsigned cvt_pk_bf16(float lo, float hi) { unsigned r; asm volatile("v_cvt_pk_bf16_f32 %0, %1, %2" : "=v"(r) : "v"(lo), "v"(hi)); return r; }
typedef float f32x2 __attribute__((ext_vector_type(2)));
template <class Epi, class Sched, bool ALIGN_EPI = false, bool SP2 = false>
__device__ __forceinline__ void gemm_phase(PG8_LAS unsigned char* lds, const Gemm g, const Sched& S, const Epi& E) {
    int tid_ = threadIdx.x; asm volatile("" : "+v"(tid_)); const int tid = tid_, wid = __builtin_amdgcn_readfirstlane(tid >> 6), lane = tid & 63, wr = wid >> 2, wc = wid & 3, fr = lane & 15, fq = lane >> 4;
    const int K = g.K, nt = K / BK;
    unsigned voffA[2], voffB[2];
#pragma unroll
    for (int i = 0; i < 2; ++i) { int R, C; stage_rc(tid * 16 + i * 8192, R, C); const int Rb = Epi::PERM ? ((R & ~31) + perm32(R & 31)) : R;
        voffA[i] = (unsigned)(R * K + C) * 2u; voffB[i] = (unsigned)(Rb * K + C) * 2u; }
    const size_t kstep = (size_t)(BK * 2);
    const size_t hstep = (size_t)HALF * K * 2;
    const size_t tstep = 2 * hstep;
    const unsigned ldsw = (unsigned)wid * 1024u;
    const int aoff = lds_byte(wr * 64 + fr, fq * 8), boff = lds_byte(wc * 32 + fr, fq * 8);
#define PG8_SA(b, h) (((b) * 2 + (h)) * HTB)
#define PG8_SB(b, h) ((4 + (b) * 2 + (h)) * HTB)
#define PG8_STAGE(bufoff, gbase, voff) do { _Pragma("unroll") for (int _i = 0; _i < 2; ++_i) \
        __builtin_amdgcn_global_load_lds((const unsigned*)((const char*)(gbase) + (voff)[_i]), (PG8_LAS unsigned*)(lds + (bufoff) + ldsw + _i * 8192), 16, 0, 0); } while (0)
#define PG8_LDA(dst, b, h) do { _Pragma("unroll") for (int m = 0; m < 4; ++m) _Pragma("unroll") for (int k = 0; k < 2; ++k) dst[m][k] = *(const PG8_LAS bf16x8*)(lds + PG8_SA(b, h) + aoff + m * 2048 + k * 1024); } while (0)
#define PG8_LDB(dst, b, h) do { _Pragma("unroll") for (int n = 0; n < 2; ++n) _Pragma("unroll") for (int k = 0; k < 2; ++k) dst[n][k] = *(const PG8_LAS bf16x8*)(lds + PG8_SB(b, h) + boff + n * 2048 + k * 1024); } while (0)
#define PG8_MMA(ai, bj, At, Bt) do { __builtin_amdgcn_s_setprio(1); _Pragma("unroll") for (int m = 0; m < 4; ++m) _Pragma("unroll") for (int n = 0; n < 2; ++n) _Pragma("unroll") for (int k = 0; k < 2; ++k) \
        acc[ai][bj][m][n] = __builtin_amdgcn_mfma_f32_16x16x32_bf16(Bt[n][k], At[m][k], acc[ai][bj][m][n], 0, 0, 0); __builtin_amdgcn_s_setprio(0); } while (0)
#define PG8_WAIT_V(n) asm volatile("s_waitcnt vmcnt(" #n ")" ::: "memory")
#define PG8_WAIT_L(n) asm volatile("s_waitcnt lgkmcnt(" #n ")" ::: "memory")
#define PG8_BAR __builtin_amdgcn_s_barrier()
#define PG8_SCHED __builtin_amdgcn_sched_barrier(0)
    Unit cur, nxt; int ui = 0;
    if (!S.next(0, cur)) return;
    f32x4 acc[2][2][4][2];
    E.init(acc, cur, wr, wc, fr, fq);
    bf16x8 At[4][2], B0[2][2], B1[2][2];
    const char* cA = (const char*)g.A + (size_t)cur.pm * tstep; const char* cB = (const char*)g.Bt + (size_t)cur.pn * tstep;
    S.a_ready(cur);
    if constexpr (SP2) {
        PG8_STAGE(PG8_SB(0, 0), cB, voffB); PG8_STAGE(PG8_SB(0, 1), cB + hstep, voffB); PG8_STAGE(PG8_SA(0, 0), cA, voffA); PG8_STAGE(PG8_SA(0, 1), cA + hstep, voffA);
        if (wr == 1) PG8_BAR;
        PG8_WAIT_V(2); PG8_BAR;
        PG8_STAGE(PG8_SB(1, 0), cB + kstep, voffB); PG8_STAGE(PG8_SA(1, 0), cA + kstep, voffA); PG8_STAGE(PG8_SB(1, 1), cB + hstep + kstep, voffB);
        PG8_WAIT_V(6); PG8_BAR;
    } else {
        PG8_STAGE(PG8_SB(0, 0), cB, voffB); PG8_STAGE(PG8_SA(0, 0), cA, voffA); PG8_STAGE(PG8_SB(0, 1), cB + hstep, voffB); PG8_STAGE(PG8_SA(0, 1), cA + hstep, voffA);
        if (wr == 1) PG8_BAR;
        PG8_WAIT_V(4); PG8_BAR;
        PG8_STAGE(PG8_SB(1, 0), cB + kstep, voffB); PG8_STAGE(PG8_SA(1, 0), cA + kstep, voffA); PG8_STAGE(PG8_SB(1, 1), cB + hstep + kstep, voffB);
        PG8_WAIT_V(6); PG8_BAR;
    }
    for (;;) {
        const bool has_next = S.next(ui + 1, nxt);
        const char* nA = has_next ? (const char*)g.A + (size_t)nxt.pm * tstep : cA; const char* nB = has_next ? (const char*)g.Bt + (size_t)nxt.pn * tstep : cB;
        for (int t = 0; t < nt; t += 2) {
            const bool last = (t == nt - 2);
            const char* a1 = cA + (size_t)(t + 1) * kstep;
            const char* a2 = last ? nA : cA + (size_t)(t + 2) * kstep; const char* b2 = last ? nB : cB + (size_t)(t + 2) * kstep;
            const char* a3 = a2 + kstep; const char* b3 = b2 + kstep;
            if (last && has_next) S.a_ready(nxt);
            if constexpr (SP2) {
            PG8_LDB(B0, 0, 0); PG8_LDB(B1, 0, 1); PG8_SCHED; PG8_LDA(At, 0, 0); PG8_STAGE(PG8_SA(1, 1), a1 + hstep, voffA);
            PG8_WAIT_V(8); PG8_WAIT_L(0); PG8_BAR; PG8_MMA(0, 0, At, B0); PG8_MMA(0, 1, At, B1); PG8_BAR; PG8_SCHED;
            PG8_LDA(At, 0, 1); PG8_STAGE(PG8_SB(0, 0), b2, voffB); PG8_STAGE(PG8_SB(0, 1), b2 + hstep, voffB); PG8_STAGE(PG8_SA(0, 0), a2, voffA);
            PG8_WAIT_V(8); PG8_WAIT_L(0); PG8_BAR; PG8_MMA(1, 0, At, B0); PG8_MMA(1, 1, At, B1); PG8_BAR; PG8_SCHED;
            PG8_LDB(B0, 1, 0); PG8_LDB(B1, 1, 1); PG8_SCHED; PG8_LDA(At, 1, 0); PG8_STAGE(PG8_SA(0, 1), a2 + hstep, voffA);
            PG8_WAIT_V(8); PG8_WAIT_L(0); PG8_BAR; PG8_MMA(0, 0, At, B0); PG8_MMA(0, 1, At, B1); PG8_BAR; PG8_SCHED;
            PG8_LDA(At, 1, 1); PG8_STAGE(PG8_SB(1, 0), b3, voffB); PG8_STAGE(PG8_SB(1, 1), b3 + hstep, voffB); PG8_STAGE(PG8_SA(1, 0), a3, voffA);
            PG8_WAIT_V(8); PG8_WAIT_L(0); PG8_BAR; PG8_MMA(1, 0, At, B0); PG8_MMA(1, 1, At, B1); PG8_BAR; PG8_SCHED;
            } else {
            PG8_LDB(B0, 0, 0); PG8_SCHED; PG8_LDA(At, 0, 0); PG8_STAGE(PG8_SA(1, 1), a1 + hstep, voffA);
            PG8_WAIT_L(8); PG8_BAR; PG8_WAIT_L(0); PG8_MMA(0, 0, At, B0); PG8_BAR; PG8_SCHED;
            PG8_LDB(B1, 0, 1); PG8_STAGE(PG8_SB(0, 0), b2, voffB);
            PG8_BAR; PG8_WAIT_L(0); PG8_MMA(0, 1, At, B1); PG8_BAR;
            PG8_LDA(At, 0, 1); PG8_STAGE(PG8_SA(0, 0), a2, voffA);
            PG8_BAR; PG8_WAIT_L(0); PG8_MMA(1, 0, At, B0); PG8_BAR; PG8_SCHED;
            PG8_STAGE(PG8_SB(0, 1), b2 + hstep, voffB);
            PG8_WAIT_V(6); PG8_BAR; PG8_MMA(1, 1, At, B1); PG8_BAR;
            PG8_LDB(B0, 1, 0); PG8_SCHED; PG8_LDA(At, 1, 0); PG8_STAGE(PG8_SA(0, 1), a2 + hstep, voffA);
            PG8_WAIT_L(8); PG8_BAR; PG8_WAIT_L(0); PG8_MMA(0, 0, At, B0); PG8_BAR; PG8_SCHED;
            PG8_LDB(B1, 1, 1); PG8_STAGE(PG8_SB(1, 0), b3, voffB);
            PG8_BAR; PG8_WAIT_L(0); PG8_MMA(0, 1, At, B1); PG8_BAR;
            PG8_LDA(At, 1, 1); PG8_STAGE(PG8_SA(1, 0), a3, voffA);
            PG8_BAR; PG8_WAIT_L(0); PG8_MMA(1, 0, At, B0); PG8_BAR; PG8_SCHED;
            PG8_STAGE(PG8_SB(1, 1), b3 + hstep, voffB);
            PG8_WAIT_V(6); PG8_BAR; PG8_MMA(1, 1, At, B1); PG8_BAR;
            }
        }
        if constexpr (ALIGN_EPI) { if (wr == 0) PG8_BAR; }
        if constexpr (!Epi::AFTER_DRAIN) { E(acc, cur, wr, wc, fr, fq); S.done(cur); }
        if (!has_next) break;
        E.init(acc, nxt, wr, wc, fr, fq);
        cur = nxt; cA = nA; cB = nB; ++ui;
        if constexpr (ALIGN_EPI) { if (wr == 1) PG8_BAR; }
    }
    PG8_WAIT_V(0);
    if constexpr (!ALIGN_EPI) { if (wr == 0) PG8_BAR; }
    PG8_BAR;
    if constexpr (Epi::AFTER_DRAIN) { E.fused(acc, cur, wr, wc, fr, fq, lds, wid, lane); S.done(cur); }
#undef PG8_SA
#undef PG8_SB
#undef PG8_STAGE
#undef PG8_LDA
#undef PG8_LDB
#undef PG8_MMA
#undef PG8_WAIT_V
#undef PG8_WAIT_L
#undef PG8_BAR
#undef PG8_SCHED
}
}

#define LAS __attribute__((address_space(3)))
typedef unsigned short bf16_t;
typedef float f32x4 __attribute__((ext_vector_type(4)));
typedef unsigned u32x4 __attribute__((ext_vector_type(4)));
constexpr int TOK = 8192, SEQ = 2048, DM = 4096, NIN = 11792, NPAD = 12032;
constexpr int C_GQ = 0, C_GK = 512, C_GV = 1024, C_SQ = 2048, C_SK = 3072, C_SV = 3328, C_DQ = 3584, C_DK = 4608, C_DV = 5632, C_RX = 6656, C_GATE = 7680, C_GA = 11776;
constexpr float EPS = 1e-6f;
constexpr int LDS_BYTES = 152 * 1024;
constexpr int NPH = 10;
constexpr int XCD_BAR_WORDS_C = 3456;
constexpr size_t WS_WIN = 0;
constexpr size_t SZ_WIN = (size_t)NPAD * DM * 2;
constexpr size_t WS_WOUT = WS_WIN + 2 * SZ_WIN;
constexpr size_t SZ_WOUT = (size_t)DM * DM * 2;
constexpr size_t WS_H = WS_WOUT + 2 * SZ_WOUT;
constexpr size_t WS_PROJ = WS_H + (size_t)TOK * DM * 2;
constexpr size_t WS_Y = WS_PROJ + (size_t)TOK * NPAD * 2;
constexpr size_t WS_X1 = WS_Y + (size_t)TOK * DM * 2;
constexpr size_t WS_LA = WS_X1 + (size_t)TOK * DM * 4;
constexpr size_t WS_LU = WS_LA + (size_t)TOK * 1024 * 4;
constexpr size_t WS_GP = WS_LU + (size_t)TOK * 1024 * 4;
constexpr size_t WS_END = WS_GP + (size_t)1024 * 41216;

struct Params { const float* in[24]; float* out; unsigned char* ws; int ph_lo, ph_hi; };

__device__ __forceinline__ int tid_opaque() { int t = threadIdx.x; asm volatile("" : "+v"(t)); return t; }
__device__ __forceinline__ float bf2f(bf16_t b) { return __uint_as_float(((unsigned)b) << 16); }
typedef __bf16 bf16v2_t __attribute__((ext_vector_type(2)));
typedef float f32v2_t __attribute__((ext_vector_type(2)));
__device__ __forceinline__ unsigned cvt2(float lo, float hi) { f32v2_t f = {lo, hi}; bf16v2_t b = __builtin_convertvector(f, bf16v2_t); return __builtin_bit_cast(unsigned, b); }
__device__ __forceinline__ bf16_t f2bf(float f) { return (bf16_t)(cvt2(f, f) & 0xffffu); }
__device__ __forceinline__ unsigned pk2(float lo, float hi) { return cvt2(lo, hi); }
__device__ __forceinline__ float wsum(float v) { for (int o = 32; o; o >>= 1) v += __shfl_xor(v, o); return v; }
__device__ __forceinline__ float wmax(float v) { for (int o = 32; o; o >>= 1) v = fmaxf(v, __shfl_xor(v, o)); return v; }
__device__ __forceinline__ float siluf(float x) { return x / (1.f + __expf(-x)); }
__device__ __forceinline__ float sigmf(float x) { return 1.f / (1.f + __expf(-x)); }
__device__ __forceinline__ void unpack8(const uint4 u, float* f) {
    f[0] = __uint_as_float(u.x << 16); f[1] = __uint_as_float(u.x & 0xffff0000u); f[2] = __uint_as_float(u.y << 16); f[3] = __uint_as_float(u.y & 0xffff0000u);
    f[4] = __uint_as_float(u.z << 16); f[5] = __uint_as_float(u.z & 0xffff0000u); f[6] = __uint_as_float(u.w << 16); f[7] = __uint_as_float(u.w & 0xffff0000u);
}

struct EpiProj {
    static constexpr bool PERM = true, AFTER_DRAIN = false;
    bf16_t* O;
    __device__ __forceinline__ void init(f32x4 (&acc)[2][2][4][2], const pg8::Unit&, int, int, int, int) const {
#pragma unroll
        for (int a = 0; a < 2; ++a)
#pragma unroll
            for (int b = 0; b < 2; ++b)
#pragma unroll
                for (int m = 0; m < 4; ++m)
#pragma unroll
                    for (int n = 0; n < 2; ++n) acc[a][b][m][n] = (f32x4){0.f, 0.f, 0.f, 0.f};
    }
    __device__ __forceinline__ void operator()(const f32x4 (&acc)[2][2][4][2], const pg8::Unit& u, int wr, int wc, int fr, int fq) const {
        const int row0 = u.pm * 256 + wr * 64 + fr, col0 = u.pn * 256 + wc * 32 + 8 * fq;
        const bool act = (u.pn >= 30 && u.pn < 46);
#pragma unroll
        for (int ai = 0; ai < 2; ++ai)
#pragma unroll
            for (int m = 0; m < 4; ++m) { bf16_t* rowp = O + (size_t)(row0 + ai * 128 + m * 16) * NPAD + col0;
#pragma unroll
                for (int bj = 0; bj < 2; ++bj) { f32x4 v0 = acc[ai][bj][m][0], v1 = acc[ai][bj][m][1];
                    if (act) {
#pragma unroll
                        for (int j = 0; j < 4; ++j) { v0[j] = v0[j] * __builtin_amdgcn_rcpf(1.f + __builtin_amdgcn_exp2f(-1.4426950408889634f * v0[j])); v1[j] = v1[j] * __builtin_amdgcn_rcpf(1.f + __builtin_amdgcn_exp2f(-1.4426950408889634f * v1[j])); } }
                    u32x4 w; w.x = pg8::cvt_pk_bf16(v0[0], v0[1]); w.y = pg8::cvt_pk_bf16(v0[2], v0[3]); w.z = pg8::cvt_pk_bf16(v1[0], v1[1]); w.w = pg8::cvt_pk_bf16(v1[2], v1[3]);
                    *(u32x4*)(rowp + bj * 128) = w; } }
    }
};
struct EpiRes {
    static constexpr bool PERM = false, AFTER_DRAIN = false;
    const float* R; float* C;
    __device__ __forceinline__ void init(f32x4 (&acc)[2][2][4][2], const pg8::Unit& u, int wr, int wc, int fr, int fq) const {
        const int row0 = u.pm * 256 + wr * 64 + fr, col0 = u.pn * 256 + wc * 32 + 4 * fq;
#pragma unroll
        for (int ai = 0; ai < 2; ++ai)
#pragma unroll
            for (int m = 0; m < 4; ++m) { const size_t off = (size_t)(row0 + ai * 128 + m * 16) * DM + col0;
#pragma unroll
                for (int bj = 0; bj < 2; ++bj)
#pragma unroll
                    for (int n = 0; n < 2; ++n) acc[ai][bj][m][n] = *(const f32x4*)(R + off + bj * 128 + n * 16); }
    }
    __device__ __forceinline__ void operator()(const f32x4 (&acc)[2][2][4][2], const pg8::Unit& u, int wr, int wc, int fr, int fq) const {
        const int row0 = u.pm * 256 + wr * 64 + fr, col0 = u.pn * 256 + wc * 32 + 4 * fq;
#pragma unroll
        for (int ai = 0; ai < 2; ++ai)
#pragma unroll
            for (int m = 0; m < 4; ++m) { const size_t off = (size_t)(row0 + ai * 128 + m * 16) * DM + col0;
#pragma unroll
                for (int bj = 0; bj < 2; ++bj)
#pragma unroll
                    for (int n = 0; n < 2; ++n) *(f32x4*)(C + off + bj * 128 + n * 16) = acc[ai][bj][m][n]; }
    }
};

constexpr int NDEF = 1536;
constexpr int HOST0 = 1024;
constexpr int PREP_TILES = 6016;
constexpr int DHOST_WIN = 6016 - HOST0, DHOST = DHOST_WIN + 2048 - NDEF;
struct TrTile { const float* W; bf16_t* WT; int ld, nt, kt; bool permute; };
__device__ __forceinline__ TrTile tr_tile(const Params& p, int t) {
    TrTile r; int q = t; const int l = 0;
    r.W = p.in[2] + (size_t)l * DM * NIN; r.WT = (bf16_t*)(p.ws + WS_WIN + l * SZ_WIN); r.ld = NIN; r.permute = true;
    r.nt = q >> 5; r.kt = q & 31; return r;
}
__device__ __forceinline__ void tr_load(const TrTile& T, int tid, f32x4 (&v)[4]) {
#pragma unroll
    for (int i = 0; i < 2; ++i) {
        const int idx = tid + 512 * i, kp = idx >> 4, c4 = idx & 15;
        const int nd = T.nt * 64 + c4 * 4;
        int ns = nd;
        if (T.permute) { ns = (nd < 2048) ? nd : ((nd < 11776) ? nd + 16 : ((nd < 11792) ? nd - 11776 + 2048 : -1)); }
        v[2 * i] = (f32x4){0.f, 0.f, 0.f, 0.f}; v[2 * i + 1] = v[2 * i];
        if (ns >= 0) { const float* q = T.W + (size_t)(T.kt * 128 + 2 * kp) * T.ld + ns; v[2 * i] = __builtin_nontemporal_load((const f32x4*)q); v[2 * i + 1] = __builtin_nontemporal_load((const f32x4*)(q + T.ld)); }
    }
}
__device__ __forceinline__ void tr_stage(int tid, const f32x4 (&v)[4], unsigned* lds) {
#pragma unroll
    for (int i = 0; i < 2; ++i) {
        const int idx = tid + 512 * i, kp = idx >> 4, c4 = idx & 15;
        const f32x4 a = v[2 * i], b = v[2 * i + 1];
        unsigned* d = lds + kp * 65 + c4 * 4;
        d[0] = pk2(a[0], b[0]); d[1] = pk2(a[1], b[1]); d[2] = pk2(a[2], b[2]); d[3] = pk2(a[3], b[3]);
    }
}
__device__ __forceinline__ void tr_flush(const TrTile& T, int tid, const unsigned* lds) {
#pragma unroll
    for (int i = 0; i < 2; ++i) {
        const int idx = tid + 512 * i, kc = idx & 15, n = idx >> 4;
        uint4 o; o.x = lds[(kc * 4 + 0) * 65 + n]; o.y = lds[(kc * 4 + 1) * 65 + n]; o.z = lds[(kc * 4 + 2) * 65 + n]; o.w = lds[(kc * 4 + 3) * 65 + n];
        *(uint4*)(T.WT + (size_t)(T.nt * 64 + n) * DM + T.kt * 128 + kc * 8) = o;
    }
}
__device__ __forceinline__ void tr_store(const TrTile& T, int tid, const f32x4 (&v)[4], unsigned* lds) {
#pragma unroll
    for (int i = 0; i < 2; ++i) {
        const int idx = tid + 512 * i, kp = idx >> 4, c4 = idx & 15;
        const f32x4 a = v[2 * i], b = v[2 * i + 1];
        unsigned* d = lds + kp * 65 + c4 * 4;
        d[0] = pk2(a[0], b[0]); d[1] = pk2(a[1], b[1]); d[2] = pk2(a[2], b[2]); d[3] = pk2(a[3], b[3]);
    }
    __syncthreads();
#pragma unroll
    for (int i = 0; i < 2; ++i) {
        const int idx = tid + 512 * i, kc = idx & 15, n = idx >> 4;
        uint4 o; o.x = lds[(kc * 4 + 0) * 65 + n]; o.y = lds[(kc * 4 + 1) * 65 + n]; o.z = lds[(kc * 4 + 2) * 65 + n]; o.w = lds[(kc * 4 + 3) * 65 + n];
        *(uint4*)(T.WT + (size_t)(T.nt * 64 + n) * DM + T.kt * 128 + kc * 8) = o;
    }
    __syncthreads();
}

template <bool NT>
__device__ __forceinline__ void rmsnorm_rows(const float* __restrict__ X, const float* __restrict__ w, bf16_t* __restrict__ H) {
    const int tid = tid_opaque(), lane = tid & 63, wave = tid >> 6;
    for (int row = blockIdx.x * 8 + wave; row < TOK; row += gridDim.x * 8) {
        const f32x4* xp = (const f32x4*)(X + (size_t)row * DM);
        f32x4 v[16]; float ss = 0.f;
#pragma unroll
        for (int i = 0; i < 16; ++i) { v[i] = NT ? __builtin_nontemporal_load(xp + lane + 64 * i) : xp[lane + 64 * i]; ss += v[i][0] * v[i][0] + v[i][1] * v[i][1] + v[i][2] * v[i][2] + v[i][3] * v[i][3]; }
        ss = wsum(ss);
        const float rstd = rsqrtf(ss * (1.f / DM) + EPS);
#pragma unroll
        for (int i = 0; i < 16; ++i) { const float4 g = ((const float4*)w)[lane + 64 * i];
            uint2 o; o.x = pk2(v[i][0] * rstd * g.x, v[i][1] * rstd * g.y); o.y = pk2(v[i][2] * rstd * g.z, v[i][3] * rstd * g.w);
            *(uint2*)(H + (size_t)row * DM + 4 * (lane + 64 * i)) = o; }
    }
}

__device__ __forceinline__ void phase_prep(const Params& p, unsigned char* lds) {
    const bool rows_first = (blockIdx.x & 1) != 0;
    if (rows_first) rmsnorm_rows<true>(p.in[0], p.in[1], (bf16_t*)(p.ws + WS_H));
    { const int tid = tid_opaque();
      f32x4 va[4], vb[4];
      int t = blockIdx.x;
      TrTile T = tr_tile(p, t < PREP_TILES ? t : 0);
      if (t < PREP_TILES) tr_load(T, tid, va);
#pragma unroll 1
      while (t < PREP_TILES) {
          const int tn = t + gridDim.x;
          const TrTile Tn = tr_tile(p, tn < PREP_TILES ? tn : 0);
          if (tn < PREP_TILES) tr_load(Tn, tid, vb);
          tr_store(T, tid, va, (unsigned*)lds);
#pragma unroll
          for (int i = 0; i < 4; ++i) va[i] = vb[i];
          T = Tn; t = tn;
      } }
    if (!rows_first) rmsnorm_rows<true>(p.in[0], p.in[1], (bf16_t*)(p.ws + WS_H));
}

__device__ __forceinline__ bool host_tile(const Params& p, int l, int hidx, TrTile& T) {
    if (l == 0) { if (hidx >= HOST0) return false;
        T.W = p.in[2] + (size_t)DM * NIN; T.WT = (bf16_t*)(p.ws + WS_WIN + SZ_WIN); T.ld = NIN; T.permute = true; T.nt = hidx >> 5; T.kt = hidx & 31; return true; }
    const int r = NDEF + hidx; if (r >= 2048) return false;
    T.W = p.in[3] + (size_t)DM * DM; T.WT = (bf16_t*)(p.ws + WS_WOUT + SZ_WOUT); T.ld = DM; T.permute = false; T.nt = r >> 5; T.kt = r & 31; return true;
}
__device__ __forceinline__ bool diff_host_tile(const Params& p, int l, int s, TrTile& T) {
    if (l != 0 || s >= DHOST) return false;
    if (s < DHOST_WIN) { const int q = HOST0 + s; T.W = p.in[2] + (size_t)DM * NIN; T.WT = (bf16_t*)(p.ws + WS_WIN + SZ_WIN); T.ld = NIN; T.permute = true; T.nt = q >> 5; T.kt = q & 31; return true; }
    const int r = NDEF + (s - DHOST_WIN); T.W = p.in[3]; T.WT = (bf16_t*)(p.ws + WS_WOUT); T.ld = DM; T.permute = false; T.nt = r >> 5; T.kt = r & 31; return true;
}
__device__ __forceinline__ TrTile tr_tile_wout(const Params& p, int l, int r) {
    TrTile T; T.W = p.in[3] + (size_t)l * DM * DM; T.WT = (bf16_t*)(p.ws + WS_WOUT + l * SZ_WOUT); T.ld = DM; T.permute = false; T.nt = r >> 5; T.kt = r & 31; return T;
}
__device__ __forceinline__ void convert_deferred(const Params& p, int l, int rank, int nidle, unsigned char* lds) {
    const int tid = tid_opaque();
    f32x4 va[4], vb[4];
    int r = rank;
    TrTile T = tr_tile_wout(p, l, r < NDEF ? r : 0);
    if (r < NDEF) tr_load(T, tid, va);
#pragma unroll 1
    while (r < NDEF) {
        const int rn = r + nidle;
        const TrTile Tn = tr_tile_wout(p, l, rn < NDEF ? rn : 0);
        if (rn < NDEF) tr_load(Tn, tid, vb);
        tr_store(T, tid, va, (unsigned*)lds);
#pragma unroll
        for (int i = 0; i < 4; ++i) va[i] = vb[i];
        T = Tn; r = rn;
    }
}

struct LayerW {
    const float *gla_w_up, *gla_b_up, *gla_nw, *swa_qn, *swa_kn, *swa_sinks, *dq_n, *dk_n, *lq1, *lk1, *lq2, *lk2, *d_on, *conv_w, *conv_b, *w_r, *b_r, *w_i, *b_i, *lam;
    float lambda_init;
};
__device__ __forceinline__ LayerW layer_w(const Params& p, int l) {
    LayerW w;
    w.gla_w_up = p.in[4] + l * 16 * 512; w.gla_b_up = p.in[5] + l * 512; w.gla_nw = p.in[6] + l * 128;
    w.swa_qn = p.in[7] + l * 128; w.swa_kn = p.in[8] + l * 128; w.swa_sinks = p.in[9] + l * 8;
    w.dq_n = p.in[10] + l * 64; w.dk_n = p.in[11] + l * 64; w.lq1 = p.in[12] + l * 64; w.lk1 = p.in[13] + l * 64; w.lq2 = p.in[14] + l * 64; w.lk2 = p.in[15] + l * 64;
    w.d_on = p.in[16] + l * 128; w.conv_w = p.in[17] + l * 4096; w.conv_b = p.in[18] + l * 1024;
    w.w_r = p.in[19] + l * 8 * 128 * 128; w.b_r = p.in[20] + l * 1024; w.w_i = p.in[21] + l * 8 * 128 * 128; w.b_i = p.in[22] + l * 1024; w.lam = p.in[23] + l * 1024;
    w.lambda_init = 0.8f - 0.6f * expf(-0.3f * (float)l);
    return w;
}

__device__ void gla_simple(const bf16_t* __restrict__ P, bf16_t* __restrict__ Y, const LayerW& W, int bh, float* lds) {
    const int b = bh >> 3, h = bh & 7, tid = tid_opaque();
    float* sAl = lds; float* sQ = sAl + 2048; float* sK = sQ + 2048; float* sV = sK + 2048; float* sPo = sV + 4096; float* sW = sPo + 16384;
    __syncthreads();
    for (int i = tid; i < 1024; i += 512) sW[i] = W.gla_w_up[(i >> 6) * 512 + h * 64 + (i & 63)];
    if (tid < 64) sW[1024 + tid] = W.gla_b_up[h * 64 + tid];
    const int v = tid & 127, dg = tid >> 7;
    float s[16];
#pragma unroll
    for (int i = 0; i < 16; ++i) s[i] = 0.f;
    for (int c = 0; c < 64; ++c) {
        __syncthreads();
        const int tok0 = b * SEQ + c * 32;
        for (int i = tid; i < 2048; i += 512) { const int tt = i >> 6, d = i & 63; const bf16_t* row = P + (size_t)(tok0 + tt) * NPAD;
            float lg = sW[1024 + d];
#pragma unroll
            for (int r = 0; r < 16; ++r) lg += bf2f(row[C_GA + r]) * sW[r * 64 + d];
            const float ls = fminf(lg, 0.f) - log1pf(expf(-fabsf(lg)));
            sAl[i] = expf(ls * (1.f / 16.f));
            sQ[i] = bf2f(row[C_GQ + h * 64 + d]) * 0.125f;
            sK[i] = bf2f(row[C_GK + h * 64 + d]); }
        for (int i = tid; i < 4096; i += 512) { const int tt = i >> 7, vv = i & 127; sV[i] = bf2f(P[(size_t)(tok0 + tt) * NPAD + C_GV + h * 128 + vv]); }
        __syncthreads();
        for (int tt = 0; tt < 32; ++tt) {
            const float vt = sV[tt * 128 + v]; float po = 0.f;
#pragma unroll
            for (int i = 0; i < 16; ++i) { const int d = dg * 16 + i; s[i] = sAl[tt * 64 + d] * s[i] + sK[tt * 64 + d] * vt; po += sQ[tt * 64 + d] * s[i]; }
            sPo[(dg * 32 + tt) * 128 + v] = po;
        }
        __syncthreads();
        { const int tt = tid >> 4, v0 = (tid & 15) * 8; float o[8]; float ss = 0.f;
#pragma unroll
            for (int j = 0; j < 8; ++j) { o[j] = sPo[(0 * 32 + tt) * 128 + v0 + j] + sPo[(1 * 32 + tt) * 128 + v0 + j] + sPo[(2 * 32 + tt) * 128 + v0 + j] + sPo[(3 * 32 + tt) * 128 + v0 + j]; ss += o[j] * o[j]; }
            ss += __shfl_xor(ss, 1); ss += __shfl_xor(ss, 2); ss += __shfl_xor(ss, 4); ss += __shfl_xor(ss, 8);
            const float rstd = rsqrtf(ss * (1.f / 128.f) + EPS);
            const bf16_t* gp = P + (size_t)(tok0 + tt) * NPAD + C_GATE + h * 128 + v0;
            bf16_t* yp = Y + (size_t)(tok0 + tt) * DM + h * 128 + v0;
#pragma unroll
            for (int j = 0; j < 8; ++j) yp[j] = f2bf(o[j] * rstd * W.gla_nw[v0 + j] * bf2f(gp[j])); }
    }
    __syncthreads();
}

__device__ void swa_simple_row(const bf16_t* __restrict__ P, bf16_t* __restrict__ Y, const LayerW& W, int row, float* wl) {
    const int lane = tid_opaque() & 63;
    const int bh = row & 31, b = bh >> 3, hq = bh & 7, q = row >> 5, kvh = hq >> 2;
    const size_t tok = (size_t)b * SEQ + q;
    const bf16_t* qp = P + tok * NPAD + C_SQ + hq * 128;
    const float q0 = bf2f(qp[2 * lane]), q1 = bf2f(qp[2 * lane + 1]);
    const float rq = rsqrtf(wsum(q0 * q0 + q1 * q1) * (1.f / 128.f) + EPS) * 0.08838834764831845f;
    __threadfence_block();
    wl[2 * lane] = q0 * rq * W.swa_qn[2 * lane] * W.swa_kn[2 * lane];
    wl[2 * lane + 1] = q1 * rq * W.swa_qn[2 * lane + 1] * W.swa_kn[2 * lane + 1];
    __threadfence_block();
    const float slope = exp2f(-(float)(hq + 1)), sink = W.swa_sinks[hq];
    float sc[2];
#pragma unroll
    for (int i = 0; i < 2; ++i) {
        const int j = q - 127 + lane + 64 * i;
        sc[i] = -INFINITY;
        if (j >= 0) { const uint4* kp = (const uint4*)(P + ((size_t)b * SEQ + j) * NPAD + C_SK + kvh * 128);
            float dot = 0.f, ssk = 0.f;
            for (int c = 0; c < 16; ++c) { float f[8]; unpack8(kp[c], f);
#pragma unroll
                for (int e = 0; e < 8; ++e) { dot += wl[c * 8 + e] * f[e]; ssk += f[e] * f[e]; } }
            sc[i] = dot * rsqrtf(ssk * (1.f / 128.f) + EPS) - slope * (float)(q - j); }
    }
    const float m = fmaxf(wmax(fmaxf(sc[0], sc[1])), sink);
    const float p0 = (sc[0] == -INFINITY) ? 0.f : __expf(sc[0] - m), p1 = (sc[1] == -INFINITY) ? 0.f : __expf(sc[1] - m);
    const float inv = 1.f / (wsum(p0 + p1) + __expf(sink - m));
    wl[128 + lane] = p0 * inv; wl[192 + lane] = p1 * inv;
    __threadfence_block();
    float o0 = 0.f, o1 = 0.f;
    for (int jj = 0; jj < 128; ++jj) { const int j = q - 127 + jj; if (j < 0) continue;
        const unsigned vv = *(const unsigned*)(P + ((size_t)b * SEQ + j) * NPAD + C_SV + kvh * 128 + 2 * lane);
        const float pj = wl[128 + jj]; o0 += pj * __uint_as_float(vv << 16); o1 += pj * __uint_as_float(vv & 0xffff0000u); }
    const unsigned gg = *(const unsigned*)(P + tok * NPAD + C_GATE + 1024 + hq * 128 + 2 * lane);
    *(unsigned*)(Y + tok * DM + 1024 + hq * 128 + 2 * lane) = pk2(o0 * __uint_as_float(gg << 16), o1 * __uint_as_float(gg & 0xffff0000u));
    __threadfence_block();
}

__device__ void diff_simple_row(const bf16_t* __restrict__ P, bf16_t* __restrict__ Y, const LayerW& W, float lam, int row, float* wl) {
    const int lane = tid_opaque() & 63;
    const int bh = row & 31, b = bh >> 3, h = bh & 7, q = row >> 5;
    const size_t tok = (size_t)b * SEQ + q;
    const bf16_t* qp = P + tok * NPAD + C_DQ + h * 128;
    const float x0 = bf2f(qp[lane]), x1 = bf2f(qp[64 + lane]);
    const float r0 = rsqrtf(wsum(x0 * x0) * (1.f / 64.f) + EPS) * 0.125f, r1 = rsqrtf(wsum(x1 * x1) * (1.f / 64.f) + EPS) * 0.125f;
    __threadfence_block();
    wl[lane] = x0 * r0 * W.dq_n[lane] * W.dk_n[lane]; wl[64 + lane] = x1 * r1 * W.dq_n[lane] * W.dk_n[lane];
    __threadfence_block();
    float* S0 = wl + 128; float* S1 = S0 + 2048;
    const float slope = exp2f(-(float)(h + 1));
    const int nk = q + 1;
    float m0 = -INFINITY, m1 = -INFINITY;
    for (int j = lane; j < nk; j += 64) {
        const uint4* kp = (const uint4*)(P + ((size_t)b * SEQ + j) * NPAD + C_DK + h * 128);
        float d0 = 0.f, k0 = 0.f, d1 = 0.f, k1 = 0.f;
        for (int c = 0; c < 8; ++c) { float f[8]; unpack8(kp[c], f);
#pragma unroll
            for (int e = 0; e < 8; ++e) { d0 += wl[c * 8 + e] * f[e]; k0 += f[e] * f[e]; } }
        for (int c = 0; c < 8; ++c) { float f[8]; unpack8(kp[8 + c], f);
#pragma unroll
            for (int e = 0; e < 8; ++e) { d1 += wl[64 + c * 8 + e] * f[e]; k1 += f[e] * f[e]; } }
        const float al = slope * (float)(q - j);
        const float s0 = d0 * rsqrtf(k0 * (1.f / 64.f) + EPS) - al, s1 = d1 * rsqrtf(k1 * (1.f / 64.f) + EPS) - al;
        S0[j] = s0; S1[j] = s1; m0 = fmaxf(m0, s0); m1 = fmaxf(m1, s1);
    }
    m0 = wmax(m0); m1 = wmax(m1);
    float l0 = 0.f, l1 = 0.f;
    for (int j = lane; j < nk; j += 64) { l0 += __expf(S0[j] - m0); l1 += __expf(S1[j] - m1); }
    l0 = 1.f / wsum(l0); l1 = lam / wsum(l1);
    for (int j = lane; j < nk; j += 64) S0[j] = __expf(S0[j] - m0) * l0 - __expf(S1[j] - m1) * l1;
    __threadfence_block();
    float o0 = 0.f, o1 = 0.f;
    const bf16_t* vp = P + (size_t)b * SEQ * NPAD + C_DV + h * 128 + 2 * lane;
    for (int j = 0; j < nk; ++j) { const unsigned vv = *(const unsigned*)(vp + (size_t)j * NPAD); const float wj = S0[j];
        o0 += wj * __uint_as_float(vv << 16); o1 += wj * __uint_as_float(vv & 0xffff0000u); }
    const float rstd = rsqrtf(wsum(o0 * o0 + o1 * o1) * (1.f / 128.f) + EPS) * (1.f - W.lambda_init);
    const unsigned gg = *(const unsigned*)(P + tok * NPAD + C_GATE + 2048 + h * 128 + 2 * lane);
    *(unsigned*)(Y + tok * DM + 2048 + h * 128 + 2 * lane) = pk2(o0 * rstd * W.d_on[2 * lane] * __uint_as_float(gg << 16), o1 * rstd * W.d_on[2 * lane + 1] * __uint_as_float(gg & 0xffff0000u));
    __threadfence_block();
}

__device__ void lru_gates_simple(const bf16_t* __restrict__ P, float* __restrict__ LA, float* __restrict__ LU, const LayerW& W, int unit, float* sXc) {
    const int tid = tid_opaque(), tg = unit >> 3, n = unit & 7, tok0 = tg * 16, t0 = tok0 & (SEQ - 1);
    __syncthreads();
#pragma unroll
    for (int e = 0; e < 4; ++e) { const int i = tid + 512 * e, tt = i >> 7, c = i & 127, ch = n * 128 + c;
        float xc = W.conv_b[ch];
#pragma unroll
        for (int w = 0; w < 4; ++w) { const int tp = t0 + tt - 3 + w; if (tp >= 0) xc += W.conv_w[w * 1024 + ch] * bf2f(P[(size_t)(tok0 + tt - 3 + w) * NPAD + C_RX + ch]); }
        sXc[i] = xc; }
    __syncthreads();
    const int tt = tid >> 5, jg = tid & 31, ch0 = n * 128 + jg * 4;
    float4 r = *(const float4*)(W.b_r + ch0), g = *(const float4*)(W.b_i + ch0);
    const float* wr = W.w_r + (size_t)n * 16384 + jg * 4; const float* wi = W.w_i + (size_t)n * 16384 + jg * 4;
    for (int i = 0; i < 128; ++i) { const float x = sXc[tt * 128 + i]; const float4 a = *(const float4*)(wr + i * 128), c = *(const float4*)(wi + i * 128);
        r.x += x * a.x; r.y += x * a.y; r.z += x * a.z; r.w += x * a.w; g.x += x * c.x; g.y += x * c.y; g.z += x * c.z; g.w += x * c.w; }
    float rr[4] = {r.x, r.y, r.z, r.w}, gg[4] = {g.x, g.y, g.z, g.w}, av[4], uv[4];
#pragma unroll
    for (int e = 0; e < 4; ++e) { const float x = -W.lam[ch0 + e]; const float sp = (x > 20.f) ? x : log1pf(expf(x));
        const float la = -8.f * sigmf(rr[e]) * sp; av[e] = expf(la); uv[e] = sqrtf(-expm1f(2.f * la)) * sigmf(gg[e]) * sXc[tt * 128 + jg * 4 + e]; }
    *(float4*)(LA + (size_t)(tok0 + tt) * 1024 + ch0) = make_float4(av[0], av[1], av[2], av[3]);
    *(float4*)(LU + (size_t)(tok0 + tt) * 1024 + ch0) = make_float4(uv[0], uv[1], uv[2], uv[3]);
}

__device__ void lru_scan_simple(const bf16_t* __restrict__ P, bf16_t* __restrict__ Y, const float* __restrict__ LA, const float* __restrict__ LU) {
    const int tid = tid_opaque();
    if (blockIdx.x >= 64 || tid >= 64) return;
    const int gid = blockIdx.x * 64 + tid, b = gid >> 10, ch = gid & 1023;
    float h = 0.f;
    for (int t = 0; t < SEQ; t += 8) {
        float a[8], u[8], g[8];
#pragma unroll
        for (int e = 0; e < 8; ++e) { const size_t tok = (size_t)b * SEQ + t + e; a[e] = LA[tok * 1024 + ch]; u[e] = LU[tok * 1024 + ch]; g[e] = bf2f(P[tok * NPAD + C_GATE + 3072 + ch]); }
#pragma unroll
        for (int e = 0; e < 8; ++e) { h = a[e] * h + u[e]; Y[((size_t)b * SEQ + t + e) * DM + 3072 + ch] = f2bf(h * g[e]); }
    }
}

__device__ __forceinline__ float diff_lambda(const LayerW& W) {
    float a = 0.f, b = 0.f;
    for (int i = 0; i < 64; ++i) { a += W.lq1[i] * W.lk1[i]; b += W.lq2[i] * W.lk2[i]; }
    return expf(a) - expf(b) + W.lambda_init;
}


typedef short bf16x8 __attribute__((ext_vector_type(8)));
typedef short s16x4 __attribute__((ext_vector_type(4)));
typedef float f32x16 __attribute__((ext_vector_type(16)));
#define MFMA32(a, b, c) __builtin_amdgcn_mfma_f32_32x32x16_bf16((a), (b), (c), 0, 0, 0)
constexpr float LOG2E = 1.4426950408889634f;
__device__ __forceinline__ int crow(int r, int h) { return (r & 3) + 8 * (r >> 2) + 4 * h; }
__device__ __forceinline__ bf16x8 pack8(const float* f) { u32x4 u; u.x = cvt2(f[0], f[1]); u.y = cvt2(f[2], f[3]); u.z = cvt2(f[4], f[5]); u.w = cvt2(f[6], f[7]); return __builtin_bit_cast(bf16x8, u); }

template <bool SWA> struct AttnCfg {
    static constexpr int DQK = SWA ? 128 : 64, NKS = DQK / 16;
    static constexpr int KP = DQK + 8;
    static constexpr int KMAPS = SWA ? 1 : 2;
    static constexpr int KBYTES = KMAPS * 64 * KP * 2;
    static constexpr int VP = 72;
    static constexpr int VBYTES = 128 * VP * 2;
    static constexpr int ABUF = KBYTES + VBYTES;
};

template <bool SWA>
__device__ __forceinline__ void attn_item(const bf16_t* __restrict__ P, bf16_t* __restrict__ Y, const LayerW& W, float lam, int item, unsigned char* lds) {
    typedef AttnCfg<SWA> C;
    const int tid = tid_opaque(), lane = tid & 63, wave = tid >> 6, c = wave & 1, g = wave >> 1, l31 = lane & 31, hh = lane >> 5;
    int b, qb, hk  , hq  ;
    if (SWA) { qb = 15 - (item >> 4); const int r = item & 15; b = r >> 2; const int kvh = (r >> 1) & 1, gp = r & 1; hk = kvh; hq = kvh * 4 + gp * 2 + c; }
    else { qb = 15 - (item >> 5); const int r = item & 31; b = r >> 3; hk = r & 7; hq = hk; }
    const size_t tokb = (size_t)b * SEQ;
    const int q0 = qb * 128 + g * 32;
    const int qcol = SWA ? (C_SQ + hq * 128) : (C_DQ + hq * 128 + c * 64);
    const int kcol = SWA ? (C_SK + hk * 128) : (C_DK + hk * 128);
    const int vcol = SWA ? (C_SV + hk * 128) : (C_DV + hk * 128);
    const float* qnw = SWA ? W.swa_qn : W.dq_n; const float* knw = SWA ? W.swa_kn : W.dk_n;
    const float slope2 = exp2f(-(float)(hq + 1)) * LOG2E;
    bf16x8 qf[C::NKS];
    {
        const bf16_t* qp = P + (tokb + q0 + l31) * NPAD + qcol;
        float f[C::NKS][8]; float ss = 0.f;
#pragma unroll
        for (int ks = 0; ks < C::NKS; ++ks) { unpack8(*(const uint4*)(qp + 16 * ks + 8 * hh), f[ks]);
#pragma unroll
            for (int e = 0; e < 8; ++e) ss += f[ks][e] * f[ks][e]; }
        ss += __shfl_xor(ss, 32);
        const float sc = rsqrtf(ss * (1.f / C::DQK) + EPS) * (SWA ? 0.08838834764831845f : 0.125f) * LOG2E;
#pragma unroll
        for (int ks = 0; ks < C::NKS; ++ks) {
#pragma unroll
            for (int e = 0; e < 8; ++e) f[ks][e] *= sc * qnw[16 * ks + 8 * hh + e];
            qf[ks] = pack8(f[ks]); }
    }
    int t_lo = 0, t_hi = 2 * qb + 2;
    if (SWA) t_lo = (qb == 0) ? 0 : 2 * qb - 2;
    const int kkey = SWA ? (tid >> 3) : (tid >> 3), kch = tid & 7;
    const int vkey = tid & 63, vch = tid >> 6;
    uint4 rk0, rk1, rv0, rv1;
#define ATT_LOAD(t) do { const bf16_t* kp_ = P + (tokb + (t) * 64 + kkey) * NPAD + kcol + kch * 16; rk0 = ((const uint4*)kp_)[0]; rk1 = ((const uint4*)kp_)[1]; \
        const bf16_t* vp_ = P + (tokb + (t) * 64 + vkey) * NPAD + vcol + vch * 16; rv0 = ((const uint4*)vp_)[0]; rv1 = ((const uint4*)vp_)[1]; } while (0)
#define ATT_STORE(bufp) do { float f_[16]; unpack8(rk0, f_); unpack8(rk1, f_ + 8); float ss_ = 0.f; \
        _Pragma("unroll") for (int e = 0; e < 16; ++e) ss_ += f_[e] * f_[e]; \
        ss_ += __shfl_xor(ss_, 1); ss_ += __shfl_xor(ss_, 2); if (SWA) ss_ += __shfl_xor(ss_, 4); \
        const float rs_ = rsqrtf(ss_ * (1.f / C::DQK) + EPS); const int d0_ = SWA ? kch * 16 : (kch & 3) * 16; \
        _Pragma("unroll") for (int e = 0; e < 16; ++e) f_[e] *= rs_ * knw[d0_ + e]; \
        bf16_t* kd_ = (bf16_t*)(bufp) + ((SWA ? 0 : (kch >> 2) * 64) + kkey) * C::KP + d0_; \
        *(bf16x8*)kd_ = pack8(f_); *(bf16x8*)(kd_ + 8) = pack8(f_ + 8); \
        bf16_t* vd_ = (bf16_t*)((bufp) + C::KBYTES) + (vch * 16) * C::VP + vkey; \
        const unsigned vw_[8] = {rv0.x, rv0.y, rv0.z, rv0.w, rv1.x, rv1.y, rv1.z, rv1.w}; \
        _Pragma("unroll") for (int e = 0; e < 8; ++e) { vd_[(2 * e) * C::VP] = (bf16_t)(vw_[e] & 0xffffu); vd_[(2 * e + 1) * C::VP] = (bf16_t)(vw_[e] >> 16); } } while (0)

    f32x16 O[4];
#pragma unroll
    for (int vt = 0; vt < 4; ++vt)
#pragma unroll
        for (int r = 0; r < 16; ++r) O[vt][r] = 0.f;
    float m = SWA ? W.swa_sinks[hq] * LOG2E + slope2 * (float)(q0 + l31) : -INFINITY, l = SWA ? 0.5f : 0.f;
    __syncthreads();
    ATT_LOAD(t_lo);
    ATT_STORE(lds);
    __syncthreads();
    for (int t = t_lo; t < t_hi; ++t) {
        unsigned char* buf = lds + ((t - t_lo) & 1) * C::ABUF;
        unsigned char* nbuf = lds + (((t - t_lo) & 1) ^ 1) * C::ABUF;
        const bool more = (t + 1 < t_hi);
        if (more) ATT_LOAD(t + 1);
        const int k0 = t * 64;
        bool act = (k0 <= q0 + 31);
        if (SWA) act = act && (k0 + 63 >= q0 - 127);
        if (act) {
            const bf16_t* Kb = (const bf16_t*)buf + (SWA ? 0 : c * 64 * C::KP);
            f32x16 s0, s1;
            { const float kb0 = slope2 * (float)(k0 + 4 * hh), kb1 = kb0 + 32.f * slope2;
#pragma unroll
              for (int r = 0; r < 16; ++r) { const float cr = (float)((r & 3) + 8 * (r >> 2)); s0[r] = fmaf(slope2, cr, kb0); s1[r] = fmaf(slope2, cr, kb1); } }
#pragma unroll
            for (int ks = 0; ks < C::NKS; ++ks) {
                const bf16x8 a0 = *(const bf16x8*)(Kb + l31 * C::KP + 16 * ks + 8 * hh);
                const bf16x8 a1 = *(const bf16x8*)(Kb + (32 + l31) * C::KP + 16 * ks + 8 * hh);
                s0 = MFMA32(a0, qf[ks], s0); s1 = MFMA32(a1, qf[ks], s1); }
            const int dq = q0 + l31 - k0;
            const bool edge = SWA ? (k0 + 63 > q0 || k0 < q0 + 31 - 127) : (k0 + 63 > q0);
            float mx = -INFINITY;
            if (edge) {
#pragma unroll
                for (int r = 0; r < 16; ++r) { const int d0 = dq - crow(r, hh), d1 = d0 - 32;
                    if (d0 < 0 || (SWA && d0 > 127)) s0[r] = -INFINITY;
                    if (d1 < 0 || (SWA && d1 > 127)) s1[r] = -INFINITY; } }
#pragma unroll
            for (int r = 0; r < 16; ++r) { mx = __builtin_amdgcn_fmed3f(mx, s0[r], INFINITY); mx = __builtin_amdgcn_fmed3f(mx, s1[r], INFINITY); }
            mx = __builtin_amdgcn_fmed3f(mx, __shfl_xor(mx, 32), INFINITY);
            const float mn = __builtin_amdgcn_fmed3f(m, mx, INFINITY), alpha = __builtin_amdgcn_exp2f(m - mn);
            m = mn;
            s0 = s0 - mn; s1 = s1 - mn;
            f32v2_t ls2 = {0.f, 0.f};
#pragma unroll
            for (int r = 0; r < 16; r += 2) { s0[r] = __builtin_amdgcn_exp2f(s0[r]); s0[r + 1] = __builtin_amdgcn_exp2f(s0[r + 1]); s1[r] = __builtin_amdgcn_exp2f(s1[r]); s1[r + 1] = __builtin_amdgcn_exp2f(s1[r + 1]);
                ls2 += (f32v2_t){s0[r], s0[r + 1]}; ls2 += (f32v2_t){s1[r], s1[r + 1]}; }
            l = l * alpha + (ls2[0] + ls2[1]);
#pragma unroll
            for (int vt = 0; vt < 4; ++vt)
#pragma unroll
                for (int r = 0; r < 16; ++r) O[vt][r] *= alpha;
            const bf16_t* Vb = (const bf16_t*)(buf + C::KBYTES);
#pragma unroll
            for (int kt2 = 0; kt2 < 2; ++kt2)
#pragma unroll
                for (int s2 = 0; s2 < 2; ++s2) {
                    float pf[8];
#pragma unroll
                    for (int e = 0; e < 8; ++e) pf[e] = kt2 ? s1[8 * s2 + e] : s0[8 * s2 + e];
                    const bf16x8 pb = pack8(pf);
#pragma unroll
                    for (int vt = 0; vt < 4; ++vt) {
                        const bf16_t* vp = Vb + (32 * vt + l31) * C::VP + 32 * kt2 + 16 * s2 + 4 * hh;
                        const s16x4 lo = *(const s16x4*)vp, hi = *(const s16x4*)(vp + 8);
                        const bf16x8 a = __builtin_shufflevector(lo, hi, 0, 1, 2, 3, 4, 5, 6, 7);
                        O[vt] = MFMA32(a, pb, O[vt]); }
                }
        }
        if (more) ATT_STORE(nbuf);
        __syncthreads();
    }
#undef ATT_LOAD
#undef ATT_STORE
    l += __shfl_xor(l, 32);
    float* OB = (float*)lds;
    const int orow = (g * 32 + l31) * 129;
    if (SWA) {
        const float sc = 1.f / l;
#pragma unroll 1
        for (int pass = 0; pass < 2; ++pass) {
            if (c == pass) {
#pragma unroll
                for (int vt = 0; vt < 4; ++vt)
#pragma unroll
                    for (int r = 0; r < 16; ++r) OB[orow + 32 * vt + crow(r, hh)] = O[vt][r] * sc; }
            __syncthreads();
            { const int q = tid >> 2, part = tid & 3; const size_t tq = tokb + qb * 128 + q; const int hq2 = hq - c + pass;
              const bf16_t* gp = P + tq * NPAD + C_GATE + 1024 + hq2 * 128 + part * 32; bf16_t* yp = Y + tq * DM + 1024 + hq2 * 128 + part * 32;
#pragma unroll
              for (int ch = 0; ch < 4; ++ch) { float gf[8]; unpack8(*(const uint4*)(gp + ch * 8), gf); float of[8];
#pragma unroll
                  for (int e = 0; e < 8; ++e) of[e] = OB[q * 129 + part * 32 + ch * 8 + e] * gf[e];
                  *(bf16x8*)(yp + ch * 8) = pack8(of); } }
            __syncthreads();
        }
    } else {
        const float sc = (c == 0) ? 1.f / l : lam / l;
        if (c == 1) {
#pragma unroll
            for (int vt = 0; vt < 4; ++vt)
#pragma unroll
                for (int r = 0; r < 16; ++r) OB[orow + 32 * vt + crow(r, hh)] = O[vt][r] * sc; }
        __syncthreads();
        if (c == 0) {
            float ss = 0.f;
#pragma unroll
            for (int vt = 0; vt < 4; ++vt)
#pragma unroll
                for (int r = 0; r < 16; ++r) { const float o = O[vt][r] * sc - OB[orow + 32 * vt + crow(r, hh)]; O[vt][r] = o; ss += o * o; }
            ss += __shfl_xor(ss, 32);
            const float rstd = rsqrtf(ss * (1.f / 128.f) + EPS) * (1.f - W.lambda_init);
#pragma unroll
            for (int vt = 0; vt < 4; ++vt)
#pragma unroll
                for (int r = 0; r < 16; ++r) OB[orow + 32 * vt + crow(r, hh)] = O[vt][r] * rstd; }
        __syncthreads();
        { const int q = tid >> 2, part = tid & 3; const size_t tq = tokb + qb * 128 + q;
          const bf16_t* gp = P + tq * NPAD + C_GATE + 2048 + hq * 128 + part * 32; bf16_t* yp = Y + tq * DM + 2048 + hq * 128 + part * 32;
#pragma unroll
          for (int ch = 0; ch < 4; ++ch) { float gf[8]; unpack8(*(const uint4*)(gp + ch * 8), gf); float of[8];
#pragma unroll
              for (int e = 0; e < 8; ++e) of[e] = OB[q * 129 + part * 32 + ch * 8 + e] * gf[e] * W.d_on[part * 32 + ch * 8 + e];
              *(bf16x8*)(yp + ch * 8) = pack8(of); } }
        __syncthreads();
    }
}


__device__ __forceinline__ void diff_item3(const Params& p, int lay, const bf16_t* __restrict__ P, bf16_t* __restrict__ Y, const LayerW& W, float lam, int item, unsigned char* lds) {
    constexpr int KP = 72, VP = 72, KBYTES = 2 * 64 * KP * 2, ABUF = KBYTES + 128 * VP * 2;
    const int tid = tid_opaque(), lane = tid & 63, wave = tid >> 6, c = wave & 1, g = wave >> 1, l31 = lane & 31, hh = lane >> 5;
    const int qb = 15 - (item >> 5), r_ = item & 31, b = r_ >> 3, h = r_ & 7;
    const size_t tokb = (size_t)b * SEQ;
    const int q0 = qb * 128 + g * 32;
    const int kcol = C_DK + h * 128, vcol = C_DV + h * 128;
    const float slope2 = exp2f(-(float)(h + 1)) * LOG2E;
    const int kkey = tid >> 3, kch = tid & 7, vkey = tid & 63, vch = tid >> 6;
    uint4 rk0, rk1, rv0, rv1;
#define D3_KLOAD(t) do { const bf16_t* kp_ = P + (tokb + (t) * 64 + kkey) * NPAD + kcol + kch * 16; rk0 = ((const uint4*)kp_)[0]; rk1 = ((const uint4*)kp_)[1]; } while (0)
#define D3_VLOAD(t) do { const bf16_t* vp_ = P + (tokb + (t) * 64 + vkey) * NPAD + vcol + vch * 16; rv0 = ((const uint4*)vp_)[0]; rv1 = ((const uint4*)vp_)[1]; } while (0)
#define D3_KSTORE(t) do { float f_[16]; unpack8(rk0, f_); unpack8(rk1, f_ + 8); float ss_ = 0.f; \
        _Pragma("unroll") for (int e = 0; e < 16; ++e) ss_ += f_[e] * f_[e]; \
        ss_ += __shfl_xor(ss_, 1); ss_ += __shfl_xor(ss_, 2); \
        const float rs_ = rsqrtf(ss_ * (1.f / 64.f) + EPS); const int d0_ = (kch & 3) * 16; \
        _Pragma("unroll") for (int e = 0; e < 16; ++e) f_[e] *= rs_ * W.dk_n[d0_ + e]; \
        bf16_t* kd_ = (bf16_t*)(lds + ((t) & 1) * ABUF) + ((kch >> 2) * 64 + kkey) * KP + d0_; \
        *(bf16x8*)kd_ = pack8(f_); *(bf16x8*)(kd_ + 8) = pack8(f_ + 8); } while (0)
#define D3_VSTORE(t) do { bf16_t* vd_ = (bf16_t*)(lds + ((t) & 1) * ABUF + KBYTES) + (vch * 16) * VP + vkey; \
        const unsigned vw_[8] = {rv0.x, rv0.y, rv0.z, rv0.w, rv1.x, rv1.y, rv1.z, rv1.w}; \
        _Pragma("unroll") for (int e = 0; e < 8; ++e) { vd_[(2 * e) * VP] = (bf16_t)(vw_[e] & 0xffffu); vd_[(2 * e + 1) * VP] = (bf16_t)(vw_[e] >> 16); } } while (0)
#define D3_QK(t) do { const int k0_ = (t) * 64; const bf16_t* Kb_ = (const bf16_t*)(lds + ((t) & 1) * ABUF) + c * 64 * KP; \
        { const float kb0 = slope2 * (float)(k0_ + 4 * hh), kb1 = kb0 + 32.f * slope2; \
          _Pragma("unroll") for (int r = 0; r < 16; ++r) { const float cr = (float)((r & 3) + 8 * (r >> 2)); s0[r] = fmaf(slope2, cr, kb0); s1[r] = fmaf(slope2, cr, kb1); } } \
        _Pragma("unroll") for (int ks = 0; ks < 4; ++ks) { \
            const bf16x8 a0 = *(const bf16x8*)(Kb_ + l31 * KP + 16 * ks + 8 * hh), a1 = *(const bf16x8*)(Kb_ + (32 + l31) * KP + 16 * ks + 8 * hh); \
            s0 = MFMA32(a0, qf[ks], s0); s1 = MFMA32(a1, qf[ks], s1); } \
        if ((t) == tw) { const int dq = q0 + l31 - k0_; \
            _Pragma("unroll") for (int r = 0; r < 16; ++r) { const int d0 = dq - crow(r, hh), d1 = d0 - 32; if (d0 < 0) s0[r] = -INFINITY; if (d1 < 0) s1[r] = -INFINITY; } } } while (0)
#define D3_PV(tv) do { const bf16_t* Vb_ = (const bf16_t*)(lds + ((tv) & 1) * ABUF + KBYTES); \
        _Pragma("unroll") for (int i4 = 0; i4 < 4; ++i4) \
            _Pragma("unroll") for (int vt = 0; vt < 4; ++vt) { \
                const bf16_t* vp = Vb_ + (32 * vt + l31) * VP + 16 * i4 + 4 * hh; \
                const s16x4 lo = *(const s16x4*)vp, hi = *(const s16x4*)(vp + 8); \
                O[vt] = MFMA32(__builtin_shufflevector(lo, hi, 0, 1, 2, 3, 4, 5, 6, 7), pp[i4], O[vt]); } } while (0)
#define D3_SOFTMAX() do { float mx = -INFINITY; \
        _Pragma("unroll") for (int r = 0; r < 16; ++r) { mx = __builtin_amdgcn_fmed3f(mx, s0[r], INFINITY); mx = __builtin_amdgcn_fmed3f(mx, s1[r], INFINITY); } \
        mx = __builtin_amdgcn_fmed3f(mx, __shfl_xor(mx, 32), INFINITY); \
        const float mn = __builtin_amdgcn_fmed3f(m, mx, INFINITY); alpha = __builtin_amdgcn_exp2f(m - mn); m = mn; \
        float ls = 0.f; \
        _Pragma("unroll") for (int r = 0; r < 16; ++r) { s0[r] = __builtin_amdgcn_exp2f(s0[r] - mn); s1[r] = __builtin_amdgcn_exp2f(s1[r] - mn); ls += s0[r] + s1[r]; } \
        l = l * alpha + ls; } while (0)
#define D3_PACK() do { _Pragma("unroll") for (int i4 = 0; i4 < 4; ++i4) { float pf[8]; \
        _Pragma("unroll") for (int e = 0; e < 8; ++e) pf[e] = (i4 >> 1) ? s1[8 * (i4 & 1) + e] : s0[8 * (i4 & 1) + e]; \
        pp[i4] = pack8(pf); } } while (0)
    const int nt = 2 * qb + 2, tw = (q0 + 31) >> 6;
    D3_KLOAD(0);
    bf16x8 qf[4];
    {
        const bf16_t* qp = P + (tokb + q0 + l31) * NPAD + C_DQ + h * 128 + c * 64;
        float f[4][8]; float ss = 0.f;
#pragma unroll
        for (int ks = 0; ks < 4; ++ks) { unpack8(*(const uint4*)(qp + 16 * ks + 8 * hh), f[ks]);
#pragma unroll
            for (int e = 0; e < 8; ++e) ss += f[ks][e] * f[ks][e]; }
        ss += __shfl_xor(ss, 32);
        const float sc = rsqrtf(ss * (1.f / 64.f) + EPS) * 0.125f * LOG2E;
#pragma unroll
        for (int ks = 0; ks < 4; ++ks) {
#pragma unroll
            for (int e = 0; e < 8; ++e) f[ks][e] *= sc * W.dq_n[16 * ks + 8 * hh + e];
            qf[ks] = pack8(f[ks]); }
    }
    f32x16 O[4];
#pragma unroll
    for (int vt = 0; vt < 4; ++vt)
#pragma unroll
        for (int r = 0; r < 16; ++r) O[vt][r] = 0.f;
    float m = -INFINITY, l = 0.f, alpha = 0.f;
    bf16x8 pp[4];
    f32x16 s0, s1;
    __syncthreads();
    D3_KSTORE(0);
    __syncthreads();
    unsigned* HC = (unsigned*)(lds + 81920);
    const int hbase = 32 * (256 - (qb + 1) * (qb + 1)) + (item & 31) * (2 * qb + 1) - 1;
    f32x4 hc[4]; TrTile Th, Tf; bool hok, fok = false;
    hok = diff_host_tile(p, lay, hbase + 1, Th);
    if (hok) tr_load(Th, tid, hc);
    {
        D3_KLOAD(1); D3_VLOAD(0);
        D3_QK(0);
        D3_SOFTMAX();
        D3_PACK();
        D3_KSTORE(1); D3_VSTORE(0);
        __syncthreads();
    }
#pragma unroll 1
    for (int t = 1; t < nt; ++t) {
        const bool more = (t + 1 < nt);
        if (fok) tr_flush(Tf, tid, HC + ((t - 1) & 1) * 4160);
        if (more) D3_KLOAD(t + 1);
        D3_VLOAD(t);
        if (t <= tw) {
            D3_QK(t);
            {
                float mx = -INFINITY;
#pragma unroll
                for (int r = 0; r < 16; ++r) { mx = __builtin_amdgcn_fmed3f(mx, s0[r], INFINITY); mx = __builtin_amdgcn_fmed3f(mx, s1[r], INFINITY); }
                mx = __builtin_amdgcn_fmed3f(mx, __shfl_xor(mx, 32), INFINITY);
                const float mn = __builtin_amdgcn_fmed3f(m, mx, INFINITY); alpha = __builtin_amdgcn_exp2f(m - mn); m = mn;
                float ls = 0.f;
                const bf16_t* Vb_ = (const bf16_t*)(lds + ((t - 1) & 1) * ABUF + KBYTES);
#pragma unroll
                for (int r = 0; r < 16; ++r) {
                    { const int i4 = r >> 2, vt = r & 3;
                      const bf16_t* vp = Vb_ + (32 * vt + l31) * VP + 16 * i4 + 4 * hh;
                      const s16x4 lo = *(const s16x4*)vp, hi = *(const s16x4*)(vp + 8);
                      O[vt] = MFMA32(__builtin_shufflevector(lo, hi, 0, 1, 2, 3, 4, 5, 6, 7), pp[i4], O[vt]); }
                    s0[r] = __builtin_amdgcn_exp2f(s0[r] - mn); s1[r] = __builtin_amdgcn_exp2f(s1[r] - mn); ls += s0[r] + s1[r];
                    __builtin_amdgcn_sched_barrier(0);
                }
                l = l * alpha + ls;
            }
#pragma unroll
            for (int vt = 0; vt < 4; ++vt)
#pragma unroll
                for (int r = 0; r < 16; ++r) O[vt][r] *= alpha;
            D3_PACK();
        } else if (t == tw + 1) {
            D3_PV(t - 1);
        }
        if (more) D3_KSTORE(t + 1);
        D3_VSTORE(t);
        if (hok) tr_stage(tid, hc, HC + (t & 1) * 4160);
        Tf = Th; fok = hok;
        hok = more && diff_host_tile(p, lay, hbase + t + 1, Th);
        if (hok) tr_load(Th, tid, hc);
        __syncthreads();
    }
    if (fok) tr_flush(Tf, tid, HC + ((nt - 1) & 1) * 4160);
    if (tw == nt - 1) D3_PV(nt - 1);
    __syncthreads();
#undef D3_KLOAD
#undef D3_VLOAD
#undef D3_KSTORE
#undef D3_VSTORE
#undef D3_QK
#undef D3_PV
#undef D3_SOFTMAX
#undef D3_PACK
    l += __shfl_xor(l, 32);
    float* OB = (float*)lds;
    const int orow = (g * 32 + l31) * 129;
    const float sc = (c == 0) ? 1.f / l : lam / l;
    if (c == 1) {
#pragma unroll
        for (int vt = 0; vt < 4; ++vt)
#pragma unroll
            for (int r = 0; r < 16; ++r) OB[orow + 32 * vt + crow(r, hh)] = O[vt][r] * sc; }
    __syncthreads();
    if (c == 0) {
        float ss = 0.f;
#pragma unroll
        for (int vt = 0; vt < 4; ++vt)
#pragma unroll
            for (int r = 0; r < 16; ++r) { const float o = O[vt][r] * sc - OB[orow + 32 * vt + crow(r, hh)]; O[vt][r] = o; ss += o * o; }
        ss += __shfl_xor(ss, 32);
        const float rstd = rsqrtf(ss * (1.f / 128.f) + EPS) * (1.f - W.lambda_init);
#pragma unroll
        for (int vt = 0; vt < 4; ++vt)
#pragma unroll
            for (int r = 0; r < 16; ++r) OB[orow + 32 * vt + crow(r, hh)] = O[vt][r] * rstd; }
    __syncthreads();
    { const int q = tid >> 2, part = tid & 3; const size_t tq = tokb + qb * 128 + q;
      const bf16_t* gp = P + tq * NPAD + C_GATE + 2048 + h * 128 + part * 32; bf16_t* yp = Y + tq * DM + 2048 + h * 128 + part * 32;
#pragma unroll
      for (int ch = 0; ch < 4; ++ch) { float gf[8]; unpack8(*(const uint4*)(gp + ch * 8), gf); float of[8];
#pragma unroll
          for (int e = 0; e < 8; ++e) of[e] = OB[q * 129 + part * 32 + ch * 8 + e] * gf[e] * W.d_on[part * 32 + ch * 8 + e];
          *(bf16x8*)(yp + ch * 8) = pack8(of); } }
    __syncthreads();
}

__device__ __forceinline__ float fast_sigm(float x) { return __builtin_amdgcn_rcpf(1.f + __builtin_amdgcn_exp2f(-x * LOG2E)); }
__device__ __forceinline__ void lru_pre_item(const bf16_t* __restrict__ P, bf16_t* __restrict__ HL, bf16_t* __restrict__ CP, const LayerW& W, int item, unsigned char* lds) {
    const int tid = tid_opaque(), lane = tid & 63, wave = tid >> 6, l31 = lane & 31, hh = lane >> 5;
    const int b = item >> 6, n = (item >> 3) & 7, seg = item & 7;
    const size_t tokb = (size_t)b * SEQ;
    bf16_t* WrT = (bf16_t*)lds; bf16_t* WiT = WrT + 128 * 136; bf16_t* XC = WiT + 128 * 136; float* A = (float*)(lds + 69632 + 17408); float* U = A + 8192;
    __syncthreads();
#pragma unroll 2
    for (int e = 0; e < 8; ++e) { const int idx = tid + 512 * e, i = idx >> 5, j4 = (idx & 31) * 4;
        const float4 a = *(const float4*)(W.w_r + (size_t)n * 16384 + i * 128 + j4), c = *(const float4*)(W.w_i + (size_t)n * 16384 + i * 128 + j4);
        WrT[(j4 + 0) * 136 + i] = f2bf(a.x); WrT[(j4 + 1) * 136 + i] = f2bf(a.y); WrT[(j4 + 2) * 136 + i] = f2bf(a.z); WrT[(j4 + 3) * 136 + i] = f2bf(a.w);
        WiT[(j4 + 0) * 136 + i] = f2bf(c.x); WiT[(j4 + 1) * 136 + i] = f2bf(c.y); WiT[(j4 + 2) * 136 + i] = f2bf(c.z); WiT[(j4 + 3) * 136 + i] = f2bf(c.w); }
    const int tt = wave >> 2, jt = wave & 3, chl = 32 * jt + l31, ch = n * 128 + chl;
    const float br = W.b_r[ch], bi = W.b_i[ch];
    float sp; { const float x = -W.lam[ch]; sp = (x > 20.f) ? x : log1pf(expf(x)); }
    const float sp8 = -8.f * sp;
    const int cc = 2 * (tid & 63), tg = tid >> 6, cch = n * 128 + cc;
    float cw[4][2], cb[2];
#pragma unroll
    for (int w = 0; w < 4; ++w) { cw[w][0] = W.conv_w[w * 1024 + cch]; cw[w][1] = W.conv_w[w * 1024 + cch + 1]; }
    cb[0] = W.conv_b[cch]; cb[1] = W.conv_b[cch + 1];
    unsigned rx[11];
#define LRU_LOAD(k) do { _Pragma("unroll") for (int i = 0; i < 11; ++i) { const int tp = seg * 256 + (k) * 64 + 8 * tg - 3 + i; rx[i] = (tp >= 0) ? *(const unsigned*)(P + (tokb + tp) * NPAD + C_RX + cch) : 0u; } } while (0)
    LRU_LOAD(0);
    float* XH = (float*)XC; float* XP = XH + 512;
    const int sch = tid & 127, ssub = tid >> 7;
    float hcar = 0.f, ccar = 1.f;
#pragma unroll 1
    for (int k = 0; k < 4; ++k) {
#pragma unroll
        for (int i = 0; i < 8; ++i) { float x0 = cb[0], x1 = cb[1];
#pragma unroll
            for (int w = 0; w < 4; ++w) { const unsigned v = rx[i + w]; x0 += cw[w][0] * __uint_as_float(v << 16); x1 += cw[w][1] * __uint_as_float(v & 0xffff0000u); }
            *(unsigned*)(XC + (8 * tg + i) * 136 + cc) = cvt2(x0, x1); }
        if (k + 1 < 4) LRU_LOAD(k + 1);
        __syncthreads();
        {
            f32x16 ar, ai;
#pragma unroll
            for (int r = 0; r < 16; ++r) { ar[r] = 0.f; ai[r] = 0.f; }
#pragma unroll
            for (int ks = 0; ks < 8; ++ks) {
                const bf16x8 a = *(const bf16x8*)(XC + (32 * tt + l31) * 136 + 16 * ks + 8 * hh);
                const bf16x8 wr = *(const bf16x8*)(WrT + (32 * jt + l31) * 136 + 16 * ks + 8 * hh);
                const bf16x8 wi = *(const bf16x8*)(WiT + (32 * jt + l31) * 136 + 16 * ks + 8 * hh);
                ar = MFMA32(a, wr, ar); ai = MFMA32(a, wi, ai); }
#pragma unroll
            for (int r = 0; r < 16; ++r) { const int t = 32 * tt + crow(r, hh);
                const float rr = fast_sigm(ar[r] + br), ii = fast_sigm(ai[r] + bi), la = sp8 * rr;
                const float av = __builtin_amdgcn_exp2f(la * LOG2E), x2 = 2.f * la;
                const float om = (x2 > -0.1f) ? -x2 * (1.f + x2 * (0.5f + x2 * (0.16666667f + x2 * 0.041666668f))) : 1.f - av * av;
                const float xv = bf2f(XC[t * 136 + chl]);
                A[t * 128 + chl] = av; U[t * 128 + chl] = __builtin_amdgcn_sqrtf(om) * ii * xv; }
        }
        __syncthreads();
        {
            float hl[16], cl[16]; float hh_ = 0.f, cc_ = 1.f;
#pragma unroll
            for (int t = 0; t < 16; ++t) { const float a = A[(16 * ssub + t) * 128 + sch]; hh_ = a * hh_ + U[(16 * ssub + t) * 128 + sch]; cc_ *= a; hl[t] = hh_; cl[t] = cc_; }
            XH[ssub * 128 + sch] = hh_; XP[ssub * 128 + sch] = cc_;
            __syncthreads();
            float hin = hcar, cin = ccar;
            for (int s = 0; s < ssub; ++s) { hin = XH[s * 128 + sch] + XP[s * 128 + sch] * hin; cin *= XP[s * 128 + sch]; }
            float hend = hin, cend = cin;
            for (int s = ssub; s < 4; ++s) { hend = XH[s * 128 + sch] + XP[s * 128 + sch] * hend; cend *= XP[s * 128 + sch]; }
            hcar = hend; ccar = cend;
            const size_t o = (tokb + seg * 256 + k * 64 + 16 * ssub) * 1024 + n * 128 + sch;
#pragma unroll
            for (int t = 0; t < 16; ++t) { HL[o + (size_t)t * 1024] = f2bf(hl[t] + cl[t] * hin); CP[o + (size_t)t * 1024] = f2bf(cl[t] * cin); }
            __syncthreads();
        }
    }
#undef LRU_LOAD
    __syncthreads();
}
__device__ __forceinline__ void lru_fix_item(const bf16_t* __restrict__ P, bf16_t* __restrict__ Y, const bf16_t* __restrict__ HL, const bf16_t* __restrict__ CP, int item) {
    const int tid = tid_opaque();
    const int b = item >> 6, n = (item >> 3) & 7, seg = item & 7;
    const size_t tokb = (size_t)b * SEQ;
    const int c0 = (tid & 15) * 8, tr = tid >> 4;
    float carry[8];
#pragma unroll
    for (int e = 0; e < 8; ++e) carry[e] = 0.f;
    for (int s = 0; s < seg; ++s) { const size_t o = (tokb + s * 256 + 255) * 1024 + n * 128 + c0;
        float h[8], c[8]; unpack8(*(const uint4*)(HL + o), h); unpack8(*(const uint4*)(CP + o), c);
#pragma unroll
        for (int e = 0; e < 8; ++e) carry[e] = h[e] + c[e] * carry[e]; }
#pragma unroll 2
    for (int it = 0; it < 8; ++it) { const size_t tok = tokb + seg * 256 + it * 32 + tr; const size_t o = tok * 1024 + n * 128 + c0;
        float h[8], c[8], gf[8]; unpack8(*(const uint4*)(HL + o), h); unpack8(*(const uint4*)(CP + o), c);
        unpack8(*(const uint4*)(P + tok * NPAD + C_GATE + 3072 + n * 128 + c0), gf);
        float of[8];
#pragma unroll
        for (int e = 0; e < 8; ++e) of[e] = (h[e] + c[e] * carry[e]) * gf[e];
        *(bf16x8*)(Y + tok * DM + 3072 + n * 128 + c0) = pack8(of); }
}

constexpr size_t GP_UNIT = 41216;
struct GlaPreRaw { uint4 ra0, ra1, rq, rk, rv0, rv1; };
__device__ __forceinline__ GlaPreRaw gla_pre_load(const bf16_t* __restrict__ P, int unit, int lane, int wave) {
    const int bh = unit >> 5, k = unit & 31, b = bh >> 3, h = bh & 7;
    const bf16_t* row_ = P + ((size_t)b * SEQ + k * 64 + lane) * NPAD;
    GlaPreRaw r;
    r.ra0 = *(const uint4*)(row_ + C_GA); r.ra1 = *(const uint4*)(row_ + C_GA + 8);
    r.rq = *(const uint4*)(row_ + C_GQ + h * 64 + 8 * wave); r.rk = *(const uint4*)(row_ + C_GK + h * 64 + 8 * wave);
    r.rv0 = *(const uint4*)(row_ + C_GV + h * 128 + 16 * wave); r.rv1 = *(const uint4*)(row_ + C_GV + h * 128 + 16 * wave + 8);
    return r;
}
__device__ __forceinline__ void gla_pre_unit(const GlaPreRaw& R, unsigned char* __restrict__ GP, const LayerW& W, int unit, unsigned char* lds, int tid) {
    const int lane = tid & 63, wave = tid >> 6;
    const int bh = unit >> 5, h = bh & 7;
    float* WUP = (float*)lds;
    __syncthreads();
    for (int i = tid; i < 1024; i += 512) WUP[i] = W.gla_w_up[(i >> 6) * 512 + h * 64 + (i & 63)];
    if (tid < 64) WUP[1024 + tid] = W.gla_b_up[h * 64 + tid];
    __syncthreads();
    unsigned char* g = GP + (size_t)unit * GP_UNIT;
    float al[16]; unpack8(R.ra0, al); unpack8(R.ra1, al + 8);
    float bc[8];
    { const float4 b0 = *(const float4*)(WUP + 1024 + 8 * wave), b1 = *(const float4*)(WUP + 1024 + 8 * wave + 4);
      bc[0] = b0.x; bc[1] = b0.y; bc[2] = b0.z; bc[3] = b0.w; bc[4] = b1.x; bc[5] = b1.y; bc[6] = b1.z; bc[7] = b1.w; }
#pragma unroll
    for (int r = 0; r < 16; ++r) { const float4 w0 = *(const float4*)(WUP + r * 64 + 8 * wave), w1 = *(const float4*)(WUP + r * 64 + 8 * wave + 4);
        bc[0] += al[r] * w0.x; bc[1] += al[r] * w0.y; bc[2] += al[r] * w0.z; bc[3] += al[r] * w0.w; bc[4] += al[r] * w1.x; bc[5] += al[r] * w1.y; bc[6] += al[r] * w1.z; bc[7] += al[r] * w1.w; }
#pragma unroll
    for (int e = 0; e < 8; ++e) { const float lg = bc[e]; bc[e] = (fminf(lg, 0.f) - __logf(1.f + __expf(-fabsf(lg)))) * (1.f / 16.f); }
#define DPP_ADD(x, ctrl, rmask) (x) += __int_as_float(__builtin_amdgcn_update_dpp(0, __float_as_int(x), (ctrl), (rmask), 0xf, true))
#pragma unroll
    for (int e = 0; e < 8; ++e) { DPP_ADD(bc[e], 0x111, 0xf); DPP_ADD(bc[e], 0x112, 0xf); DPP_ADD(bc[e], 0x114, 0xf); DPP_ADD(bc[e], 0x118, 0xf); DPP_ADD(bc[e], 0x142, 0xa); DPP_ADD(bc[e], 0x143, 0xc); }
#undef DPP_ADD
    float qv[8], kv[8], qd[8], kd[8]; unpack8(R.rq, qv); unpack8(R.rk, kv);
#pragma unroll
    for (int e = 0; e < 8; ++e) { const float bl = __shfl(bc[e], 63);
        qd[e] = qv[e] * 0.125f * __expf(bc[e]); kd[e] = kv[e] * __expf(-bc[e]);
        ((bf16_t*)(g + 16384))[(8 * wave + e) * 64 + lane] = f2bf(kv[e] * __expf(bl - bc[e]));
        if (lane == 63) ((float*)(g + 40960))[8 * wave + e] = __expf(bl); }
    *(bf16x8*)(g + (lane * 64 + 8 * wave) * 2) = pack8(qd); *(bf16x8*)(g + 8192 + (lane * 64 + 8 * wave) * 2) = pack8(kd);
    const unsigned vw[8] = {R.rv0.x, R.rv0.y, R.rv0.z, R.rv0.w, R.rv1.x, R.rv1.y, R.rv1.z, R.rv1.w};
    bf16_t* vt = (bf16_t*)(g + 24576);
#pragma unroll
    for (int e = 0; e < 8; ++e) { vt[(16 * wave + 2 * e) * 64 + lane] = (bf16_t)(vw[e] & 0xffffu); vt[(16 * wave + 2 * e + 1) * 64 + lane] = (bf16_t)(vw[e] >> 16); }
}
__device__ __forceinline__ void gla_pre_all(const bf16_t* __restrict__ P, unsigned char* __restrict__ GP, const LayerW& W, unsigned char* lds) {
    const int tid = tid_opaque(), lane = tid & 63, wave = tid >> 6;
    int u = blockIdx.x;
    if (u >= 1024) return;
    GlaPreRaw cur = gla_pre_load(P, u, lane, wave);
#pragma unroll 1
    while (u < 1024) {
        const int un = u + gridDim.x;
        GlaPreRaw nxt = cur;
        if (un < 1024) nxt = gla_pre_load(P, un, lane, wave);
        gla_pre_unit(cur, GP, W, u, lds, tid);
        cur = nxt; u = un;
    }
}

__device__ __forceinline__ void gla_item(const Params& p, int l, const bf16_t* __restrict__ P, bf16_t* __restrict__ Y, const unsigned char* __restrict__ GP, const LayerW& W, int item, unsigned char* lds) {
    const int tid = tid_opaque(), lane = tid & 63, wave = tid >> 6, l31 = lane & 31, hh = lane >> 5;
    const int b = item >> 3, h = item & 7;
    const size_t tokb = (size_t)b * SEQ;
    bf16_t* QD = (bf16_t*)lds; bf16_t* KD = QD + 64 * 72; bf16_t* KST = KD + 64 * 72; bf16_t* VT = KST + 64 * 72; bf16_t* ST = VT + 128 * 72;
    float* OB = (float*)(lds + 64768);
    const int vt = wave >> 1, it = wave & 1;
    const int srow = tid >> 3, sseg = tid & 7, ctok = tid >> 3, cvch = tid & 7;
    f32x16 S;
#pragma unroll
    for (int r = 0; r < 16; ++r) S[r] = 0.f;
    uint4 rQ, rK, rS, rV0, rV1, rg0, rg1; float rdec;
#define GLA_LOAD(k) do { const unsigned char* g_ = GP + (size_t)(item * 32 + (k)) * GP_UNIT + srow * 128 + sseg * 16; \
        rQ = *(const uint4*)g_; rK = *(const uint4*)(g_ + 8192); rS = *(const uint4*)(g_ + 16384); rV0 = *(const uint4*)(g_ + 24576); rV1 = *(const uint4*)(g_ + 24576 + 8192); \
        rdec = ((const float*)(GP + (size_t)(item * 32 + (k)) * GP_UNIT + 40960))[32 * it + l31]; \
        const bf16_t* gp_ = P + (tokb + (k) * 64 + ctok) * NPAD + C_GATE + h * 128 + cvch * 16; rg0 = *(const uint4*)gp_; rg1 = *(const uint4*)(gp_ + 8); } while (0)
    GLA_LOAD(0);
    unsigned* CS0 = (unsigned*)(lds + 98304); unsigned* CS1 = (unsigned*)(lds + 98304 + 16640);
    f32x4 ca[4], cb[4]; TrTile Ta, Tb;
    bool oka = host_tile(p, l, item * 32, Ta), okb = false;
    if (oka) tr_load(Ta, tid, ca);
    if (okb) tr_load(Tb, tid, cb);
    float nw[16];
#pragma unroll
    for (int e = 0; e < 16; ++e) nw[e] = W.gla_nw[cvch * 16 + e];
    const bf16_t* LH = (const bf16_t*)(p.ws + WS_LA); const bf16_t* LC = (const bf16_t*)(p.ws + WS_LU);
    const int fc0 = (tid & 15) * 8, ftr = tid >> 4;
    float fcar[8];
#pragma unroll
    for (int e = 0; e < 8; ++e) fcar[e] = 0.f;
    __syncthreads();
#pragma unroll 1
    for (int k = 0; k < 32; ++k) {
        uint4 fh0, fh1, fp0, fp1, fg0, fg1, feh, fep;
        { const size_t t0 = tokb + k * 64 + ftr, t1 = t0 + 32;
          fh0 = *(const uint4*)(LH + t0 * 1024 + h * 128 + fc0); fp0 = *(const uint4*)(LC + t0 * 1024 + h * 128 + fc0); fg0 = *(const uint4*)(P + t0 * NPAD + C_GATE + 3072 + h * 128 + fc0);
          fh1 = *(const uint4*)(LH + t1 * 1024 + h * 128 + fc0); fp1 = *(const uint4*)(LC + t1 * 1024 + h * 128 + fc0); fg1 = *(const uint4*)(P + t1 * NPAD + C_GATE + 3072 + h * 128 + fc0);
          const size_t te = tokb + (k > 0 ? k * 64 - 1 : 0);
          feh = *(const uint4*)(LH + te * 1024 + h * 128 + fc0); fep = *(const uint4*)(LC + te * 1024 + h * 128 + fc0); }
        *(uint4*)(QD + srow * 72 + sseg * 8) = rQ; *(uint4*)(KD + srow * 72 + sseg * 8) = rK; *(uint4*)(KST + srow * 72 + sseg * 8) = rS;
        *(uint4*)(VT + srow * 72 + sseg * 8) = rV0; *(uint4*)(VT + (64 + srow) * 72 + sseg * 8) = rV1;
#pragma unroll
        for (int r = 0; r < 16; ++r) ST[(32 * vt + crow(r, hh)) * 72 + 32 * it + l31] = f2bf(S[r]);
        const float dec = rdec; const uint4 g0 = rg0, g1 = rg1;
        __syncthreads();
        if (k + 1 < 32) GLA_LOAD(k + 1);
        {
            f32x16 at0, at1, o, u;
#pragma unroll
            for (int r = 0; r < 16; ++r) { at0[r] = 0.f; at1[r] = 0.f; o[r] = 0.f; u[r] = 0.f; }
#pragma unroll
            for (int ks = 0; ks < 4; ++ks) {
                const bf16x8 bq = *(const bf16x8*)(QD + (32 * it + l31) * 72 + 16 * ks + 8 * hh);
                const bf16x8 a0 = *(const bf16x8*)(KD + l31 * 72 + 16 * ks + 8 * hh), a1 = *(const bf16x8*)(KD + (32 + l31) * 72 + 16 * ks + 8 * hh);
                at0 = MFMA32(a0, bq, at0); at1 = MFMA32(a1, bq, at1); }
            const int iq = 32 * it + l31;
#pragma unroll
            for (int r = 0; r < 16; ++r) { const int j0 = crow(r, hh); if (j0 > iq) at0[r] = 0.f; if (j0 + 32 > iq) at1[r] = 0.f; }
#pragma unroll
            for (int jt2 = 0; jt2 < 2; ++jt2)
#pragma unroll
                for (int s2 = 0; s2 < 2; ++s2) { float pf[8];
#pragma unroll
                    for (int e = 0; e < 8; ++e) pf[e] = jt2 ? at1[8 * s2 + e] : at0[8 * s2 + e];
                    const bf16x8 pb = pack8(pf);
                    const bf16_t* vp = VT + (32 * vt + l31) * 72 + 32 * jt2 + 16 * s2 + 4 * hh;
                    const s16x4 lo = *(const s16x4*)vp, hi = *(const s16x4*)(vp + 8);
                    o = MFMA32(__builtin_shufflevector(lo, hi, 0, 1, 2, 3, 4, 5, 6, 7), pb, o); }
#pragma unroll
            for (int ks = 0; ks < 4; ++ks) {
                const bf16x8 a = *(const bf16x8*)(ST + (32 * vt + l31) * 72 + 16 * ks + 8 * hh);
                const bf16x8 bq = *(const bf16x8*)(QD + (32 * it + l31) * 72 + 16 * ks + 8 * hh);
                o = MFMA32(a, bq, o); }
#pragma unroll
            for (int ks = 0; ks < 4; ++ks) {
                const bf16x8 a = *(const bf16x8*)(VT + (32 * vt + l31) * 72 + 16 * ks + 8 * hh);
                const bf16x8 bk = *(const bf16x8*)(KST + (32 * it + l31) * 72 + 16 * ks + 8 * hh);
                u = MFMA32(a, bk, u); }
#pragma unroll
            for (int r = 0; r < 16; ++r) { S[r] = dec * S[r] + u[r]; OB[(32 * it + l31) * 129 + 32 * vt + crow(r, hh)] = o[r]; }
        }
        const TrTile Fa = Ta, Fb = Tb; const bool fa = oka, fb = okb;
        if (fa) tr_stage(tid, ca, CS0);
        if (fb) tr_stage(tid, cb, CS1);
        oka = (k + 1 < 32) && host_tile(p, l, item * 32 + k + 1, Ta); okb = false;
        if (oka) tr_load(Ta, tid, ca);
        if (okb) tr_load(Tb, tid, cb);
        __syncthreads();
        if (fa) tr_flush(Fa, tid, CS0);
        if (fb) tr_flush(Fb, tid, CS1);
        {
            float ov[16]; float ss = 0.f;
#pragma unroll
            for (int e = 0; e < 16; ++e) { ov[e] = OB[ctok * 129 + cvch * 16 + e]; ss += ov[e] * ov[e]; }
            ss += __shfl_xor(ss, 1); ss += __shfl_xor(ss, 2); ss += __shfl_xor(ss, 4);
            const float rstd = rsqrtf(ss * (1.f / 128.f) + EPS);
            float gf[16]; unpack8(g0, gf); unpack8(g1, gf + 8);
#pragma unroll
            for (int e = 0; e < 16; ++e) ov[e] *= rstd * nw[e] * gf[e];
            bf16_t* yp = Y + (tokb + k * 64 + ctok) * DM + h * 128 + cvch * 16;
            *(bf16x8*)yp = pack8(ov); *(bf16x8*)(yp + 8) = pack8(ov + 8);
        }
        {
            if (k > 0 && (k & 3) == 0) { float eh[8], ep[8]; unpack8(feh, eh); unpack8(fep, ep);
#pragma unroll
                for (int e = 0; e < 8; ++e) fcar[e] = eh[e] + ep[e] * fcar[e]; }
            float hv[8], cv[8], gv[8], of[8];
            unpack8(fh0, hv); unpack8(fp0, cv); unpack8(fg0, gv);
#pragma unroll
            for (int e = 0; e < 8; ++e) of[e] = (hv[e] + cv[e] * fcar[e]) * gv[e];
            *(bf16x8*)(Y + (tokb + k * 64 + ftr) * DM + 3072 + h * 128 + fc0) = pack8(of);
            unpack8(fh1, hv); unpack8(fp1, cv); unpack8(fg1, gv);
#pragma unroll
            for (int e = 0; e < 8; ++e) of[e] = (hv[e] + cv[e] * fcar[e]) * gv[e];
            *(bf16x8*)(Y + (tokb + k * 64 + 32 + ftr) * DM + 3072 + h * 128 + fc0) = pack8(of);
        }
    }
#undef GLA_LOAD
    __syncthreads();
}

constexpr int QSLOT_OFF = LDS_BYTES - 16;
constexpr size_t WS_CTR = WS_END;
constexpr size_t WS_BAR = WS_END + 512;
constexpr size_t WS_CTL_BYTES = 512 + XCD_BAR_WORDS_C * 4;
__device__ __forceinline__ void phase_mix_fast(const Params& p, int l, unsigned char* lds, int rep) {
    const LayerW W = layer_w(p, l);
    const bf16_t* P = (const bf16_t*)(p.ws + WS_PROJ); bf16_t* Y = (bf16_t*)(p.ws + WS_Y);
    unsigned* ctr = (unsigned*)(p.ws + WS_CTR) + l * 64 + rep * 16;
    const float lam = diff_lambda(W);
    volatile int* slot = (volatile int*)(lds + QSLOT_OFF);
    for (;;) {
        __syncthreads();
        if (tid_opaque() == 0) *slot = (int)atomicAdd(ctr, 1u);
        __syncthreads();
        const int it = __builtin_amdgcn_readfirstlane(*slot);
        if (it >= 800) break;
        if (it < 32) { gla_item(p, l, P, Y, p.ws + WS_GP, W, it, lds);
#ifdef PROBE_GLA2
            gla_item(p, l, P, Y, p.ws + WS_GP, W, it, lds);
#endif
        }
        else if (it < 544) diff_item3(p, l, P, Y, W, lam, it - 32, lds);
        else attn_item<true>(P, Y, W, lam, it - 544, lds);
    }
}

#define XB_TMO      128
#define XB_XCNT(j)  (256  + 64 * (j))
#define XB_XSUB(j)  (1280 + 64 * (j))
#define XB_XGEN(j)  (2304 + 64 * (j))
#define XB_TOP      3328
#define XB_TOPGEN   3392
#define XCD_BAR_WORDS 3456
#define XB_SPIN_CAP (1u << 18)

__device__ __forceinline__ unsigned xb_ld(unsigned* p)              { return __hip_atomic_load(p, __ATOMIC_RELAXED, __HIP_MEMORY_SCOPE_AGENT); }
__device__ __forceinline__ unsigned xb_add(unsigned* p, unsigned v) { return __hip_atomic_fetch_add(p, v, __ATOMIC_RELAXED, __HIP_MEMORY_SCOPE_AGENT); }
__device__ __forceinline__ unsigned xb_xcc_id() { return (unsigned)__builtin_amdgcn_s_getreg((3 << 11) | 20) & 0xFu; }
#define XB_SPIN(cond, bar) do { unsigned _sp = 0; while (cond) { __builtin_amdgcn_s_sleep(1); \
    if ((++_sp & 255u) == 0u) { if (xb_ld(&(bar)[XB_TMO])) break; if (_sp > XB_SPIN_CAP) { atomicAdd(&(bar)[XB_TMO], 1u); break; } } } } while (0)

struct XcdBarrier {
    unsigned* bar; unsigned x;
    volatile LAS unsigned* st;
};

__device__ __forceinline__ XcdBarrier xcd_barrier_post(unsigned* bar, volatile LAS unsigned* st) {
    XcdBarrier b; b.bar = bar; b.x = xb_xcc_id(); b.st = st;
    if (threadIdx.x == 0) (void)xb_add(&bar[XB_XCNT(b.x)], 1u);
    return b;
}
__device__ __forceinline__ void xcd_barrier_complete(unsigned* bar, unsigned x, unsigned& nloc, unsigned& nx) {
    const unsigned G = gridDim.x * gridDim.y * gridDim.z;
    unsigned sum, cnt, mine, sp = 0u;
    for (;;) {
        sum = 0u; cnt = 0u; mine = 0u;
#pragma unroll
        for (unsigned j = 0; j < 16; ++j) { const unsigned c = xb_ld(&bar[XB_XCNT(j)]); sum += c; cnt += (c > 0u) ? 1u : 0u; mine = (j == x) ? c : mine; }
        if (sum == G) break;
        __builtin_amdgcn_s_sleep(1);
        if ((++sp & 255u) == 0u) { if (xb_ld(&bar[XB_TMO])) break; if (sp > XB_SPIN_CAP) { atomicAdd(&bar[XB_TMO], 1u); break; } }
    }
    nloc = mine > 0u ? mine : 1u; nx = cnt > 0u ? cnt : 1u;
}

__device__ __forceinline__ void xcd_barrier(const XcdBarrier& b) {
    asm volatile("s_waitcnt vmcnt(0)" ::: "memory");
    __syncthreads();
    if (threadIdx.x == 0) {
        unsigned* bar = b.bar;
        __builtin_amdgcn_s_waitcnt(0);
        unsigned nloc = b.st[0], nx = b.st[1];
        if (nloc == 0u) { xcd_barrier_complete(bar, b.x, nloc, nx); b.st[0] = nloc; b.st[1] = nx; }
        const unsigned old = xb_add(&bar[XB_XSUB(b.x)], 1u);
        const unsigned gen = old / nloc;
        if (old + 1u == (gen + 1u) * nloc) {
            __builtin_amdgcn_fence(__ATOMIC_RELEASE, "agent");
            asm volatile("s_waitcnt vmcnt(0)" ::: "memory");
            const unsigned og = xb_add(&bar[XB_TOP], 1u);
            const unsigned tg = og / nx;
            if (og + 1u == (tg + 1u) * nx) xb_add(&bar[XB_TOPGEN], 1u);
            else XB_SPIN(xb_ld(&bar[XB_TOPGEN]) == tg, bar);
            __builtin_amdgcn_fence(__ATOMIC_ACQUIRE, "agent");
            xb_add(&bar[XB_XGEN(b.x)], 1u);
            asm volatile("s_waitcnt vmcnt(0)" ::: "memory");
        } else {
            XB_SPIN(xb_ld(&bar[XB_XGEN(b.x)]) == gen, bar);
            __builtin_amdgcn_fence(__ATOMIC_ACQUIRE, "agent");
            asm volatile("s_waitcnt vmcnt(0)" ::: "memory");
        }
    }
    __syncthreads();
}


#ifndef GEMM_SP2
#define GEMM_SP2 true
#endif
#ifndef GEMM_ALIGN
#define GEMM_ALIGN true
#endif
#ifndef REP_M1
#define REP_M1 1
#endif
#ifndef REP_PREP
#define REP_PREP 1
#endif
#ifndef REP_G1
#define REP_G1 1
#endif
#ifndef REP_MIX
#define REP_MIX 1
#endif
__global__ void __launch_bounds__(512, 2) mega(Params p) {
    extern __shared__ __attribute__((aligned(16))) unsigned char lds[];
    cg::grid_group grid = cg::this_grid();
    const int lo = p.ph_lo, hi = p.ph_hi;
#define IN(k) (lo <= (k) && (k) < hi)
#define SYNC(k) do { if (IN(k) && IN((k) + 1)) xcd_barrier(xbar); } while (0)
    if (lo < 0) grid.sync();
    volatile LAS unsigned* xst = (volatile LAS unsigned*)((LAS unsigned char*)lds + (LDS_BYTES - 32));
    if (threadIdx.x < 2) xst[threadIdx.x] = 0u;
    __syncthreads();
    XcdBarrier xbar; xbar.bar = (unsigned*)(p.ws + WS_BAR); xbar.x = xb_xcc_id(); xbar.st = xst;
    if (threadIdx.x == 0) xst[2] = xb_add(&xbar.bar[XB_XCNT(xbar.x)], 1u);
    __syncthreads();
    const int xrank = (int)xst[2];
    int cu_c = (int)blockIdx.x;
#ifdef EXTRA_SYNC
    if (hi - lo > 1) {
#pragma unroll 1
        for (int r = 0; r < EXTRA_SYNC; ++r) grid.sync(); }
#endif
    if (IN(0)) {
#pragma unroll 1
        for (int r = 0; r < REP_PREP; ++r) phase_prep(p, lds); }
    SYNC(0);
    if (hi - lo > 1) {
        bool even = (gridDim.x % 8 == 0);
        for (unsigned j = 0; j < 16; ++j) { const unsigned cnt = xb_ld(&xbar.bar[XB_XCNT(j)]); even = even && (cnt == (j < 8 ? gridDim.x / 8 : 0u)); }
        if (even) cu_c = (int)xbar.x + 8 * xrank;
    }
#pragma unroll 1
    for (int l = 0; l < 2; ++l) {
        const int pb = 1 + 5 * l;
        if (IN(pb)) {
            pg8::Gemm g{(const bf16_t*)(p.ws + WS_H), (const bf16_t*)(p.ws + WS_WIN + l * SZ_WIN), TOK, NPAD, DM};
            pg8::StaticOrder S; S.init(TOK, NPAD, (int)gridDim.x, cu_c);
            EpiProj E{(bf16_t*)(p.ws + WS_PROJ)};
#pragma unroll 1
            for (int r = 0; r < REP_G1; ++r)
            pg8::gemm_phase<EpiProj, pg8::StaticOrder, GEMM_ALIGN, GEMM_SP2>((LAS unsigned char*)lds, g, S, E);
            { const int nwg = (TOK / 256) * (NPAD / 256), G = (int)gridDim.x, rem = nwg % G;
              if (rem == 0) convert_deferred(p, l, cu_c, G, lds);
              else if (cu_c >= rem) convert_deferred(p, l, cu_c - rem, G - rem, lds); }
        }
        SYNC(pb);
        if (IN(pb + 1)) { const LayerW W = layer_w(p, l);
#pragma unroll 1
          for (int r1 = 0; r1 < REP_M1; ++r1) {
            gla_pre_all((const bf16_t*)(p.ws + WS_PROJ), p.ws + WS_GP, W, lds);
            for (int it = blockIdx.x; it < 256; it += gridDim.x) lru_pre_item((const bf16_t*)(p.ws + WS_PROJ), (bf16_t*)(p.ws + WS_LA), (bf16_t*)(p.ws + WS_LU), W, it, lds); } }
        SYNC(pb + 1);
        if (IN(pb + 2)) {
#pragma unroll 1
            for (int r = 0; r < REP_MIX; ++r) phase_mix_fast(p, l, lds, r); }
        SYNC(pb + 2);
        if (IN(pb + 3)) {
            pg8::Gemm g{(const bf16_t*)(p.ws + WS_Y), (const bf16_t*)(p.ws + WS_WOUT + l * SZ_WOUT), TOK, DM, DM};
            pg8::StaticOrder S; S.init(TOK, DM, (int)gridDim.x, cu_c);
            EpiRes E{l == 0 ? p.in[0] : (const float*)(p.ws + WS_X1), l == 0 ? (float*)(p.ws + WS_X1) : p.out};
            pg8::gemm_phase<EpiRes, pg8::StaticOrder, GEMM_ALIGN, GEMM_SP2>((LAS unsigned char*)lds, g, S, E);
        }
        SYNC(pb + 3);
        if (l == 0) {
            if (IN(pb + 4)) rmsnorm_rows<false>((const float*)(p.ws + WS_X1), p.in[1] + DM, (bf16_t*)(p.ws + WS_H));
            SYNC(pb + 4);
        }
    }
}

#ifndef COOP
#define COOP 1
#endif
extern "C" void kernel_launch(void* const* d_in, const int* in_sizes, int n_in, void* d_out, int out_size, void* d_ws, size_t ws_size, hipStream_t stream) {
    static int grid = 0;
    if (grid == 0) {
        if (n_in != 24 || ws_size < WS_END + 65536) { fprintf(stderr, "kernel_launch: unexpected n_in %d / ws %zu (need %zu)\n", n_in, ws_size, (size_t)WS_END); grid = -1; return; }
        if (hipFuncSetAttribute((const void*)mega, hipFuncAttributeMaxDynamicSharedMemorySize, LDS_BYTES) != hipSuccess) { fprintf(stderr, "kernel_launch: hipFuncSetAttribute failed\n"); grid = -1; return; }
        int dev = 0, cus = 0, per_cu = 0;
        hipGetDevice(&dev); hipDeviceGetAttribute(&cus, hipDeviceAttributeMultiprocessorCount, dev);
        hipOccupancyMaxActiveBlocksPerMultiprocessor(&per_cu, (const void*)mega, 512, LDS_BYTES);
        if (per_cu < 1) { fprintf(stderr, "kernel_launch: occupancy query says %d blocks/CU\n", per_cu); per_cu = 1; }
        grid = cus * 1;
        (void)hipGetLastError();
    }
    if (grid < 0) return;
    Params p{};
    for (int i = 0; i < 24; ++i) p.in[i] = (const float*)d_in[i];
    p.out = (float*)d_out; p.ws = (unsigned char*)d_ws;
    if (hipMemsetAsync((unsigned char*)d_ws + WS_CTR, 0, WS_CTL_BYTES, stream) != hipSuccess) { fprintf(stderr, "kernel_launch: memset failed\n"); return; }
#if COOP
    p.ph_lo = 0; p.ph_hi = NPH - 1 + 0;
    p.ph_hi = NPH;
    void* args[] = {&p};
    hipError_t e = hipLaunchCooperativeKernel((const void*)mega, dim3(grid), dim3(512), args, LDS_BYTES, stream);
    if (e != hipSuccess) fprintf(stderr, "cooperative launch failed: %s (grid %d)\n", hipGetErrorString(e), grid);
#else
    for (int ph = 0; ph < NPH; ++ph) { p.ph_lo = ph; p.ph_hi = ph + 1; hipLaunchKernelGGL(mega, dim3(grid), dim3(512), LDS_BYTES, stream, p); }
#endif
}
```
